# Optimizing an MI355X kernel written in HIP

```python
import jax, jax.numpy as jnp
from jax import lax
import numpy as np

D_MODEL = 1024
BATCH = 4
SEQ = 4096
DEPTH = 1

MIX_WIDTH = D_MODEL
CONV_WIDTH = MIX_WIDTH // 2
CONV_GROUPS = 8
CONV_KERNEL = 31
GM_WIDTH = MIX_WIDTH - CONV_WIDTH
GM_HEADS = 8
GM_HEAD_DIM = GM_WIDTH // GM_HEADS
CHUNK = 128
IN_COLS = 2 * CONV_WIDTH + 2 * GM_WIDTH
MEM_LEN = 256
XA_HEADS = 4
XA_HEAD_DIM = D_MODEL // XA_HEADS
FFN_HIDDEN = ((8 * D_MODEL // 3 + 255) // 256) * 256
RMS_EPS = 1e-6
LN_EPS = 1e-5

kernel_name = "hybrid_conv_gmlp_xattn_block"


def rmsnorm(x, g):
    xf = x.astype(jnp.float32)
    y = xf * lax.rsqrt(jnp.mean(xf * xf, axis=-1, keepdims=True) + RMS_EPS)
    return (y * g.astype(jnp.float32)).astype(x.dtype)


def layernorm(x, g, b):
    xf = x.astype(jnp.float32)
    mu = jnp.mean(xf, axis=-1, keepdims=True)
    var = jnp.mean(jnp.square(xf - mu), axis=-1, keepdims=True)
    y = (xf - mu) * lax.rsqrt(var + LN_EPS)
    return (y * g.astype(jnp.float32) + b.astype(jnp.float32)).astype(x.dtype)


def causal_depthwise_conv(a, w, b):
    k, c = w.shape
    a_pad = jnp.pad(a, ((0, 0), (k - 1, 0), (0, 0)))
    y = lax.conv_general_dilated(
        a_pad, w[:, None, :], window_strides=(1,), padding='VALID',
        dimension_numbers=('NWC', 'WIO', 'NWC'), feature_group_count=c)
    return y + b


def conformer_conv_group(za, zg, conv_w, conv_b, ln_g, ln_b):
    a = za * jax.nn.sigmoid(zg)
    a = causal_depthwise_conv(a, conv_w, conv_b)
    a = layernorm(a, ln_g, ln_b)
    return jax.nn.silu(a)


def gmlp_group(zu, zv, ln_g, ln_b, w_s, b_s):
    u = jax.nn.gelu(zu)
    v = layernorm(jax.nn.gelu(zv), ln_g, ln_b)
    bsz, s, _ = v.shape
    vh = v.reshape(bsz, s // CHUNK, CHUNK, GM_HEADS, GM_HEAD_DIM)
    mask = jnp.tril(jnp.ones((CHUNK, CHUNK), dtype=bool))
    ws = jnp.where(mask[None], w_s, jnp.zeros_like(w_s))
    mixed = jnp.einsum('hts,bnshd->bnthd', ws, vh)
    mixed = mixed + b_s.T[None, None, :, :, None]
    return u * mixed.reshape(bsz, s, GM_WIDTH)


def cross_attention(hn, mn, wq, wkv, wo):
    bsz, s, _ = hn.shape
    q = (hn @ wq).reshape(bsz, s, XA_HEADS, XA_HEAD_DIM)
    kv = mn @ wkv
    k, v = jnp.split(kv, 2, axis=-1)
    k = k.reshape(bsz, MEM_LEN, XA_HEADS, XA_HEAD_DIM)
    v = v.reshape(bsz, MEM_LEN, XA_HEADS, XA_HEAD_DIM)
    scale = XA_HEAD_DIM ** -0.5
    scores = jnp.einsum('bshd,bmhd->bhsm', q, k).astype(jnp.float32) * scale
    p = jax.nn.softmax(scores, axis=-1).astype(v.dtype)
    o = jnp.einsum('bhsm,bmhd->bshd', p, v).reshape(bsz, s, D_MODEL)
    return o @ wo


def swiglu(hn, w_gate_up, w_down):
    gu = hn @ w_gate_up
    g, u = jnp.split(gu, 2, axis=-1)
    return (jax.nn.silu(g) * u) @ w_down


def setup_inputs(seed: int = 0) -> dict:
    key = jax.random.key(seed)
    ks = jax.random.split(key, 24)
    f32 = jnp.float32

    def nrm(k, shape, scale):
        return jax.random.normal(k, shape, f32) * scale

    def gain(k, n):
        return jnp.ones((n,), f32) + 0.05 * jax.random.normal(k, (n,), f32)

    return {
        "x": nrm(ks[0], (BATCH, SEQ, D_MODEL), 1.0),
        "mem": nrm(ks[1], (BATCH, MEM_LEN, D_MODEL), 1.0),
        "norm_mix_g": gain(ks[2], D_MODEL),
        "w_in": nrm(ks[3], (D_MODEL, IN_COLS), D_MODEL ** -0.5),
        "b_in": nrm(ks[4], (IN_COLS,), 0.02),
        "conv_w": nrm(ks[5], (CONV_KERNEL, CONV_WIDTH), CONV_KERNEL ** -0.5),
        "conv_b": nrm(ks[6], (CONV_WIDTH,), 0.02),
        "conv_ln_g": gain(ks[7], CONV_WIDTH),
        "conv_ln_b": nrm(ks[8], (CONV_WIDTH,), 0.02),
        "gm_ln_g": gain(ks[9], GM_WIDTH),
        "gm_ln_b": nrm(ks[10], (GM_WIDTH,), 0.02),
        "gm_w_s": nrm(ks[11], (GM_HEADS, CHUNK, CHUNK), CHUNK ** -0.5),
        "gm_b_s": jnp.ones((GM_HEADS, CHUNK), f32) + 0.1 * jax.random.normal(ks[12], (GM_HEADS, CHUNK), f32),
        "w_out": nrm(ks[13], (MIX_WIDTH, D_MODEL), MIX_WIDTH ** -0.5),
        "norm_xa_g": gain(ks[14], D_MODEL),
        "mem_norm_g": gain(ks[15], D_MODEL),
        "xa_wq": nrm(ks[16], (D_MODEL, D_MODEL), D_MODEL ** -0.5),
        "xa_wkv": nrm(ks[17], (D_MODEL, 2 * D_MODEL), D_MODEL ** -0.5),
        "xa_wo": nrm(ks[18], (D_MODEL, D_MODEL), D_MODEL ** -0.5),
        "norm_ffn_g": gain(ks[19], D_MODEL),
        "ffn_w_gate_up": nrm(ks[20], (D_MODEL, 2 * FFN_HIDDEN), D_MODEL ** -0.5),
        "ffn_w_down": nrm(ks[21], (FFN_HIDDEN, D_MODEL), FFN_HIDDEN ** -0.5),
        "final_norm_g": gain(ks[22], D_MODEL),
    }


def reference(x, mem, norm_mix_g, w_in, b_in, conv_w, conv_b, conv_ln_g, conv_ln_b,
              gm_ln_g, gm_ln_b, gm_w_s, gm_b_s, w_out, norm_xa_g, mem_norm_g,
              xa_wq, xa_wkv, xa_wo, norm_ffn_g, ffn_w_gate_up, ffn_w_down,
              final_norm_g):
    h = x
    mn = rmsnorm(mem, mem_norm_g)
    for _ in range(DEPTH):
        hn = rmsnorm(h, norm_mix_g)
        z = hn @ w_in + b_in
        za, zg, zu, zv = jnp.split(
            z, [CONV_WIDTH, 2 * CONV_WIDTH, 2 * CONV_WIDTH + GM_WIDTH], axis=-1)
        conv_out = conformer_conv_group(za, zg, conv_w, conv_b, conv_ln_g, conv_ln_b)
        gm_out = gmlp_group(zu, zv, gm_ln_g, gm_ln_b, gm_w_s, gm_b_s)
        h = h + jnp.concatenate([conv_out, gm_out], axis=-1) @ w_out
        h = h + cross_attention(rmsnorm(h, norm_xa_g), mn, xa_wq, xa_wkv, xa_wo)
        h = h + swiglu(rmsnorm(h, norm_ffn_g), ffn_w_gate_up, ffn_w_down)
    return rmsnorm(h, final_norm_g)
```

```cpp
#include <hip/hip_runtime.h>
#include <hip/hip_cooperative_groups.h>
#include <cstdio>
#include <cstdint>
namespace cg = cooperative_groups;

#define LAS __attribute__((address_space(3)))
typedef unsigned short bf16_t;
typedef short bf16x8 __attribute__((ext_vector_type(8)));
typedef float f32x4 __attribute__((ext_vector_type(4)));
typedef float f32x2 __attribute__((ext_vector_type(2)));
typedef unsigned u32x4 __attribute__((ext_vector_type(4)));
typedef unsigned u32x2 __attribute__((ext_vector_type(2)));

constexpr int D = 1024, NB = 4, SEQ = 4096, M = NB * SEQ, CW = 512, GW = 512, CHUNK = 128, MEML = 256, MR = NB * MEML, FF = 2816;
constexpr float RMS_EPS = 1e-6f, LN_EPS = 1e-5f;
constexpr float LOG2E = 1.4426950408889634f;
constexpr float QSCALE = 0.0625f * LOG2E;

constexpr size_t MiB = 1u << 20;
constexpr size_t WS_BT1 = 0 * MiB;
constexpr size_t WS_WOUT = 4 * MiB;
constexpr size_t WS_WQ = 6 * MiB;
constexpr size_t WS_WKV = 8 * MiB;
constexpr size_t WS_WO = 12 * MiB;
constexpr size_t WS_WGU = 14 * MiB;
constexpr size_t WS_WD = 25 * MiB;
constexpr size_t WS_WSB = 31 * MiB;
constexpr size_t WS_MN = 32 * MiB;
constexpr size_t WS_KM = 34 * MiB;
constexpr size_t WS_VT = 36 * MiB;
constexpr size_t WS_SSQ1 = 38 * MiB, WS_SSQ2 = 39 * MiB, WS_SSQ3 = 40 * MiB;
constexpr size_t WS_HB = 48 * MiB;
constexpr size_t WS_HN = 80 * MiB;
constexpr size_t WS_AGLU = 112 * MiB;
constexpr size_t WS_U = 128 * MiB;
constexpr size_t WS_GVT = 144 * MiB;
constexpr size_t WS_Q = 112 * MiB;
constexpr size_t WS_ACT = 80 * MiB;
constexpr int LDS_BYTES = 147456;


constexpr size_t WS_CTL = 41 * MiB;
constexpr size_t CTL_ZERO_BYTES = 32768;
#define XB_TMO      128
#define XB_XCNT(j)  (256  + 64 * (j))
#define XB_XSUB(j)  (1280 + 64 * (j))
#define XB_XGEN(j)  (2304 + 64 * (j))
#define XB_TOP      3328
#define XB_TOPGEN   3392
#define XB_SPIN_CAP (1u << 18)
__device__ __forceinline__ unsigned xb_ld(unsigned* p)              { return __hip_atomic_load(p, __ATOMIC_RELAXED, __HIP_MEMORY_SCOPE_AGENT); }
__device__ __forceinline__ unsigned xb_add(unsigned* p, unsigned v) { return __hip_atomic_fetch_add(p, v, __ATOMIC_RELAXED, __HIP_MEMORY_SCOPE_AGENT); }
__device__ __forceinline__ unsigned xb_xcc_id() { return (unsigned)__builtin_amdgcn_s_getreg((3 << 11) | 20) & 0xFu; }
#define XB_SPIN(cond, bar) do { unsigned _sp = 0; while (cond) { __builtin_amdgcn_s_sleep(1); \
    if ((++_sp & 255u) == 0u) { if (xb_ld(&(bar)[XB_TMO])) break; if (_sp > XB_SPIN_CAP) { atomicAdd(&(bar)[XB_TMO], 1u); break; } } } } while (0)
struct XcdBarrier { unsigned* bar; unsigned x; volatile LAS unsigned* st; };
__device__ __forceinline__ XcdBarrier xcd_barrier_post(unsigned* bar, volatile LAS unsigned* st) {
    XcdBarrier b; b.bar = bar; b.x = xb_xcc_id(); b.st = st;
    if (threadIdx.x == 0) (void)xb_add(&bar[XB_XCNT(b.x)], 1u);
    return b;
}
__device__ __forceinline__ void xcd_barrier_complete(unsigned* bar, unsigned x, unsigned& nloc, unsigned& nx) {
    const unsigned G = gridDim.x * gridDim.y * gridDim.z;
    unsigned sum, cnt, mine, sp = 0u;
    for (;;) {
        sum = 0u; cnt = 0u; mine = 0u;
#pragma unroll
        for (unsigned j = 0; j < 16; ++j) { const unsigned c = xb_ld(&bar[XB_XCNT(j)]); sum += c; cnt += (c > 0u) ? 1u : 0u; mine = (j == x) ? c : mine; }
        if (sum == G) break;
        __builtin_amdgcn_s_sleep(1);
        if ((++sp & 255u) == 0u) { if (xb_ld(&bar[XB_TMO])) break; if (sp > XB_SPIN_CAP) { atomicAdd(&bar[XB_TMO], 1u); break; } }
    }
    nloc = mine > 0u ? mine : 1u; nx = cnt > 0u ? cnt : 1u;
}
__device__ __forceinline__ void xcd_barrier(const XcdBarrier& b) {
    asm volatile("s_waitcnt vmcnt(0)" ::: "memory");
    __syncthreads();
    if (threadIdx.x == 0) {
        unsigned* bar = b.bar;
        __builtin_amdgcn_s_waitcnt(0);
        unsigned nloc = b.st[0], nx = b.st[1];
        if (nloc == 0u) { xcd_barrier_complete(bar, b.x, nloc, nx); b.st[0] = nloc; b.st[1] = nx; }
        const unsigned old = xb_add(&bar[XB_XSUB(b.x)], 1u);
        const unsigned gen = old / nloc;
        if (old + 1u == (gen + 1u) * nloc) {
            __builtin_amdgcn_fence(__ATOMIC_RELEASE, "agent");
            asm volatile("s_waitcnt vmcnt(0)" ::: "memory");
            const unsigned og = xb_add(&bar[XB_TOP], 1u);
            const unsigned tg = og / nx;
            if (og + 1u == (tg + 1u) * nx) xb_add(&bar[XB_TOPGEN], 1u);
            else XB_SPIN(xb_ld(&bar[XB_TOPGEN]) == tg, bar);
            __builtin_amdgcn_fence(__ATOMIC_ACQUIRE, "agent");
            xb_add(&bar[XB_XGEN(b.x)], 1u);
            asm volatile("s_waitcnt vmcnt(0)" ::: "memory");
        } else {
            XB_SPIN(xb_ld(&bar[XB_XGEN(b.x)]) == gen, bar);
            __builtin_amdgcn_fence(__ATOMIC_ACQUIRE, "agent");
            asm volatile("s_waitcnt vmcnt(0)" ::: "memory");
        }
    }
    __syncthreads();
}

__device__ __forceinline__ unsigned cvt_pk_bf16(float lo, float hi) { unsigned r; asm volatile("v_cvt_pk_bf16_f32 %0, %1, %2" : "=v"(r) : "v"(lo), "v"(hi)); return r; }
__device__ __forceinline__ float bf_lo(unsigned u) { return __uint_as_float(u << 16); }
__device__ __forceinline__ float bf_hi(unsigned u) { return __uint_as_float(u & 0xffff0000u); }
__device__ __forceinline__ float sigmoidf_(float x) { return __builtin_amdgcn_rcpf(1.0f + __builtin_amdgcn_exp2f(-LOG2E * x)); }
__device__ __forceinline__ float siluf_(float x) { return x * sigmoidf_(x); }
__device__ __forceinline__ float geluf_(float x) { const float u = 0.7978845608028654f * (x + 0.044715f * x * x * x); return x * __builtin_amdgcn_rcpf(1.0f + __builtin_amdgcn_exp2f(-2.0f * LOG2E * u)); }
__device__ __forceinline__ f32x2 sigmoid2_(float x0, float x1) {
    const float a = 1.0f + __builtin_amdgcn_exp2f(fminf(-LOG2E * x0, 60.0f)), b = 1.0f + __builtin_amdgcn_exp2f(fminf(-LOG2E * x1, 60.0f));
    const float r = __builtin_amdgcn_rcpf(a * b);
    return (f32x2){r * b, r * a};
}
__device__ __forceinline__ f32x2 gelu2_(float x0, float x1) {
    const float u0 = 1.5957691216057308f * (x0 + 0.044715f * x0 * x0 * x0), u1 = 1.5957691216057308f * (x1 + 0.044715f * x1 * x1 * x1);
    const f32x2 sg = sigmoid2_(u0, u1); return (f32x2){x0 * sg[0], x1 * sg[1]};
}
__device__ __forceinline__ float wave_sum(float v) {
#pragma unroll
    for (int o = 1; o < 64; o <<= 1) v += __shfl_xor(v, o);
    return v;
}
__device__ __forceinline__ u32x4 pack8(f32x4 a, f32x4 b) { u32x4 w; w.x = cvt_pk_bf16(a[0], a[1]); w.y = cvt_pk_bf16(a[2], a[3]); w.z = cvt_pk_bf16(b[0], b[1]); w.w = cvt_pk_bf16(b[2], b[3]); return w; }

namespace pg8 {
constexpr int BM = 256, BK = 64, HALF = 128, HTB = HALF * BK * 2, NXCD = 8, WGM = 8;
__device__ __forceinline__ int lds_byte(int r, int c) { const int st = (r >> 4) * 2 + (c >> 5), rr = r & 15, cc = c & 31, ob = rr * 64 + cc * 2; return st * 1024 + (ob ^ (((ob >> 9) & 1) << 5)); }
__device__ __forceinline__ void stage_rc(int b, int& R, int& C) { const int st = b / 1024, sb = b % 1024, swz = sb ^ (((sb >> 9) & 1) << 5); R = (st >> 1) * 16 + swz / 64; C = (st & 1) * 32 + (swz % 64) / 2; }
__device__ __forceinline__ int perm32(int rho) { const int n = rho >> 4, i = rho & 15; return 8 * (i >> 2) + 4 * n + (i & 3); }

struct Unit { const char* A; const char* B; int pm, pn, kind; };

__device__ __forceinline__ void tile_order(int wgid, int nM, int nN, int& pm, int& pn) {
    const int nwg = nM * nN;
    { const int q = nwg / NXCD, r = nwg % NXCD, xcd = wgid % NXCD, off = wgid / NXCD; wgid = (xcd < r ? xcd * (q + 1) : r * (q + 1) + (xcd - r) * q) + off; }
    const int nig = WGM * nN, gid = wgid / nig, fm = gid * WGM, gsz = (nM - fm) < WGM ? (nM - fm) : WGM;
    pm = fm + ((wgid % nig) % gsz); pn = (wgid % nig) / gsz;
}
struct Sched {
    const char *A0, *B0, *A1, *B1, *A2, *B2; int nM0, nN0, nM1, nN1, nM2, nN2; int G, c; size_t tstep;
    __device__ __forceinline__ bool next(int i, Unit& u) const {
        int L = i * G + c;
        if (L < nM0 * nN0) { tile_order(L, nM0, nN0, u.pm, u.pn); u.A = A0 + (size_t)u.pm * tstep; u.B = B0 + (size_t)u.pn * tstep; u.kind = 0; return true; }
        L -= nM0 * nN0;
        if (L < nM1 * nN1) { tile_order(L, nM1, nN1, u.pm, u.pn); u.A = A1 + (size_t)u.pm * tstep; u.B = B1 + (size_t)u.pn * tstep; u.kind = 1; return true; }
        L -= nM1 * nN1;
        if (L < nM2 * nN2) { tile_order(L, nM2, nN2, u.pm, u.pn); u.A = A2 + (size_t)u.pm * tstep; u.B = B2 + (size_t)u.pn * tstep; u.kind = 2; return true; }
        return false;
    }
};
template <class Epi, class Sch>
__device__ __forceinline__ void gemm_phase(LAS unsigned char* lds, const int K, const Sch& S, const Epi& E) {
    int tid_ = threadIdx.x; asm volatile("" : "+v"(tid_));
    const int tid = tid_, wid = __builtin_amdgcn_readfirstlane(tid >> 6), lane = tid & 63, wr = wid >> 2, wc = wid & 3, fr = lane & 15, fq = lane >> 4;
    const int nt = K / BK;
    unsigned voffA[2], voffB[2];
#pragma unroll
    for (int i = 0; i < 2; ++i) { int R, C; stage_rc(tid * 16 + i * 8192, R, C); const int Rb = (R & ~31) + perm32(R & 31);
        voffA[i] = (unsigned)(R * K + C) * 2u; voffB[i] = (unsigned)(Rb * K + C) * 2u; }
    const size_t kstep = (size_t)(BK * 2);
    const size_t hstep = (size_t)HALF * K * 2;
    const unsigned ldsw = (unsigned)wid * 1024u;
    const int aoff = lds_byte(wr * 64 + fr, fq * 8), boff = lds_byte(wc * 32 + fr, fq * 8);
#define PG8_SA(b, h) (((b) * 2 + (h)) * HTB)
#define PG8_SB(b, h) ((4 + (b) * 2 + (h)) * HTB)
#define PG8_STAGE(bufoff, gbase, voff) do { _Pragma("unroll") for (int _i = 0; _i < 2; ++_i) \
        __builtin_amdgcn_global_load_lds((const unsigned*)((const char*)(gbase) + (voff)[_i]), (LAS unsigned*)(lds + (bufoff) + ldsw + _i * 8192), 16, 0, 0); } while (0)
#define PG8_LDA(dst, b, h) do { _Pragma("unroll") for (int m = 0; m < 4; ++m) _Pragma("unroll") for (int k = 0; k < 2; ++k) dst[m][k] = *(const LAS bf16x8*)(lds + PG8_SA(b, h) + aoff + m * 2048 + k * 1024); } while (0)
#define PG8_LDB(dst, b, h) do { _Pragma("unroll") for (int n = 0; n < 2; ++n) _Pragma("unroll") for (int k = 0; k < 2; ++k) dst[n][k] = *(const LAS bf16x8*)(lds + PG8_SB(b, h) + boff + n * 2048 + k * 1024); } while (0)
#define PG8_MMA(ai, bj, At, Bt) do { __builtin_amdgcn_s_setprio(1); _Pragma("unroll") for (int m = 0; m < 4; ++m) _Pragma("unroll") for (int n = 0; n < 2; ++n) _Pragma("unroll") for (int k = 0; k < 2; ++k) \
        acc[ai][bj][m][n] = __builtin_amdgcn_mfma_f32_16x16x32_bf16(Bt[n][k], At[m][k], acc[ai][bj][m][n], 0, 0, 0); __builtin_amdgcn_s_setprio(0); } while (0)
#define PG8_WAIT_V(n) asm volatile("s_waitcnt vmcnt(" #n ")" ::: "memory")
#define PG8_WAIT_L(n) asm volatile("s_waitcnt lgkmcnt(" #n ")" ::: "memory")
#define PG8_BAR __builtin_amdgcn_s_barrier()
#define PG8_SCHED __builtin_amdgcn_sched_barrier(0)
    Unit cur, nxt; int ui = 0;
    if (!S.next(0, cur)) return;
    f32x4 acc[2][2][4][2];
#pragma unroll
    for (int a = 0; a < 2; ++a)
#pragma unroll
        for (int b = 0; b < 2; ++b)
#pragma unroll
            for (int m = 0; m < 4; ++m)
#pragma unroll
                for (int n = 0; n < 2; ++n) acc[a][b][m][n] = (f32x4){0.f, 0.f, 0.f, 0.f};
    bf16x8 At[4][2], B0[2][2], B1[2][2];
    const char* cA = cur.A; const char* cB = cur.B;
    PG8_STAGE(PG8_SB(0, 0), cB, voffB); PG8_STAGE(PG8_SB(0, 1), cB + hstep, voffB); PG8_STAGE(PG8_SA(0, 0), cA, voffA); PG8_STAGE(PG8_SA(0, 1), cA + hstep, voffA);
    if (wr == 1) PG8_BAR;
    PG8_WAIT_V(2); PG8_BAR;
    PG8_STAGE(PG8_SB(1, 0), cB + kstep, voffB); PG8_STAGE(PG8_SA(1, 0), cA + kstep, voffA); PG8_STAGE(PG8_SB(1, 1), cB + hstep + kstep, voffB);
    PG8_WAIT_V(6); PG8_BAR;
    for (;;) {
        const bool has_next = S.next(ui + 1, nxt);
        const char* nA = has_next ? nxt.A : cA; const char* nB = has_next ? nxt.B : cB;
        for (int t = 0; t < nt; t += 2) {
            const bool last = (t == nt - 2);
            const char* a1 = cA + (size_t)(t + 1) * kstep;
            const char* a2 = last ? nA : cA + (size_t)(t + 2) * kstep; const char* b2 = last ? nB : cB + (size_t)(t + 2) * kstep;
            const char* a3 = a2 + kstep; const char* b3 = b2 + kstep;
            PG8_LDB(B0, 0, 0); PG8_LDB(B1, 0, 1); PG8_SCHED; PG8_LDA(At, 0, 0); PG8_STAGE(PG8_SA(1, 1), a1 + hstep, voffA);
            PG8_WAIT_V(8); PG8_WAIT_L(0); PG8_BAR; PG8_MMA(0, 0, At, B0); PG8_MMA(0, 1, At, B1); PG8_BAR; PG8_SCHED;
            PG8_LDA(At, 0, 1); PG8_STAGE(PG8_SB(0, 0), b2, voffB); PG8_STAGE(PG8_SB(0, 1), b2 + hstep, voffB); PG8_STAGE(PG8_SA(0, 0), a2, voffA);
            PG8_WAIT_V(8); PG8_WAIT_L(0); PG8_BAR; PG8_MMA(1, 0, At, B0); PG8_MMA(1, 1, At, B1); PG8_BAR; PG8_SCHED;
            PG8_LDB(B0, 1, 0); PG8_LDB(B1, 1, 1); PG8_SCHED; PG8_LDA(At, 1, 0); PG8_STAGE(PG8_SA(0, 1), a2 + hstep, voffA);
            PG8_WAIT_V(8); PG8_WAIT_L(0); PG8_BAR; PG8_MMA(0, 0, At, B0); PG8_MMA(0, 1, At, B1); PG8_BAR; PG8_SCHED;
            PG8_LDA(At, 1, 1); PG8_STAGE(PG8_SB(1, 0), b3, voffB); PG8_STAGE(PG8_SB(1, 1), b3 + hstep, voffB); PG8_STAGE(PG8_SA(1, 0), a3, voffA);
            PG8_WAIT_V(8); PG8_WAIT_L(0); PG8_BAR; PG8_MMA(1, 0, At, B0); PG8_MMA(1, 1, At, B1); PG8_BAR; PG8_SCHED;
        }
        if (wr == 0) PG8_BAR;
        E(acc, cur, wr, wc, fr, fq);
        if (!has_next) break;
#pragma unroll
        for (int a = 0; a < 2; ++a)
#pragma unroll
            for (int b = 0; b < 2; ++b)
#pragma unroll
                for (int m = 0; m < 4; ++m)
#pragma unroll
                    for (int n = 0; n < 2; ++n) acc[a][b][m][n] = (f32x4){0.f, 0.f, 0.f, 0.f};
        cur = nxt; cA = nA; cB = nB; ++ui;
        if (wr == 1) PG8_BAR;
    }
    PG8_WAIT_V(0);
    PG8_BAR;
#undef PG8_SA
#undef PG8_SB
#undef PG8_STAGE
#undef PG8_LDA
#undef PG8_LDB
#undef PG8_MMA
#undef PG8_WAIT_V
#undef PG8_WAIT_L
#undef PG8_BAR
#undef PG8_SCHED
}
}
using pg8::Unit;

#define EPI_ROW(ai, m) (un.pm * 256 + (ai) * 128 + wr * 64 + (m) * 16 + fr)
struct EpiP1 {
    bf16_t* aglu; bf16_t* u; bf16_t* gvT; const float* b_in;
    __device__ __forceinline__ void operator()(const f32x4 (&acc)[2][2][4][2], const Unit& un, int wr, int wc, int fr, int fq) const {
        if (un.kind == 0) {
            const int c0 = un.pn * 128 + wc * 32 + 8 * fq;
            f32x4 ba[2], bg[2];
#pragma unroll
            for (int n = 0; n < 2; ++n) { ba[n] = *(const f32x4*)(b_in + c0 + 4 * n); bg[n] = *(const f32x4*)(b_in + 512 + c0 + 4 * n); }
#pragma unroll
            for (int ai = 0; ai < 2; ++ai)
#pragma unroll
                for (int m = 0; m < 4; ++m) {
                    f32x4 v[2];
#pragma unroll
                    for (int n = 0; n < 2; ++n) { const f32x4 za = acc[ai][0][m][n] + ba[n], zg = acc[ai][1][m][n] + bg[n];
#pragma unroll
                        for (int j = 0; j < 4; j += 2) { const f32x2 sg = sigmoid2_(zg[j], zg[j + 1]); v[n][j] = za[j] * sg[0]; v[n][j + 1] = za[j + 1] * sg[1]; } }
                    *(u32x4*)(aglu + (size_t)EPI_ROW(ai, m) * CW + c0) = pack8(v[0], v[1]);
                }
        } else if (un.kind == 1) {
#pragma unroll
            for (int bj = 0; bj < 2; ++bj) {
                const int cu = un.pn * 256 + bj * 128 + wc * 32 + 8 * fq;
                f32x4 bb[2];
#pragma unroll
                for (int n = 0; n < 2; ++n) bb[n] = *(const f32x4*)(b_in + 1024 + cu + 4 * n);
#pragma unroll
                for (int ai = 0; ai < 2; ++ai)
#pragma unroll
                    for (int m = 0; m < 4; ++m) {
                        f32x4 v[2];
#pragma unroll
                        for (int n = 0; n < 2; ++n) { const f32x4 z = acc[ai][bj][m][n] + bb[n];
#pragma unroll
                            for (int j = 0; j < 4; j += 2) { const f32x2 ge = gelu2_(z[j], z[j + 1]); v[n][j] = ge[0]; v[n][j + 1] = ge[1]; } }
                        *(u32x4*)(u + (size_t)EPI_ROW(ai, m) * GW + cu) = pack8(v[0], v[1]);
                    }
            }
        } else {
#pragma unroll
            for (int ai = 0; ai < 2; ++ai)
#pragma unroll
                for (int m = 0; m < 4; ++m) {
                    const int ch = EPI_ROW(ai, m);
                    const float bb = b_in[1536 + ch];
#pragma unroll
                    for (int bj = 0; bj < 2; ++bj) {
                        const int tok = un.pn * 256 + bj * 128 + wc * 32 + 8 * fq;
                        f32x4 v[2];
#pragma unroll
                        for (int n = 0; n < 2; ++n)
#pragma unroll
                            for (int j = 0; j < 4; j += 2) { const f32x2 ge = gelu2_(acc[ai][bj][m][n][j] + bb, acc[ai][bj][m][n][j + 1] + bb); v[n][j] = ge[0]; v[n][j + 1] = ge[1]; }
                        *(u32x4*)(gvT + (size_t)ch * M + tok) = pack8(v[0], v[1]);
                    }
                }
        }
    }
};
struct EpiKV {
    bf16_t* o0; bf16_t* o1;
    __device__ __forceinline__ void operator()(const f32x4 (&acc)[2][2][4][2], const Unit& un, int wr, int wc, int fr, int fq) const {
        bf16_t* o = un.kind == 0 ? o0 : o1;
#pragma unroll
        for (int ai = 0; ai < 2; ++ai)
#pragma unroll
            for (int m = 0; m < 4; ++m)
#pragma unroll
                for (int bj = 0; bj < 2; ++bj)
                    *(u32x4*)(o + (size_t)EPI_ROW(ai, m) * 1024 + un.pn * 256 + bj * 128 + wc * 32 + 8 * fq) = pack8(acc[ai][bj][m][0], acc[ai][bj][m][1]);
    }
};
template <bool RES_BF16> struct EpiRes {
    const float* resf; bf16_t* hb; float* ssq;
    __device__ __forceinline__ void operator()(const f32x4 (&acc)[2][2][4][2], const Unit& un, int wr, int wc, int fr, int fq) const {
        const size_t off0 = (size_t)(un.pm * 256 + wr * 64 + fr) * D + un.pn * 256 + wc * 32 + 8 * fq;
        if (RES_BF16) {
            u32x4 hv[2][4][2];
#pragma unroll
            for (int ai = 0; ai < 2; ++ai)
#pragma unroll
                for (int m = 0; m < 4; ++m)
#pragma unroll
                    for (int bj = 0; bj < 2; ++bj) hv[ai][m][bj] = *(const u32x4*)(hb + off0 + (size_t)(ai * 128 + m * 16) * D + bj * 128);
#pragma unroll
            for (int ai = 0; ai < 2; ++ai)
#pragma unroll
                for (int m = 0; m < 4; ++m) {
                    float ss = 0.f;
#pragma unroll
                    for (int bj = 0; bj < 2; ++bj) {
                        const u32x4 h4 = hv[ai][m][bj];
                        const f32x4 v0 = acc[ai][bj][m][0] + (f32x4){bf_lo(h4.x), bf_hi(h4.x), bf_lo(h4.y), bf_hi(h4.y)}, v1 = acc[ai][bj][m][1] + (f32x4){bf_lo(h4.z), bf_hi(h4.z), bf_lo(h4.w), bf_hi(h4.w)};
                        *(u32x4*)(hb + off0 + (size_t)(ai * 128 + m * 16) * D + bj * 128) = pack8(v0, v1);
                        ss += (v0[0] * v0[0] + v0[1] * v0[1]) + (v0[2] * v0[2] + v0[3] * v0[3]) + (v1[0] * v1[0] + v1[1] * v1[1]) + (v1[2] * v1[2] + v1[3] * v1[3]);
                    }
                    ss += __shfl_xor(ss, 16); ss += __shfl_xor(ss, 32);
                    if (fq == 0) ssq[(size_t)EPI_ROW(ai, m) * 16 + un.pn * 4 + wc] = ss;
                }
        } else {
#pragma unroll
            for (int aim = 0; aim < 4; ++aim) {
                const int ai = aim >> 1;
                f32x4 rv[4][2][2];
#pragma unroll
                for (int m = 2 * (aim & 1); m < 2 * (aim & 1) + 2; ++m)
#pragma unroll
                    for (int bj = 0; bj < 2; ++bj) { const float* p = resf + off0 + (size_t)(ai * 128 + m * 16) * D + bj * 128; rv[m][bj][0] = *(const f32x4*)p; rv[m][bj][1] = *(const f32x4*)(p + 4); }
#pragma unroll
                for (int m = 2 * (aim & 1); m < 2 * (aim & 1) + 2; ++m) {
                    float ss = 0.f;
#pragma unroll
                    for (int bj = 0; bj < 2; ++bj) {
                        const f32x4 v0 = acc[ai][bj][m][0] + rv[m][bj][0], v1 = acc[ai][bj][m][1] + rv[m][bj][1];
                        *(u32x4*)(hb + off0 + (size_t)(ai * 128 + m * 16) * D + bj * 128) = pack8(v0, v1);
                        ss += (v0[0] * v0[0] + v0[1] * v0[1]) + (v0[2] * v0[2] + v0[3] * v0[3]) + (v1[0] * v1[0] + v1[1] * v1[1]) + (v1[2] * v1[2] + v1[3] * v1[3]);
                    }
                    ss += __shfl_xor(ss, 16); ss += __shfl_xor(ss, 32);
                    if (fq == 0) ssq[(size_t)EPI_ROW(ai, m) * 16 + un.pn * 4 + wc] = ss;
                }
                asm volatile("" ::: "memory");
            }
        }
    }
};
struct EpiFinal {
    const bf16_t* hb; float* out; float* ssqp; unsigned* cnt; const float* g;
    __device__ __forceinline__ void operator()(f32x4 (&acc)[2][2][4][2], const Unit& un, int wr, int wc, int fr, int fq) const {
        const size_t off0 = (size_t)(un.pm * 256 + wr * 64 + fr) * D + un.pn * 256 + wc * 32 + 8 * fq;
        {
            u32x4 hv[2][4][2];
#pragma unroll
            for (int ai = 0; ai < 2; ++ai)
#pragma unroll
                for (int m = 0; m < 4; ++m)
#pragma unroll
                    for (int bj = 0; bj < 2; ++bj) hv[ai][m][bj] = *(const u32x4*)(hb + off0 + (size_t)(ai * 128 + m * 16) * D + bj * 128);
#pragma unroll
            for (int ai = 0; ai < 2; ++ai)
#pragma unroll
                for (int m = 0; m < 4; ++m) {
                    float ss = 0.f;
#pragma unroll
                    for (int bj = 0; bj < 2; ++bj) {
                        const u32x4 h4 = hv[ai][m][bj];
                        const f32x4 v0 = acc[ai][bj][m][0] + (f32x4){bf_lo(h4.x), bf_hi(h4.x), bf_lo(h4.y), bf_hi(h4.y)}, v1 = acc[ai][bj][m][1] + (f32x4){bf_lo(h4.z), bf_hi(h4.z), bf_lo(h4.w), bf_hi(h4.w)};
                        acc[ai][bj][m][0] = v0; acc[ai][bj][m][1] = v1;
                        ss += (v0[0] * v0[0] + v0[1] * v0[1]) + (v0[2] * v0[2] + v0[3] * v0[3]) + (v1[0] * v1[0] + v1[1] * v1[1]) + (v1[2] * v1[2] + v1[3] * v1[3]);
                    }
                    ss += __shfl_xor(ss, 16); ss += __shfl_xor(ss, 32);
                    if (fq == 0) __hip_atomic_store(ssqp + ((size_t)un.pn * M + EPI_ROW(ai, m)) * 4 + wc, ss, __ATOMIC_RELAXED, __HIP_MEMORY_SCOPE_AGENT);
                }
        }
        asm volatile("s_waitcnt vmcnt(0)" ::: "memory");
        if ((threadIdx.x & 63) == 0) __hip_atomic_fetch_add(cnt + 64 * un.pm, 1u, __ATOMIC_RELAXED, __HIP_MEMORY_SCOPE_AGENT);
        f32x4 gg[2][2];
#pragma unroll
        for (int bj = 0; bj < 2; ++bj)
#pragma unroll
            for (int n = 0; n < 2; ++n) gg[bj][n] = *(const f32x4*)(g + un.pn * 256 + bj * 128 + wc * 32 + 8 * fq + 4 * n);
        if (wr == 0 && wc == 0) {
            unsigned sp = 0;
            while ((unsigned)__builtin_amdgcn_readfirstlane(__hip_atomic_load(cnt + 64 * un.pm, __ATOMIC_RELAXED, __HIP_MEMORY_SCOPE_AGENT)) < 32u) { __builtin_amdgcn_s_sleep(2); if (++sp > (1u << 22)) break; }
            __builtin_amdgcn_fence(__ATOMIC_ACQUIRE, "agent");
        }
        asm volatile("s_waitcnt vmcnt(0) lgkmcnt(0)" ::: "memory"); __builtin_amdgcn_s_barrier(); asm volatile("" ::: "memory");
        float rr[2][4];
        {
            unsigned long long p0[2][4], p1[2][4];
#pragma unroll
            for (int ai = 0; ai < 2; ++ai)
#pragma unroll
                for (int m = 0; m < 4; ++m) { const unsigned long long* sp8 = (const unsigned long long*)(ssqp + ((size_t)fq * M + EPI_ROW(ai, m)) * 4);
                    p0[ai][m] = __hip_atomic_load(sp8, __ATOMIC_RELAXED, __HIP_MEMORY_SCOPE_AGENT); p1[ai][m] = __hip_atomic_load(sp8 + 1, __ATOMIC_RELAXED, __HIP_MEMORY_SCOPE_AGENT); }
#pragma unroll
            for (int ai = 0; ai < 2; ++ai)
#pragma unroll
                for (int m = 0; m < 4; ++m) {
                    float t = (__uint_as_float((unsigned)p0[ai][m]) + __uint_as_float((unsigned)(p0[ai][m] >> 32))) + (__uint_as_float((unsigned)p1[ai][m]) + __uint_as_float((unsigned)(p1[ai][m] >> 32)));
                    t += __shfl_xor(t, 16); t += __shfl_xor(t, 32);
                    rr[ai][m] = 1.0f / sqrtf(t * (1.0f / D) + RMS_EPS);
                }
        }
#pragma unroll
        for (int ai = 0; ai < 2; ++ai)
#pragma unroll
            for (int m = 0; m < 4; ++m) {
                const float r = rr[ai][m];
#pragma unroll
                for (int bj = 0; bj < 2; ++bj) {
                    float* op = out + off0 + (size_t)(ai * 128 + m * 16) * D + bj * 128;
                    *(f32x4*)op = acc[ai][bj][m][0] * r * gg[bj][0]; *(f32x4*)(op + 4) = acc[ai][bj][m][1] * r * gg[bj][1];
                }
            }
    }
};
__device__ __forceinline__ float row_rs(const float* ssq, int row, int fq) {
    const f32x4 p = *(const f32x4*)(ssq + (size_t)row * 16 + 4 * fq);
    float s = (p[0] + p[1]) + (p[2] + p[3]); s += __shfl_xor(s, 16); s += __shfl_xor(s, 32);
    return __builtin_amdgcn_rsqf(s * (1.0f / D) + RMS_EPS);
}
struct EpiQ {
    bf16_t* q; const float* ssq;
    __device__ __forceinline__ void operator()(const f32x4 (&acc)[2][2][4][2], const Unit& un, int wr, int wc, int fr, int fq) const {
#pragma unroll
        for (int ai = 0; ai < 2; ++ai)
#pragma unroll
            for (int m = 0; m < 4; ++m) {
                const int row = EPI_ROW(ai, m); const float r = row_rs(ssq, row, fq) * QSCALE;
#pragma unroll
                for (int bj = 0; bj < 2; ++bj)
                    *(u32x4*)(q + (size_t)row * D + un.pn * 256 + bj * 128 + wc * 32 + 8 * fq) = pack8(acc[ai][bj][m][0] * r, acc[ai][bj][m][1] * r);
            }
    }
};
struct EpiGU {
    bf16_t* act; const float* ssq;
    __device__ __forceinline__ void operator()(const f32x4 (&acc)[2][2][4][2], const Unit& un, int wr, int wc, int fr, int fq) const {
#pragma unroll
        for (int ai = 0; ai < 2; ++ai)
#pragma unroll
            for (int m = 0; m < 4; ++m) {
                const int row = EPI_ROW(ai, m); const float r = row_rs(ssq, row, fq);
                f32x4 v[2];
#pragma unroll
                for (int n = 0; n < 2; ++n)
#pragma unroll
                    for (int j = 0; j < 4; j += 2) { const float g0 = acc[ai][0][m][n][j] * r, g1 = acc[ai][0][m][n][j + 1] * r; const f32x2 sg = sigmoid2_(g0, g1);
                        v[n][j] = g0 * sg[0] * (acc[ai][1][m][n][j] * r); v[n][j + 1] = g1 * sg[1] * (acc[ai][1][m][n][j + 1] * r); }
                *(u32x4*)(act + (size_t)row * FF + un.pn * 128 + wc * 32 + 8 * fq) = pack8(v[0], v[1]);
            }
    }
};

__device__ __forceinline__ void p0_transpose_item(const float* W, int N, bf16_t* WT, int K, int dest_row0, const float* gk, LAS float* scr, int k0, int n0, int lane) {
    float v[32];
    const float* wp = W + (size_t)(k0 + (lane >> 5)) * N + n0 + (lane & 31);
#pragma unroll
    for (int i = 0; i < 32; ++i) v[i] = wp[(size_t)(2 * i) * N];
    if (gk) {
        const float gv = gk[k0 + lane];
#pragma unroll
        for (int i = 0; i < 32; ++i) v[i] *= __shfl(gv, 2 * i + (lane >> 5));
    }
#pragma unroll
    for (int i = 0; i < 32; ++i) scr[(2 * i + (lane >> 5)) * 33 + (lane & 31)] = v[i];
    asm volatile("s_waitcnt lgkmcnt(0)" ::: "memory");
    const int c = lane & 7;
#pragma unroll
    for (int j = 0; j < 4; ++j) { const int n = (lane >> 3) + 8 * j; const LAS float* s = scr + (8 * c) * 33 + n;
        u32x4 o; o.x = cvt_pk_bf16(s[0 * 33], s[1 * 33]); o.y = cvt_pk_bf16(s[2 * 33], s[3 * 33]); o.z = cvt_pk_bf16(s[4 * 33], s[5 * 33]); o.w = cvt_pk_bf16(s[6 * 33], s[7 * 33]);
        *(u32x4*)(WT + (size_t)(dest_row0 + n) * K + k0 + 8 * c) = o; }
    asm volatile("s_waitcnt lgkmcnt(0)" ::: "memory");
}
__device__ __forceinline__ void rms_row_to_bf16(const float* xrow, const float* g, bf16_t* orow, int lane) {
    const f32x4* xr = (const f32x4*)xrow + lane; const f32x4* gr = (const f32x4*)g + lane;
    f32x4 v[4]; float s = 0.f;
#pragma unroll
    for (int j = 0; j < 4; ++j) { v[j] = xr[64 * j]; s += (v[j][0] * v[j][0] + v[j][1] * v[j][1]) + (v[j][2] * v[j][2] + v[j][3] * v[j][3]); }
    const float r = 1.0f / sqrtf(wave_sum(s) * (1.0f / D) + RMS_EPS);
    u32x2* o8 = (u32x2*)orow + lane;
#pragma unroll
    for (int j = 0; j < 4; ++j) { const f32x4 gg = gr[64 * j]; u32x2 w; w.x = cvt_pk_bf16(v[j][0] * r * gg[0], v[j][1] * r * gg[1]); w.y = cvt_pk_bf16(v[j][2] * r * gg[2], v[j][3] * r * gg[3]); o8[64 * j] = w; }
}

struct Args { const float* in[23]; float* out; unsigned char* ws; unsigned long long never; };

__device__ __forceinline__ void rms_row2_to_bf16(const float* xrow, const float* g, bf16_t* orow, int lane) {
    const f32x4* xr = (const f32x4*)xrow + lane; const f32x4* gr = (const f32x4*)g + lane;
    f32x4 v[8]; float s0 = 0.f, s1 = 0.f;
#pragma unroll
    for (int j = 0; j < 8; ++j) v[j] = xr[64 * j];
#pragma unroll
    for (int j = 0; j < 4; ++j) { s0 += (v[j][0] * v[j][0] + v[j][1] * v[j][1]) + (v[j][2] * v[j][2] + v[j][3] * v[j][3]); s1 += (v[4 + j][0] * v[4 + j][0] + v[4 + j][1] * v[4 + j][1]) + (v[4 + j][2] * v[4 + j][2] + v[4 + j][3] * v[4 + j][3]); }
    const float r0 = 1.0f / sqrtf(wave_sum(s0) * (1.0f / D) + RMS_EPS), r1 = 1.0f / sqrtf(wave_sum(s1) * (1.0f / D) + RMS_EPS);
    u32x2* o8 = (u32x2*)orow + lane;
#pragma unroll
    for (int j = 0; j < 4; ++j) { const f32x4 gg = gr[64 * j]; u32x2 w;
        w.x = cvt_pk_bf16(v[j][0] * r0 * gg[0], v[j][1] * r0 * gg[1]); w.y = cvt_pk_bf16(v[j][2] * r0 * gg[2], v[j][3] * r0 * gg[3]); o8[64 * j] = w;
        w.x = cvt_pk_bf16(v[4 + j][0] * r1 * gg[0], v[4 + j][1] * r1 * gg[1]); w.y = cvt_pk_bf16(v[4 + j][2] * r1 * gg[2], v[4 + j][3] * r1 * gg[3]); o8[256 + 64 * j] = w; }
}
__device__ __forceinline__ void rms_row4_to_bf16(const float* xrow, const float* g, bf16_t* orow, int lane) {
    const f32x4* xr = (const f32x4*)xrow + lane; const f32x4* gr = (const f32x4*)g + lane;
    f32x4 v[16]; float ss[4];
#pragma unroll
    for (int j = 0; j < 16; ++j) v[j] = xr[64 * j];
#pragma unroll
    for (int r = 0; r < 4; ++r) { float s = 0.f;
#pragma unroll
        for (int j = 0; j < 4; ++j) s += (v[4 * r + j][0] * v[4 * r + j][0] + v[4 * r + j][1] * v[4 * r + j][1]) + (v[4 * r + j][2] * v[4 * r + j][2] + v[4 * r + j][3] * v[4 * r + j][3]);
        ss[r] = s; }
#pragma unroll
    for (int o = 1; o < 64; o <<= 1) {
#pragma unroll
        for (int r = 0; r < 4; ++r) ss[r] += __shfl_xor(ss[r], o); }
    u32x2* o8 = (u32x2*)orow + lane;
#pragma unroll
    for (int j = 0; j < 4; ++j) { const f32x4 gg = gr[64 * j];
#pragma unroll
        for (int r = 0; r < 4; ++r) { const float rr = 1.0f / sqrtf(ss[r] * (1.0f / D) + RMS_EPS); const f32x4 x = v[4 * r + j]; u32x2 w;
            w.x = cvt_pk_bf16(x[0] * rr * gg[0], x[1] * rr * gg[1]); w.y = cvt_pk_bf16(x[2] * rr * gg[2], x[3] * rr * gg[3]); o8[256 * r + 64 * j] = w; } }
}
__device__ __forceinline__ void p0_prologue(const Args& a, LAS unsigned char* lds, int bid, int G, int wid, int lane) {
    LAS float* scr = (LAS float*)(lds + wid * 16384);
    const int gw = bid * 8 + wid, NGW = G * 8;
    unsigned char* ws = a.ws;
    constexpr int I0 = 16 * 64, I1 = 16 * 32, I3 = 16 * 64;
    constexpr int NITEMS = I0 + I1 + I3;
    for (int it = gw; it < NITEMS; it += NGW) {
        int r = it;
        if (r < I0) { const int nb = r % 64, kb = r / 64, n0 = nb * 32; int dr = n0;
            if (n0 < 1024) { const int half = n0 / 512, c = n0 % 512; dr = 256 * (c / 128) + 128 * half + (c % 128); }
            p0_transpose_item(a.in[3], 2048, (bf16_t*)(ws + WS_BT1), 1024, dr, nullptr, scr, kb * 64, n0, lane); continue; } r -= I0;
        if (r < I1) { p0_transpose_item(a.in[13], 1024, (bf16_t*)(ws + WS_WOUT), 1024, (r % 32) * 32, nullptr, scr, (r / 32) * 64, (r % 32) * 32, lane); continue; } r -= I1;
        p0_transpose_item(a.in[17], 2048, (bf16_t*)(ws + WS_WKV), 1024, (r % 64) * 32, nullptr, scr, (r / 64) * 64, (r % 64) * 32, lane);
    }
    for (int m = 4 * gw; m < M; m += 4 * NGW) rms_row4_to_bf16(a.in[0] + (size_t)m * D, a.in[2], (bf16_t*)(ws + WS_HN) + (size_t)m * D, lane);
    for (int m = gw; m < MR; m += NGW) rms_row_to_bf16(a.in[1] + (size_t)m * D, a.in[15], (bf16_t*)(ws + WS_MN) + (size_t)m * D, lane);
    for (int rr = gw; rr < 8 * 128; rr += NGW) {
        const int t = rr & 127; const f32x2 wv = *(const f32x2*)(a.in[11] + (size_t)rr * 128 + 2 * lane);
        ((unsigned*)(ws + WS_WSB))[(size_t)rr * 64 + lane] = cvt_pk_bf16(2 * lane <= t ? wv[0] : 0.f, 2 * lane + 1 <= t ? wv[1] : 0.f);
    }
}
struct LwItem { const float* wp; const float* gk; bf16_t* wt; int N, K, k0; };
__device__ __forceinline__ LwItem lw_decode(const Args& a, unsigned char* ws, int it, int lane) {
    constexpr int I2 = 16 * 32, I4 = 16 * 32, I5 = 16 * 176;
    const float* W; const float* gk = nullptr; bf16_t* WT; int N, K = 1024, k0, n0, dr;
    if (it < I2) { W = a.in[16]; gk = a.in[14]; WT = (bf16_t*)(ws + WS_WQ); N = 1024; k0 = (it / 32) * 64; n0 = (it % 32) * 32; dr = n0; }
    else if (it < I2 + I4) { const int r = it - I2; W = a.in[18]; WT = (bf16_t*)(ws + WS_WO); N = 1024; k0 = (r / 32) * 64; n0 = (r % 32) * 32; dr = n0; }
    else if (it < I2 + I4 + I5) { const int r = it - I2 - I4; W = a.in[20]; gk = a.in[19]; WT = (bf16_t*)(ws + WS_WGU); N = 2 * FF; k0 = (r / 176) * 64; n0 = (r % 176) * 32;
        const int half = n0 / FF, c = n0 % FF; dr = 256 * (c / 128) + 128 * half + (c % 128); }
    else { const int r = it - I2 - I4 - I5; W = a.in[21]; WT = (bf16_t*)(ws + WS_WD); N = 1024; K = FF; k0 = (r / 32) * 64; n0 = (r % 32) * 32; dr = n0; }
    LwItem d; d.wp = W + (size_t)(k0 + (lane >> 5)) * N + n0 + (lane & 31); d.gk = gk; d.wt = WT + (size_t)dr * K + k0; d.N = N; d.K = K; d.k0 = k0; return d;
}
__device__ __forceinline__ void late_weights(const Args& a, LAS unsigned char* lds, int gw, int NGW, int wid, int lane) {
    LAS float* scr = (LAS float*)(lds + wid * 16384);
    unsigned char* ws = a.ws;
    constexpr int NITEMS = 16 * 32 + 16 * 32 + 16 * 176 + 44 * 32;
    if (gw >= NITEMS) return;
    LwItem cur = lw_decode(a, ws, gw, lane);
    float v[32];
#pragma unroll
    for (int i = 0; i < 32; ++i) v[i] = cur.wp[(size_t)(2 * i) * cur.N];
    for (int it = gw; it < NITEMS; it += NGW) {
        const bool has_next = it + NGW < NITEMS;
        LwItem nxt = cur; float nv[32];
        if (has_next) { nxt = lw_decode(a, ws, it + NGW, lane);
#pragma unroll
            for (int i = 0; i < 32; ++i) nv[i] = nxt.wp[(size_t)(2 * i) * nxt.N]; }
        if (cur.gk) { const float gv = cur.gk[cur.k0 + lane];
#pragma unroll
            for (int i = 0; i < 32; ++i) v[i] *= __shfl(gv, 2 * i + (lane >> 5)); }
#pragma unroll
        for (int i = 0; i < 32; ++i) scr[(2 * i + (lane >> 5)) * 33 + (lane & 31)] = v[i];
        asm volatile("s_waitcnt lgkmcnt(0)" ::: "memory");
        const int c = lane & 7;
#pragma unroll
        for (int j = 0; j < 4; ++j) { const int n = (lane >> 3) + 8 * j; const LAS float* sp = scr + (8 * c) * 33 + n;
            u32x4 o; o.x = cvt_pk_bf16(sp[0 * 33], sp[1 * 33]); o.y = cvt_pk_bf16(sp[2 * 33], sp[3 * 33]); o.z = cvt_pk_bf16(sp[4 * 33], sp[5 * 33]); o.w = cvt_pk_bf16(sp[6 * 33], sp[7 * 33]);
            *(u32x4*)(cur.wt + (size_t)n * cur.K + 8 * c) = o; }
        asm volatile("s_waitcnt lgkmcnt(0)" ::: "memory");
        if (has_next) {
#pragma unroll
            for (int i = 0; i < 32; ++i) v[i] = nv[i];
            cur = nxt; }
    }
}

template <int NT> __device__ __forceinline__ void conv_unit(const Args& a, LAS unsigned char* lds, int unit, int tid, int wid, int lane) {
    unsigned char* ws = a.ws;
    const bf16_t* aglu = (const bf16_t*)(ws + WS_AGLU); const bf16_t* ub = (const bf16_t*)(ws + WS_U); const bf16_t* gvT = (const bf16_t*)(ws + WS_GVT);
    const bf16_t* wsb = (const bf16_t*)(ws + WS_WSB); bf16_t* mix = (bf16_t*)(ws + WS_HN);
    const int t0 = unit * NT, p0 = t0 & (SEQ - 1);
    constexpr int HT = NT / 2, NB = NT / 16;
    {
        const int cp = tid & 255, th = tid >> 8;
        f32x2 w[31];
#pragma unroll
        for (int k = 0; k < 31; ++k) w[k] = *(const f32x2*)(a.in[5] + k * CW + 2 * cp);
        const f32x2 cb = *(const f32x2*)(a.in[6] + 2 * cp);
        const int base = t0 + HT * th;
        const int pbase = p0 + HT * th;
        const unsigned* arow = (const unsigned*)aglu + cp;
        f32x2 win[38];
#pragma unroll
        for (int i = 0; i < 30; ++i) { const bool ok = (pbase - 30 + i) >= 0; const unsigned v = ok ? arow[(size_t)(base - 30 + i) * 256] : 0u; win[i] = (f32x2){bf_lo(v), bf_hi(v)}; }
        unsigned nx[8], nx2[8];
#pragma unroll
        for (int i = 0; i < 8; ++i) nx[i] = arow[(size_t)(base + i) * 256];
#pragma unroll
        for (int i = 0; i < 8; ++i) nx2[i] = arow[(size_t)(base + 8 + i) * 256];
        for (int blk = 0; blk < NB; ++blk) {
#pragma unroll
            for (int i = 0; i < 8; ++i) win[30 + i] = (f32x2){bf_lo(nx[i]), bf_hi(nx[i])};
#pragma unroll
            for (int i = 0; i < 8; ++i) nx[i] = nx2[i];
            if (blk < NB - 2) {
#pragma unroll
                for (int i = 0; i < 8; ++i) nx2[i] = arow[(size_t)(base + 8 * (blk + 2) + i) * 256];
            }
#pragma unroll
            for (int o = 0; o < 8; ++o) {
                f32x2 s = cb;
#pragma unroll
                for (int k = 0; k < 31; ++k) s += w[k] * win[o + k];
                *(LAS unsigned*)(lds + (size_t)(HT * th + 8 * blk + o) * 1024 + cp * 4) = cvt_pk_bf16(s[0], s[1]);
            }
#pragma unroll
            for (int i = 0; i < 30; ++i) win[i] = win[i + 8];
        }
    }
    __syncthreads();
    {
        f32x4 g0 = *(const f32x4*)(a.in[7] + 8 * lane), g1 = *(const f32x4*)(a.in[7] + 8 * lane + 4);
        f32x4 b0 = *(const f32x4*)(a.in[8] + 8 * lane), b1 = *(const f32x4*)(a.in[8] + 8 * lane + 4);
        for (int i = 0; i < NT / 8; ++i) {
            const int tok = wid * (NT / 8) + i;
            const u32x4 raw = *(const LAS u32x4*)(lds + (size_t)tok * 1024 + lane * 16);
            f32x4 x0 = {bf_lo(raw.x), bf_hi(raw.x), bf_lo(raw.y), bf_hi(raw.y)}, x1 = {bf_lo(raw.z), bf_hi(raw.z), bf_lo(raw.w), bf_hi(raw.w)};
            const float mean = wave_sum((x0[0] + x0[1]) + (x0[2] + x0[3]) + (x1[0] + x1[1]) + (x1[2] + x1[3])) * (1.0f / CW);
            x0 = x0 - mean; x1 = x1 - mean;
            const float var = wave_sum((x0[0] * x0[0] + x0[1] * x0[1]) + (x0[2] * x0[2] + x0[3] * x0[3]) + (x1[0] * x1[0] + x1[1] * x1[1]) + (x1[2] * x1[2] + x1[3] * x1[3])) * (1.0f / CW);
            const float rstd = 1.0f / sqrtf(var + LN_EPS);
            f32x4 y0 = x0 * rstd * g0 + b0, y1 = x1 * rstd * g1 + b1;
#pragma unroll
            for (int j = 0; j < 4; ++j) { y0[j] = siluf_(y0[j]); y1[j] = siluf_(y1[j]); }
            *(u32x4*)(mix + (size_t)(t0 + tok) * D + 8 * lane) = pack8(y0, y1);
        }
    }
    __syncthreads();
}
__device__ __forceinline__ void gmlp_unit(const Args& a, LAS unsigned char* lds, int chunk, int tid, int wid, int lane) {
    unsigned char* ws = a.ws;
    const bf16_t* ub = (const bf16_t*)(ws + WS_U); const bf16_t* gvT = (const bf16_t*)(ws + WS_GVT);
    const bf16_t* wsb = (const bf16_t*)(ws + WS_WSB); bf16_t* mix = (bf16_t*)(ws + WS_HN);
    const int t0 = chunk * CHUNK;
    constexpr int LDG = 264;
    LAS unsigned char* part = lds + 512 * LDG;
    LAS f32x2* stat = (LAS f32x2*)(lds + 512 * LDG + 8192);
    const int h = wid, fr = lane & 15, fq = lane >> 4;
    bf16x8 Bf[20];
    const bf16_t* wb = wsb + (size_t)(h * 128 + fr) * 128 + 8 * fq;
    {
        int n = 0;
#pragma unroll
        for (int ks = 0; ks < 2; ++ks)
#pragma unroll
            for (int tb = 0; tb < 4; ++tb) { if (tb < 2 * ks) continue; Bf[n++] = *(const bf16x8*)(wb + (size_t)(16 * tb) * 128 + 32 * ks); }
    }
    const bf16_t* ubase = ub + (size_t)(t0 + fr) * GW + 64 * h + 4 * fq;
    u32x2 uu[2][4][4];
#pragma unroll
    for (int tb = 0; tb < 4; ++tb)
#pragma unroll
        for (int db = 0; db < 4; ++db) uu[0][tb][db] = *(const u32x2*)(ubase + (size_t)(16 * tb) * GW + 16 * db);
    {
        const bf16_t* gp = gvT + (size_t)(tid >> 4) * M + t0 + (tid & 15) * 8;
        LAS unsigned char* lp = lds + (tid >> 4) * LDG + (tid & 15) * 16;
        u32x4 tr[16];
#pragma unroll
        for (int p = 0; p < 16; ++p) tr[p] = *(const u32x4*)(gp + (size_t)(32 * p) * M);
#pragma unroll
        for (int p = 0; p < 16; ++p) *(LAS u32x4*)(lp + 32 * p * LDG) = tr[p];
    }
    __syncthreads();
    {
        const int tg = tid & 15, cgp = tid >> 4;
        float sm[8], sq[8];
#pragma unroll
        for (int j = 0; j < 8; ++j) { sm[j] = 0.f; sq[j] = 0.f; }
        const LAS unsigned char* rp = lds + (16 * cgp) * LDG + tg * 16;
#pragma unroll
        for (int c = 0; c < 16; ++c) { const u32x4 r = *(const LAS u32x4*)(rp + c * LDG);
            const float v[8] = {bf_lo(r.x), bf_hi(r.x), bf_lo(r.y), bf_hi(r.y), bf_lo(r.z), bf_hi(r.z), bf_lo(r.w), bf_hi(r.w)};
#pragma unroll
            for (int j = 0; j < 8; ++j) { sm[j] += v[j]; sq[j] += v[j] * v[j]; } }
#pragma unroll
        for (int j = 0; j < 8; ++j) { sm[j] += __shfl_xor(sm[j], 16); sm[j] += __shfl_xor(sm[j], 32); sq[j] += __shfl_xor(sq[j], 16); sq[j] += __shfl_xor(sq[j], 32); }
        if (lane < 16) {
#pragma unroll
            for (int j = 0; j < 8; ++j) *(LAS f32x2*)(part + ((size_t)wid * 128 + 8 * tg + j) * 8) = (f32x2){sm[j], sq[j]};
        }
        __syncthreads();
        if (tid < 128) { float ts = 0.f, tq2 = 0.f;
#pragma unroll
            for (int w = 0; w < 8; ++w) { const f32x2 p = *(const LAS f32x2*)(part + ((size_t)w * 128 + tid) * 8); ts += p[0]; tq2 += p[1]; }
            const float mean = ts * (1.0f / GW); const float var = fmaxf(tq2 * (1.0f / GW) - mean * mean, 0.f);
            stat[tid] = (f32x2){mean, 1.0f / sqrtf(var + LN_EPS)}; }
        __syncthreads();
    }
    {
        float lg[4], lb[4];
#pragma unroll
        for (int db = 0; db < 4; ++db) { lg[db] = a.in[9][64 * h + 16 * db + fr]; lb[db] = a.in[10][64 * h + 16 * db + fr]; }
        const LAS unsigned char* abase = lds + (64 * h + fr) * LDG + fq * 16;
        bf16_t* obase = mix + (size_t)(t0 + fr) * D + 512 + 64 * h + 4 * fq;
        int nb = 0;
#pragma unroll
        for (int th = 0; th < 2; ++th) {
            if (th == 0) {
#pragma unroll
                for (int tb = 0; tb < 4; ++tb)
#pragma unroll
                    for (int db = 0; db < 4; ++db) uu[1][tb][db] = *(const u32x2*)(ubase + (size_t)(16 * (4 + tb)) * GW + 16 * db);
            }
            f32x4 acc[4][4];
#pragma unroll
            for (int db = 0; db < 4; ++db)
#pragma unroll
                for (int tb = 0; tb < 4; ++tb) acc[db][tb] = (f32x4){0.f, 0.f, 0.f, 0.f};
#pragma unroll
            for (int ks = 0; ks < 2 * th + 2; ++ks) {
                float mu[8], rs[8];
#pragma unroll
                for (int j = 0; j < 8; ++j) { const f32x2 st = stat[32 * ks + 8 * fq + j]; mu[j] = st[0]; rs[j] = st[1]; }
                bf16x8 Af[4];
#pragma unroll
                for (int db = 0; db < 4; ++db) {
                    const u32x4 r = *(const LAS u32x4*)(abase + 16 * db * LDG + 64 * ks);
                    const float gg = lg[db], bb = lb[db];
                    u32x4 o;
                    o.x = cvt_pk_bf16((bf_lo(r.x) - mu[0]) * rs[0] * gg + bb, (bf_hi(r.x) - mu[1]) * rs[1] * gg + bb);
                    o.y = cvt_pk_bf16((bf_lo(r.y) - mu[2]) * rs[2] * gg + bb, (bf_hi(r.y) - mu[3]) * rs[3] * gg + bb);
                    o.z = cvt_pk_bf16((bf_lo(r.z) - mu[4]) * rs[4] * gg + bb, (bf_hi(r.z) - mu[5]) * rs[5] * gg + bb);
                    o.w = cvt_pk_bf16((bf_lo(r.w) - mu[6]) * rs[6] * gg + bb, (bf_hi(r.w) - mu[7]) * rs[7] * gg + bb);
                    Af[db] = __builtin_bit_cast(bf16x8, o);
                }
#pragma unroll
                for (int tb = 0; tb < 4; ++tb) {
                    if (4 * th + tb < 2 * ks) continue;
                    const bf16x8 bfr = Bf[nb++];
#pragma unroll
                    for (int db = 0; db < 4; ++db) acc[db][tb] = __builtin_amdgcn_mfma_f32_16x16x32_bf16(Af[db], bfr, acc[db][tb], 0, 0, 0);
                }
            }
            if (th == 0) {
                asm volatile("" ::: "memory");
                int n = 6;
#pragma unroll
                for (int ks = 0; ks < 4; ++ks)
#pragma unroll
                    for (int tb = 0; tb < 4; ++tb) { if (4 + tb < 2 * ks) continue; Bf[n++] = *(const bf16x8*)(wb + (size_t)(16 * (4 + tb)) * 128 + 32 * ks); }
                asm volatile("" ::: "memory");
            }
#pragma unroll
            for (int tb = 0; tb < 4; ++tb) {
                const float bs = a.in[12][h * 128 + 16 * (4 * th + tb) + fr];
#pragma unroll
                for (int db = 0; db < 4; ++db) {
                    u32x2 o; o.x = cvt_pk_bf16(bf_lo(uu[th][tb][db].x) * (acc[db][tb][0] + bs), bf_hi(uu[th][tb][db].x) * (acc[db][tb][1] + bs));
                    o.y = cvt_pk_bf16(bf_lo(uu[th][tb][db].y) * (acc[db][tb][2] + bs), bf_hi(uu[th][tb][db].y) * (acc[db][tb][3] + bs));
                    *(u32x2*)(obase + (size_t)(16 * (4 * th + tb)) * D + 16 * db) = o;
                }
            }
        }
    }
}

__device__ __forceinline__ void attn_unit(LAS unsigned char* lds, const bf16_t* q, const bf16_t* Km, const bf16_t* Vt, bf16_t* o, int pm, int h, int tid, int wid, int lane) {
    constexpr int LDK = 544, LDV = 528;
    const int fr = lane & 15, fq = lane >> 4, b = pm >> 4, row0 = pm * 256 + wid * 32;
    {
        const bf16_t* kg = Km + (size_t)(b * 256 + (tid >> 5)) * 1024 + h * 256 + (tid & 31) * 8;
        LAS unsigned char* kl = lds + (tid >> 5) * LDK + (tid & 31) * 16;
#pragma unroll
        for (int half = 0; half < 2; ++half) {
            u32x4 kr[8];
#pragma unroll
            for (int i = 0; i < 8; ++i) kr[i] = *(const u32x4*)(kg + (size_t)(half * 8 + i) * 16 * 1024);
#pragma unroll
            for (int i = 0; i < 8; ++i) *(LAS u32x4*)(kl + (half * 8 + i) * 16 * LDK) = kr[i];
        }
    }
    __syncthreads();
    const bf16_t* qbase = q + (size_t)(row0 + fr) * D + h * 256 + 8 * fq;
    bf16x8 Pf[2][8]; float inv[2];
    u32x4 vr[8];
    const bf16_t* vg = Vt + (size_t)(h * 256 + (tid >> 5)) * 1024 + b * 256 + (tid & 31) * 8;
#pragma unroll
    for (int qb = 0; qb < 2; ++qb) {
        if (qb == 1) {
#pragma unroll
            for (int i = 0; i < 8; ++i) vr[i] = *(const u32x4*)(vg + (size_t)i * 16 * 1024);
        }
        bf16x8 Qf[8];
#pragma unroll
        for (int ks = 0; ks < 8; ++ks) Qf[ks] = *(const bf16x8*)(qbase + (size_t)(16 * qb) * D + 32 * ks);
        f32x4 S[16];
#pragma unroll
        for (int kb = 0; kb < 16; ++kb) S[kb] = (f32x4){0.f, 0.f, 0.f, 0.f};
        bf16x8 kf[2][4];
        const LAS unsigned char* kbase = lds + fr * LDK + fq * 16;
#pragma unroll
        for (int k4 = 0; k4 < 4; ++k4) kf[0][k4] = *(const LAS bf16x8*)(kbase + 64 * k4);
#pragma unroll
        for (int it = 0; it < 32; ++it) {
            if (it < 31) {
#pragma unroll
                for (int k4 = 0; k4 < 4; ++k4) kf[(it + 1) & 1][k4] = *(const LAS bf16x8*)(kbase + 16 * ((it + 1) >> 1) * LDK + 64 * (4 * ((it + 1) & 1) + k4));
            }
#pragma unroll
            for (int k4 = 0; k4 < 4; ++k4) S[it >> 1] = __builtin_amdgcn_mfma_f32_16x16x32_bf16(kf[it & 1][k4], Qf[4 * (it & 1) + k4], S[it >> 1], 0, 0, 0);
#pragma unroll
            for (int k4 = 0; k4 < 4; ++k4) { __builtin_amdgcn_sched_group_barrier(0x100, 1, 0); __builtin_amdgcn_sched_group_barrier(0x008, 1, 0); }
            __builtin_amdgcn_sched_barrier(0);
        }
        float mx = -3.0e38f;
#pragma unroll
        for (int kb = 0; kb < 16; ++kb) mx = fmaxf(fmaxf(fmaxf(S[kb][0], S[kb][1]), fmaxf(S[kb][2], S[kb][3])), mx);
        mx = fmaxf(mx, __shfl_xor(mx, 16)); mx = fmaxf(mx, __shfl_xor(mx, 32));
        float sum = 0.f;
#pragma unroll
        for (int kb = 0; kb < 16; ++kb)
#pragma unroll
            for (int j = 0; j < 4; ++j) { const float p = __builtin_amdgcn_exp2f(S[kb][j] - mx); S[kb][j] = p; sum += p; }
        sum += __shfl_xor(sum, 16); sum += __shfl_xor(sum, 32);
        inv[qb] = 1.0f / sum;
#pragma unroll
        for (int ks = 0; ks < 8; ++ks) { const u32x4 w = pack8(S[2 * ks], S[2 * ks + 1]); Pf[qb][ks] = __builtin_bit_cast(bf16x8, w); }
        asm volatile("" ::: "memory");
    }
    __syncthreads();
    {
        LAS unsigned char* vl = lds + (tid >> 5) * LDV + (tid & 31) * 16;
        u32x4 kr[8];
#pragma unroll
        for (int i = 0; i < 8; ++i) kr[i] = *(const u32x4*)(vg + (size_t)(8 + i) * 16 * 1024);
#pragma unroll
        for (int i = 0; i < 8; ++i) *(LAS u32x4*)(vl + i * 16 * LDV) = vr[i];
#pragma unroll
        for (int i = 0; i < 8; ++i) *(LAS u32x4*)(vl + (8 + i) * 16 * LDV) = kr[i];
    }
    __syncthreads();
    const LAS unsigned char* vbase = lds + fr * LDV + fq * 8;
    bf16_t* obase = o + (size_t)(row0 + fr) * D + h * 256 + 4 * fq;
#pragma unroll
    for (int dh = 0; dh < 2; ++dh) {
        f32x4 O[2][8];
#pragma unroll
        for (int qb = 0; qb < 2; ++qb)
#pragma unroll
            for (int db = 0; db < 8; ++db) O[qb][db] = (f32x4){0.f, 0.f, 0.f, 0.f};
        u32x2 vlo[2][4], vhi[2][4];
#pragma unroll
        for (int k4 = 0; k4 < 4; ++k4) { const LAS unsigned char* vp = vbase + 128 * dh * LDV + 64 * k4; vlo[0][k4] = *(const LAS u32x2*)vp; vhi[0][k4] = *(const LAS u32x2*)(vp + 32); }
#pragma unroll
        for (int it = 0; it < 16; ++it) {
            if (it < 15) {
#pragma unroll
                for (int k4 = 0; k4 < 4; ++k4) { const LAS unsigned char* vp = vbase + (128 * dh + 16 * ((it + 1) >> 1)) * LDV + 64 * (4 * ((it + 1) & 1) + k4); vlo[(it + 1) & 1][k4] = *(const LAS u32x2*)vp; vhi[(it + 1) & 1][k4] = *(const LAS u32x2*)(vp + 32); }
            }
#pragma unroll
            for (int k4 = 0; k4 < 4; ++k4) {
                const u32x4 w = {vlo[it & 1][k4].x, vlo[it & 1][k4].y, vhi[it & 1][k4].x, vhi[it & 1][k4].y}; const bf16x8 vf = __builtin_bit_cast(bf16x8, w);
#pragma unroll
                for (int qb = 0; qb < 2; ++qb) O[qb][it >> 1] = __builtin_amdgcn_mfma_f32_16x16x32_bf16(vf, Pf[qb][4 * (it & 1) + k4], O[qb][it >> 1], 0, 0, 0);
            }
#pragma unroll
            for (int k4 = 0; k4 < 4; ++k4) { __builtin_amdgcn_sched_group_barrier(0x100, 2, 0); __builtin_amdgcn_sched_group_barrier(0x008, 2, 0); }
            __builtin_amdgcn_sched_barrier(0);
        }
#pragma unroll
        for (int qb = 0; qb < 2; ++qb)
#pragma unroll
            for (int db = 0; db < 8; ++db) {
                const f32x4 v = O[qb][db] * inv[qb]; u32x2 w; w.x = cvt_pk_bf16(v[0], v[1]); w.y = cvt_pk_bf16(v[2], v[3]);
                *(u32x2*)(obase + (size_t)(16 * qb) * D + 128 * dh + 16 * db) = w;
            }
    }
    __syncthreads();
}

#define PHASE_ARGS const Args& a, LAS unsigned char* lds, unsigned char* ws, int tid, int wid, int lane, int bid, int G
#define PHASE_CALL a, lds, ws, tid, wid, lane, bid, G
constexpr size_t TS1024 = (size_t)256 * 1024 * 2;

__device__ __forceinline__ void phase_p1(PHASE_ARGS) {
    pg8::Sched S{}; S.G = G; S.c = bid; S.tstep = TS1024;
    S.A0 = (const char*)(ws + WS_HN); S.B0 = (const char*)(ws + WS_BT1); S.nM0 = 64; S.nN0 = 4;
    S.A1 = (const char*)(ws + WS_HN); S.B1 = (const char*)(ws + WS_BT1) + (size_t)1024 * 2048; S.nM1 = 64; S.nN1 = 2;
    S.A2 = (const char*)(ws + WS_BT1) + (size_t)1536 * 2048; S.B2 = (const char*)(ws + WS_HN); S.nM2 = 2; S.nN2 = 64;
    EpiP1 E{(bf16_t*)(ws + WS_AGLU), (bf16_t*)(ws + WS_U), (bf16_t*)(ws + WS_GVT), a.in[4]};
    pg8::gemm_phase(lds, 1024, S, E);
}
__device__ __forceinline__ void phase_p2(PHASE_ARGS) {
    conv_unit<64>(a, lds, bid, tid, wid, lane);
    if (bid < 128) {
        gmlp_unit(a, lds, bid, tid, wid, lane);
    } else if (bid < 160) {
        pg8::Sched S{}; S.G = 32; S.c = bid - 128; S.tstep = TS1024;
        S.A0 = (const char*)(ws + WS_MN); S.B0 = (const char*)(ws + WS_WKV); S.nM0 = 4; S.nN0 = 4;
        S.A1 = (const char*)(ws + WS_WKV) + (size_t)1024 * 2048; S.B1 = (const char*)(ws + WS_MN); S.nM1 = 4; S.nN1 = 4;
        EpiKV E{(bf16_t*)(ws + WS_KM), (bf16_t*)(ws + WS_VT)};
        pg8::gemm_phase(lds, 1024, S, E);
    } else {
        late_weights(a, lds, (bid - 160) * 8 + wid, 96 * 8, wid, lane);
    }
}
__device__ __forceinline__ void phase_p3(PHASE_ARGS) {
    pg8::Sched S{}; S.G = G; S.c = bid; S.tstep = TS1024;
    S.A0 = (const char*)(ws + WS_HN); S.B0 = (const char*)(ws + WS_WOUT); S.nM0 = 64; S.nN0 = 4;
    EpiRes<false> E{a.in[0], (bf16_t*)(ws + WS_HB), (float*)(ws + WS_SSQ1)};
    pg8::gemm_phase(lds, 1024, S, E);
}
__device__ __forceinline__ void phase_p4(PHASE_ARGS) {
    pg8::Sched S{}; S.G = 1 << 20; S.c = bid; S.tstep = TS1024;
    S.A0 = (const char*)(ws + WS_HB); S.B0 = (const char*)(ws + WS_WQ); S.nM0 = 64; S.nN0 = 4;
    Unit un; S.next(0, un);
    EpiQ E{(bf16_t*)(ws + WS_Q), (const float*)(ws + WS_SSQ1)};
    pg8::gemm_phase(lds, 1024, S, E);
    asm volatile("s_waitcnt vmcnt(0)" ::: "memory");
    __syncthreads();
    attn_unit(lds, (const bf16_t*)(ws + WS_Q), (const bf16_t*)(ws + WS_KM), (const bf16_t*)(ws + WS_VT), (bf16_t*)(ws + WS_HN), un.pm, un.pn, tid, wid, lane);
}
__device__ __forceinline__ void phase_p5(PHASE_ARGS) {
    pg8::Sched S{}; S.G = G; S.c = bid; S.tstep = TS1024;
    S.A0 = (const char*)(ws + WS_HN); S.B0 = (const char*)(ws + WS_WO); S.nM0 = 64; S.nN0 = 4;
    EpiRes<true> E{nullptr, (bf16_t*)(ws + WS_HB), (float*)(ws + WS_SSQ2)};
    pg8::gemm_phase(lds, 1024, S, E);
}
__device__ __forceinline__ void phase_p6(PHASE_ARGS) {
    pg8::Sched S{}; S.G = G; S.c = bid; S.tstep = TS1024;
    S.A0 = (const char*)(ws + WS_HB); S.B0 = (const char*)(ws + WS_WGU); S.nM0 = 64; S.nN0 = 22;
    EpiGU E{(bf16_t*)(ws + WS_ACT), (const float*)(ws + WS_SSQ2)};
    pg8::gemm_phase(lds, 1024, S, E);
}
__device__ __forceinline__ void phase_p7(PHASE_ARGS) {
    pg8::Sched S{}; S.G = G; S.c = bid; S.tstep = (size_t)256 * FF * 2;
    S.A0 = (const char*)(ws + WS_ACT); S.B0 = (const char*)(ws + WS_WD); S.nM0 = 64; S.nN0 = 4;
    EpiFinal E{(const bf16_t*)(ws + WS_HB), a.out, (float*)(ws + WS_SSQ3), (unsigned*)(ws + WS_CTL + 16384), a.in[22]};
    pg8::gemm_phase(lds, FF, S, E);
}
__global__ void __launch_bounds__(512, 2) fwd_mega(Args a) {
    extern __shared__ __attribute__((aligned(16))) unsigned char lds_raw[];
    LAS unsigned char* lds = (LAS unsigned char*)lds_raw;
    cg::grid_group grid = cg::this_grid();
    const int tid = threadIdx.x, wid = __builtin_amdgcn_readfirstlane(tid >> 6), lane = tid & 63, bid = blockIdx.x, G = gridDim.x;
    unsigned char* ws = a.ws;
    if (tid < 2) ((volatile LAS unsigned*)(lds + LDS_BYTES - 64))[tid] = 0u;
    __syncthreads();
    const XcdBarrier xbar = xcd_barrier_post((unsigned*)(ws + WS_CTL), (volatile LAS unsigned*)(lds + LDS_BYTES - 64));
    if (a.never != 0) grid.sync();
#define GRID_BAR() xcd_barrier(xbar)
    { p0_prologue(a, lds, bid, G, wid, lane); }
    GRID_BAR();
    phase_p1(PHASE_CALL); GRID_BAR();
    { phase_p2(PHASE_CALL);
    } GRID_BAR();
    phase_p3(PHASE_CALL); GRID_BAR();
    { phase_p4(PHASE_CALL); } GRID_BAR();
    { phase_p5(PHASE_CALL); } GRID_BAR();
    phase_p6(PHASE_CALL); GRID_BAR();
    phase_p7(PHASE_CALL);
}

extern "C" void kernel_launch(void* const* d_in, const int* in_sizes, int n_in, void* d_out, int out_size, void* d_ws, size_t ws_size, hipStream_t stream) {
    static int grid = 0;
    if (grid == 0) {
        int dev = 0, cus = 0, per_cu = 0;
        (void)hipGetDevice(&dev);
        (void)hipDeviceGetAttribute(&cus, hipDeviceAttributeMultiprocessorCount, dev);
        (void)hipFuncSetAttribute((const void*)fwd_mega, hipFuncAttributeMaxDynamicSharedMemorySize, LDS_BYTES);
        (void)hipOccupancyMaxActiveBlocksPerMultiprocessor(&per_cu, (const void*)fwd_mega, 512, LDS_BYTES);
        (void)hipGetLastError();
        grid = cus > 0 ? cus : 256;
        if (grid > 256) grid = 256;
    }
    Args a{};
    for (int i = 0; i < 23; ++i) a.in[i] = (const float*)d_in[i];
    a.out = (float*)d_out; a.ws = (unsigned char*)d_ws; a.never = 0ull;
    (void)hipMemsetAsync((char*)d_ws + WS_CTL, 0, CTL_ZERO_BYTES, stream);
    void* args[] = {&a};
    hipError_t e = hipLaunchCooperativeKernel((const void*)fwd_mega, dim3(grid), dim3(512), args, LDS_BYTES, stream);
    if (e != hipSuccess) fprintf(stderr, "cooperative launch failed: %s (grid %d)\n", hipGetErrorString(e), grid);
}
```

```cpp
#include <hip/hip_runtime.h>
#include <hip/hip_cooperative_groups.h>
#include <cstdio>
#include <cstdint>
namespace cg = cooperative_groups;

#define LAS __attribute__((address_space(3)))
typedef unsigned short bf16_t;
typedef short bf16x8 __attribute__((ext_vector_type(8)));
typedef float f32x4 __attribute__((ext_vector_type(4)));
typedef float f32x2 __attribute__((ext_vector_type(2)));
typedef unsigned u32x4 __attribute__((ext_vector_type(4)));
typedef unsigned u32x2 __attribute__((ext_vector_type(2)));

constexpr int D = 1024, NB = 4, SEQ = 4096, M = NB * SEQ, CW = 512, GW = 512, CHUNK = 128, MEML = 256, MR = NB * MEML, FF = 2816;
constexpr float RMS_EPS = 1e-6f, LN_EPS = 1e-5f;
constexpr float LOG2E = 1.4426950408889634f;
constexpr float QSCALE = 0.0625f * LOG2E;

constexpr size_t MiB = 1u << 20;
constexpr size_t WS_BT1 = 0 * MiB;
constexpr size_t WS_WOUT = 4 * MiB;
constexpr size_t WS_WQ = 6 * MiB;
constexpr size_t WS_WKV = 8 * MiB;
constexpr size_t WS_WO = 12 * MiB;
constexpr size_t WS_WGU = 14 * MiB;
constexpr size_t WS_WD = 25 * MiB;
constexpr size_t WS_WSB = 31 * MiB;
constexpr size_t WS_MN = 32 * MiB;
constexpr size_t WS_KM = 34 * MiB;
constexpr size_t WS_VT = 36 * MiB;
constexpr size_t WS_SSQ1 = 38 * MiB, WS_SSQ2 = 39 * MiB, WS_SSQ3 = 40 * MiB;
constexpr size_t WS_HB = 48 * MiB;
constexpr size_t WS_HN = 80 * MiB;
constexpr size_t WS_MIX = 176 * MiB;
constexpr size_t WS_RX = 42 * MiB;
constexpr size_t WS_AGLU = 112 * MiB;
constexpr size_t WS_U = 128 * MiB;
constexpr size_t WS_GVT = 144 * MiB;
constexpr size_t WS_Q = 112 * MiB;
constexpr size_t WS_ACT = 80 * MiB;
constexpr int LDS_BYTES = 147456;


constexpr size_t WS_CTL = 41 * MiB;
constexpr size_t CTL_ZERO_BYTES = 32768;
#define XB_TMO      128
#define XB_XCNT(j)  (256  + 64 * (j))
#define XB_XSUB(j)  (1280 + 64 * (j))
#define XB_XGEN(j)  (2304 + 64 * (j))
#define XB_TOP      3328
#define XB_TOPGEN   3392
#define XB_SPIN_CAP (1u << 18)
__device__ __forceinline__ unsigned xb_ld(unsigned* p)              { return __hip_atomic_load(p, __ATOMIC_RELAXED, __HIP_MEMORY_SCOPE_AGENT); }
__device__ __forceinline__ unsigned xb_add(unsigned* p, unsigned v) { return __hip_atomic_fetch_add(p, v, __ATOMIC_RELAXED, __HIP_MEMORY_SCOPE_AGENT); }
__device__ __forceinline__ unsigned xb_xcc_id() { return (unsigned)__builtin_amdgcn_s_getreg((3 << 11) | 20) & 0xFu; }
#define XB_SPIN(cond, bar) do { unsigned _sp = 0; while (cond) { __builtin_amdgcn_s_sleep(1); \
    if ((++_sp & 255u) == 0u) { if (xb_ld(&(bar)[XB_TMO])) break; if (_sp > XB_SPIN_CAP) { atomicAdd(&(bar)[XB_TMO], 1u); break; } } } } while (0)
struct XcdBarrier { unsigned* bar; unsigned x; volatile LAS unsigned* st; };
__device__ __forceinline__ XcdBarrier xcd_barrier_post(unsigned* bar, volatile LAS unsigned* st) {
    XcdBarrier b; b.bar = bar; b.x = xb_xcc_id(); b.st = st;
    if (threadIdx.x == 0) (void)xb_add(&bar[XB_XCNT(b.x)], 1u);
    return b;
}
__device__ __forceinline__ void xcd_barrier_complete(unsigned* bar, unsigned x, unsigned& nloc, unsigned& nx) {
    const unsigned G = gridDim.x * gridDim.y * gridDim.z;
    unsigned sum, cnt, mine, sp = 0u;
    for (;;) {
        sum = 0u; cnt = 0u; mine = 0u;
#pragma unroll
        for (unsigned j = 0; j < 16; ++j) { const unsigned c = xb_ld(&bar[XB_XCNT(j)]); sum += c; cnt += (c > 0u) ? 1u : 0u; mine = (j == x) ? c : mine; }
        if (sum == G) break;
        __builtin_amdgcn_s_sleep(1);
        if ((++sp & 255u) == 0u) { if (xb_ld(&bar[XB_TMO])) break; if (sp > XB_SPIN_CAP) { atomicAdd(&bar[XB_TMO], 1u); break; } }
    }
    nloc = mine > 0u ? mine : 1u; nx = cnt > 0u ? cnt : 1u;
}
__device__ __forceinline__ void xcd_barrier(const XcdBarrier& b) {
    asm volatile("s_waitcnt vmcnt(0)" ::: "memory");
    __syncthreads();
    if (threadIdx.x == 0) {
        unsigned* bar = b.bar;
        __builtin_amdgcn_s_waitcnt(0);
        unsigned nloc = b.st[0], nx = b.st[1];
        if (nloc == 0u) { xcd_barrier_complete(bar, b.x, nloc, nx); b.st[0] = nloc; b.st[1] = nx; }
        const unsigned old = xb_add(&bar[XB_XSUB(b.x)], 1u);
        const unsigned gen = old / nloc;
        if (old + 1u == (gen + 1u) * nloc) {
            __builtin_amdgcn_fence(__ATOMIC_RELEASE, "agent");
            asm volatile("s_waitcnt vmcnt(0)" ::: "memory");
            const unsigned og = xb_add(&bar[XB_TOP], 1u);
            const unsigned tg = og / nx;
            if (og + 1u == (tg + 1u) * nx) xb_add(&bar[XB_TOPGEN], 1u);
            else XB_SPIN(xb_ld(&bar[XB_TOPGEN]) == tg, bar);
            __builtin_amdgcn_fence(__ATOMIC_ACQUIRE, "agent");
            xb_add(&bar[XB_XGEN(b.x)], 1u);
            asm volatile("s_waitcnt vmcnt(0)" ::: "memory");
        } else {
            XB_SPIN(xb_ld(&bar[XB_XGEN(b.x)]) == gen, bar);
            __builtin_amdgcn_fence(__ATOMIC_ACQUIRE, "agent");
            asm volatile("s_waitcnt vmcnt(0)" ::: "memory");
        }
    }
    __syncthreads();
}

__device__ __forceinline__ unsigned cvt_pk_bf16(float lo, float hi) { unsigned r; asm volatile("v_cvt_pk_bf16_f32 %0, %1, %2" : "=v"(r) : "v"(lo), "v"(hi)); return r; }
__device__ __forceinline__ float bf_lo(unsigned u) { return __uint_as_float(u << 16); }
__device__ __forceinline__ float bf_hi(unsigned u) { return __uint_as_float(u & 0xffff0000u); }
__device__ __forceinline__ float sigmoidf_(float x) { return __builtin_amdgcn_rcpf(1.0f + __builtin_amdgcn_exp2f(-LOG2E * x)); }
__device__ __forceinline__ float siluf_(float x) { return x * sigmoidf_(x); }
__device__ __forceinline__ float geluf_(float x) { const float u = 0.7978845608028654f * (x + 0.044715f * x * x * x); return x * __builtin_amdgcn_rcpf(1.0f + __builtin_amdgcn_exp2f(-2.0f * LOG2E * u)); }
__device__ __forceinline__ f32x2 sigmoid2_(float x0, float x1) {
    const float a = 1.0f + __builtin_amdgcn_exp2f(fminf(-LOG2E * x0, 60.0f)), b = 1.0f + __builtin_amdgcn_exp2f(fminf(-LOG2E * x1, 60.0f));
    const float r = __builtin_amdgcn_rcpf(a * b);
    return (f32x2){r * b, r * a};
}
__device__ __forceinline__ f32x2 gelu2_(float x0, float x1) {
    const float u0 = 1.5957691216057308f * (x0 + 0.044715f * x0 * x0 * x0), u1 = 1.5957691216057308f * (x1 + 0.044715f * x1 * x1 * x1);
    const f32x2 sg = sigmoid2_(u0, u1); return (f32x2){x0 * sg[0], x1 * sg[1]};
}
__device__ __forceinline__ float wave_sum(float v) {
#pragma unroll
    for (int o = 1; o < 64; o <<= 1) v += __shfl_xor(v, o);
    return v;
}
__device__ __forceinline__ u32x4 pack8(f32x4 a, f32x4 b) { u32x4 w; w.x = cvt_pk_bf16(a[0], a[1]); w.y = cvt_pk_bf16(a[2], a[3]); w.z = cvt_pk_bf16(b[0], b[1]); w.w = cvt_pk_bf16(b[2], b[3]); return w; }

namespace pg8 {
constexpr int BM = 256, BK = 64, HALF = 128, HTB = HALF * BK * 2, NXCD = 8, WGM = 8;
__device__ __forceinline__ int lds_byte(int r, int c) { const int st = (r >> 4) * 2 + (c >> 5), rr = r & 15, cc = c & 31, ob = rr * 64 + cc * 2; return st * 1024 + (ob ^ (((ob >> 9) & 1) << 5)); }
__device__ __forceinline__ void stage_rc(int b, int& R, int& C) { const int st = b / 1024, sb = b % 1024, swz = sb ^ (((sb >> 9) & 1) << 5); R = (st >> 1) * 16 + swz / 64; C = (st & 1) * 32 + (swz % 64) / 2; }
__device__ __forceinline__ int perm32(int rho) { const int n = rho >> 4, i = rho & 15; return 8 * (i >> 2) + 4 * n + (i & 3); }

struct Unit { const char* A; const char* B; int pm, pn, kind; };

__device__ __forceinline__ void tile_order(int wgid, int nM, int nN, int& pm, int& pn) {
    const int nwg = nM * nN;
    { const int q = nwg / NXCD, r = nwg % NXCD, xcd = wgid % NXCD, off = wgid / NXCD; wgid = (xcd < r ? xcd * (q + 1) : r * (q + 1) + (xcd - r) * q) + off; }
    const int nig = WGM * nN, gid = wgid / nig, fm = gid * WGM, gsz = (nM - fm) < WGM ? (nM - fm) : WGM;
    pm = fm + ((wgid % nig) % gsz); pn = (wgid % nig) / gsz;
}
struct Sched {
    const char *A0, *B0, *A1, *B1, *A2, *B2; int nM0, nN0, nM1, nN1, nM2, nN2; int G, c; size_t tstep;
    __device__ __forceinline__ bool next(int i, Unit& u) const {
        int L = i * G + c;
        if (L < nM0 * nN0) { tile_order(L, nM0, nN0, u.pm, u.pn); u.A = A0 + (size_t)u.pm * tstep; u.B = B0 + (size_t)u.pn * tstep; u.kind = 0; return true; }
        L -= nM0 * nN0;
        if (L < nM1 * nN1) { tile_order(L, nM1, nN1, u.pm, u.pn); u.A = A1 + (size_t)u.pm * tstep; u.B = B1 + (size_t)u.pn * tstep; u.kind = 1; return true; }
        L -= nM1 * nN1;
        if (L < nM2 * nN2) { tile_order(L, nM2, nN2, u.pm, u.pn); u.A = A2 + (size_t)u.pm * tstep; u.B = B2 + (size_t)u.pn * tstep; u.kind = 2; return true; }
        return false;
    }
};
template <class Epi, class Sch>
__device__ __forceinline__ void gemm_phase(LAS unsigned char* lds, const int K, const Sch& S, const Epi& E) {
    int tid_ = threadIdx.x; asm volatile("" : "+v"(tid_));
    const int tid = tid_, wid = __builtin_amdgcn_readfirstlane(tid >> 6), lane = tid & 63, wr = wid >> 2, wc = wid & 3, fr = lane & 15, fq = lane >> 4;
    const int nt = K / BK;
    unsigned voffA[2], voffB[2];
#pragma unroll
    for (int i = 0; i < 2; ++i) { int R, C; stage_rc(tid * 16 + i * 8192, R, C); const int Rb = (R & ~31) + perm32(R & 31);
        voffA[i] = (unsigned)(R * K + C) * 2u; voffB[i] = (unsigned)(Rb * K + C) * 2u; }
    const size_t kstep = (size_t)(BK * 2);
    const size_t hstep = (size_t)HALF * K * 2;
    const unsigned ldsw = (unsigned)wid * 1024u;
    const int aoff = lds_byte(wr * 64 + fr, fq * 8), boff = lds_byte(wc * 32 + fr, fq * 8);
#define PG8_SA(b, h) (((b) * 2 + (h)) * HTB)
#define PG8_SB(b, h) ((4 + (b) * 2 + (h)) * HTB)
#define PG8_STAGE(bufoff, gbase, voff) do { _Pragma("unroll") for (int _i = 0; _i < 2; ++_i) \
        __builtin_amdgcn_global_load_lds((const unsigned*)((const char*)(gbase) + (voff)[_i]), (LAS unsigned*)(lds + (bufoff) + ldsw + _i * 8192), 16, 0, 0); } while (0)
#define PG8_LDA(dst, b, h) do { _Pragma("unroll") for (int m = 0; m < 4; ++m) _Pragma("unroll") for (int k = 0; k < 2; ++k) dst[m][k] = *(const LAS bf16x8*)(lds + PG8_SA(b, h) + aoff + m * 2048 + k * 1024); } while (0)
#define PG8_LDB(dst, b, h) do { _Pragma("unroll") for (int n = 0; n < 2; ++n) _Pragma("unroll") for (int k = 0; k < 2; ++k) dst[n][k] = *(const LAS bf16x8*)(lds + PG8_SB(b, h) + boff + n * 2048 + k * 1024); } while (0)
#define PG8_MMA(ai, bj, At, Bt) do { __builtin_amdgcn_s_setprio(1); _Pragma("unroll") for (int m = 0; m < 4; ++m) _Pragma("unroll") for (int n = 0; n < 2; ++n) _Pragma("unroll") for (int k = 0; k < 2; ++k) \
        acc[ai][bj][m][n] = __builtin_amdgcn_mfma_f32_16x16x32_bf16(Bt[n][k], At[m][k], acc[ai][bj][m][n], 0, 0, 0); __builtin_amdgcn_s_setprio(0); } while (0)
#define PG8_WAIT_V(n) asm volatile("s_waitcnt vmcnt(" #n ")" ::: "memory")
#define PG8_WAIT_L(n) asm volatile("s_waitcnt lgkmcnt(" #n ")" ::: "memory")
#define PG8_BAR __builtin_amdgcn_s_barrier()
#define PG8_SCHED __builtin_amdgcn_sched_barrier(0)
    Unit cur, nxt; int ui = 0;
    if (!S.next(0, cur)) return;
    f32x4 acc[2][2][4][2];
#pragma unroll
    for (int a = 0; a < 2; ++a)
#pragma unroll
        for (int b = 0; b < 2; ++b)
#pragma unroll
            for (int m = 0; m < 4; ++m)
#pragma unroll
                for (int n = 0; n < 2; ++n) acc[a][b][m][n] = (f32x4){0.f, 0.f, 0.f, 0.f};
    bf16x8 At[4][2], B0[2][2], B1[2][2];
    const char* cA = cur.A; const char* cB = cur.B;
    PG8_STAGE(PG8_SB(0, 0), cB, voffB); PG8_STAGE(PG8_SB(0, 1), cB + hstep, voffB); PG8_STAGE(PG8_SA(0, 0), cA, voffA); PG8_STAGE(PG8_SA(0, 1), cA + hstep, voffA);
    if (wr == 1) PG8_BAR;
    PG8_WAIT_V(2); PG8_BAR;
    PG8_STAGE(PG8_SB(1, 0), cB + kstep, voffB); PG8_STAGE(PG8_SA(1, 0), cA + kstep, voffA); PG8_STAGE(PG8_SB(1, 1), cB + hstep + kstep, voffB);
    PG8_WAIT_V(6); PG8_BAR;
    for (;;) {
        const bool has_next = S.next(ui + 1, nxt);
        const char* nA = has_next ? nxt.A : cA; const char* nB = has_next ? nxt.B : cB;
        for (int t = 0; t < nt; t += 2) {
            const bool last = (t == nt - 2);
            const char* a1 = cA + (size_t)(t + 1) * kstep;
            const char* a2 = last ? nA : cA + (size_t)(t + 2) * kstep; const char* b2 = last ? nB : cB + (size_t)(t + 2) * kstep;
            const char* a3 = a2 + kstep; const char* b3 = b2 + kstep;
            PG8_LDB(B0, 0, 0); PG8_LDB(B1, 0, 1); PG8_SCHED; PG8_LDA(At, 0, 0); PG8_STAGE(PG8_SA(1, 1), a1 + hstep, voffA);
            PG8_WAIT_V(8); PG8_WAIT_L(0); PG8_BAR; PG8_MMA(0, 0, At, B0); PG8_MMA(0, 1, At, B1); PG8_BAR; PG8_SCHED;
            PG8_LDA(At, 0, 1); PG8_STAGE(PG8_SB(0, 0), b2, voffB); PG8_STAGE(PG8_SB(0, 1), b2 + hstep, voffB); PG8_STAGE(PG8_SA(0, 0), a2, voffA);
            PG8_WAIT_V(8); PG8_WAIT_L(0); PG8_BAR; PG8_MMA(1, 0, At, B0); PG8_MMA(1, 1, At, B1); PG8_BAR; PG8_SCHED;
            PG8_LDB(B0, 1, 0); PG8_LDB(B1, 1, 1); PG8_SCHED; PG8_LDA(At, 1, 0); PG8_STAGE(PG8_SA(0, 1), a2 + hstep, voffA);
            PG8_WAIT_V(8); PG8_WAIT_L(0); PG8_BAR; PG8_MMA(0, 0, At, B0); PG8_MMA(0, 1, At, B1); PG8_BAR; PG8_SCHED;
            PG8_LDA(At, 1, 1); PG8_STAGE(PG8_SB(1, 0), b3, voffB); PG8_STAGE(PG8_SB(1, 1), b3 + hstep, voffB); PG8_STAGE(PG8_SA(1, 0), a3, voffA);
            PG8_WAIT_V(8); PG8_WAIT_L(0); PG8_BAR; PG8_MMA(1, 0, At, B0); PG8_MMA(1, 1, At, B1); PG8_BAR; PG8_SCHED;
        }
        if (wr == 0) PG8_BAR;
        E(acc, cur, wr, wc, fr, fq);
        if (!has_next) break;
#pragma unroll
        for (int a = 0; a < 2; ++a)
#pragma unroll
            for (int b = 0; b < 2; ++b)
#pragma unroll
                for (int m = 0; m < 4; ++m)
#pragma unroll
                    for (int n = 0; n < 2; ++n) acc[a][b][m][n] = (f32x4){0.f, 0.f, 0.f, 0.f};
        cur = nxt; cA = nA; cB = nB; ++ui;
        if (wr == 1) PG8_BAR;
    }
    PG8_WAIT_V(0);
    PG8_BAR;
#undef PG8_SA
#undef PG8_SB
#undef PG8_STAGE
#undef PG8_LDA
#undef PG8_LDB
#undef PG8_MMA
#undef PG8_WAIT_V
#undef PG8_WAIT_L
#undef PG8_BAR
#undef PG8_SCHED
}
}
using pg8::Unit;

#define EPI_ROW(ai, m) (un.pm * 256 + (ai) * 128 + wr * 64 + (m) * 16 + fr)
struct EpiP1 {
    bf16_t* aglu; bf16_t* u; bf16_t* gvT; const float* b_in; const float* rx;
    __device__ __forceinline__ void operator()(const f32x4 (&acc)[2][2][4][2], const Unit& un, int wr, int wc, int fr, int fq) const {
        if (un.kind == 0) {
            const int c0 = un.pn * 128 + wc * 32 + 8 * fq;
            f32x4 ba[2], bg[2];
#pragma unroll
            for (int n = 0; n < 2; ++n) { ba[n] = *(const f32x4*)(b_in + c0 + 4 * n); bg[n] = *(const f32x4*)(b_in + 512 + c0 + 4 * n); }
#pragma unroll
            for (int ai = 0; ai < 2; ++ai)
#pragma unroll
                for (int m = 0; m < 4; ++m) {
                    f32x4 v[2]; const float rs = rx[EPI_ROW(ai, m)];
#pragma unroll
                    for (int n = 0; n < 2; ++n) { const f32x4 za = acc[ai][0][m][n] * rs + ba[n], zg = acc[ai][1][m][n] * rs + bg[n];
#pragma unroll
                        for (int j = 0; j < 4; j += 2) { const f32x2 sg = sigmoid2_(zg[j], zg[j + 1]); v[n][j] = za[j] * sg[0]; v[n][j + 1] = za[j + 1] * sg[1]; } }
                    *(u32x4*)(aglu + (size_t)EPI_ROW(ai, m) * CW + c0) = pack8(v[0], v[1]);
                }
        } else if (un.kind == 1) {
#pragma unroll
            for (int bj = 0; bj < 2; ++bj) {
                const int cu = un.pn * 256 + bj * 128 + wc * 32 + 8 * fq;
                f32x4 bb[2];
#pragma unroll
                for (int n = 0; n < 2; ++n) bb[n] = *(const f32x4*)(b_in + 1024 + cu + 4 * n);
#pragma unroll
                for (int ai = 0; ai < 2; ++ai)
#pragma unroll
                    for (int m = 0; m < 4; ++m) {
                        f32x4 v[2]; const float rs = rx[EPI_ROW(ai, m)];
#pragma unroll
                        for (int n = 0; n < 2; ++n) { const f32x4 z = acc[ai][bj][m][n] * rs + bb[n];
#pragma unroll
                            for (int j = 0; j < 4; j += 2) { const f32x2 ge = gelu2_(z[j], z[j + 1]); v[n][j] = ge[0]; v[n][j + 1] = ge[1]; } }
                        *(u32x4*)(u + (size_t)EPI_ROW(ai, m) * GW + cu) = pack8(v[0], v[1]);
                    }
            }
        } else {
            f32x4 rt[2][2];
#pragma unroll
            for (int bj = 0; bj < 2; ++bj)
#pragma unroll
                for (int n = 0; n < 2; ++n) rt[bj][n] = *(const f32x4*)(rx + un.pn * 256 + bj * 128 + wc * 32 + 8 * fq + 4 * n);
#pragma unroll
            for (int ai = 0; ai < 2; ++ai)
#pragma unroll
                for (int m = 0; m < 4; ++m) {
                    const int ch = EPI_ROW(ai, m);
                    const float bb = b_in[1536 + ch];
#pragma unroll
                    for (int bj = 0; bj < 2; ++bj) {
                        const int tok = un.pn * 256 + bj * 128 + wc * 32 + 8 * fq;
                        f32x4 v[2];
#pragma unroll
                        for (int n = 0; n < 2; ++n)
#pragma unroll
                            for (int j = 0; j < 4; j += 2) { const f32x2 ge = gelu2_(acc[ai][bj][m][n][j] * rt[bj][n][j] + bb, acc[ai][bj][m][n][j + 1] * rt[bj][n][j + 1] + bb); v[n][j] = ge[0]; v[n][j + 1] = ge[1]; }
                        *(u32x4*)(gvT + (size_t)ch * M + tok) = pack8(v[0], v[1]);
                    }
                }
        }
    }
};
struct EpiKV {
    bf16_t* o0; bf16_t* o1;
    __device__ __forceinline__ void operator()(const f32x4 (&acc)[2][2][4][2], const Unit& un, int wr, int wc, int fr, int fq) const {
        bf16_t* o = un.kind == 0 ? o0 : o1;
#pragma unroll
        for (int ai = 0; ai < 2; ++ai)
#pragma unroll
            for (int m = 0; m < 4; ++m)
#pragma unroll
                for (int bj = 0; bj < 2; ++bj)
                    *(u32x4*)(o + (size_t)EPI_ROW(ai, m) * 1024 + un.pn * 256 + bj * 128 + wc * 32 + 8 * fq) = pack8(acc[ai][bj][m][0], acc[ai][bj][m][1]);
    }
};
template <bool RES_BF16> struct EpiRes {
    const bf16_t* resb; bf16_t* hb; float* ssq;
    __device__ __forceinline__ void operator()(const f32x4 (&acc)[2][2][4][2], const Unit& un, int wr, int wc, int fr, int fq) const {
        const size_t off0 = (size_t)(un.pm * 256 + wr * 64 + fr) * D + un.pn * 256 + wc * 32 + 8 * fq;
        if (RES_BF16) {
            u32x4 hv[2][4][2];
#pragma unroll
            for (int ai = 0; ai < 2; ++ai)
#pragma unroll
                for (int m = 0; m < 4; ++m)
#pragma unroll
                    for (int bj = 0; bj < 2; ++bj) hv[ai][m][bj] = *(const u32x4*)(resb + off0 + (size_t)(ai * 128 + m * 16) * D + bj * 128);
#pragma unroll
            for (int ai = 0; ai < 2; ++ai)
#pragma unroll
                for (int m = 0; m < 4; ++m) {
                    float ss = 0.f;
#pragma unroll
                    for (int bj = 0; bj < 2; ++bj) {
                        const u32x4 h4 = hv[ai][m][bj];
                        const f32x4 v0 = acc[ai][bj][m][0] + (f32x4){bf_lo(h4.x), bf_hi(h4.x), bf_lo(h4.y), bf_hi(h4.y)}, v1 = acc[ai][bj][m][1] + (f32x4){bf_lo(h4.z), bf_hi(h4.z), bf_lo(h4.w), bf_hi(h4.w)};
                        *(u32x4*)(hb + off0 + (size_t)(ai * 128 + m * 16) * D + bj * 128) = pack8(v0, v1);
                        ss += (v0[0] * v0[0] + v0[1] * v0[1]) + (v0[2] * v0[2] + v0[3] * v0[3]) + (v1[0] * v1[0] + v1[1] * v1[1]) + (v1[2] * v1[2] + v1[3] * v1[3]);
                    }
                    ss += __shfl_xor(ss, 16); ss += __shfl_xor(ss, 32);
                    if (fq == 0) ssq[(size_t)EPI_ROW(ai, m) * 16 + un.pn * 4 + wc] = ss;
                }
        } else {
#pragma unroll
            for (int aim = 0; aim < 4; ++aim) {
                const int ai = aim >> 1;
                f32x4 rv[4][2][2];
#pragma unroll
                for (int m = 2 * (aim & 1); m < 2 * (aim & 1) + 2; ++m)
#pragma unroll
                    for (int bj = 0; bj < 2; ++bj) { const float* p = (const float*)resb + off0 + (size_t)(ai * 128 + m * 16) * D + bj * 128; rv[m][bj][0] = *(const f32x4*)p; rv[m][bj][1] = *(const f32x4*)(p + 4); }
#pragma unroll
                for (int m = 2 * (aim & 1); m < 2 * (aim & 1) + 2; ++m) {
                    float ss = 0.f;
#pragma unroll
                    for (int bj = 0; bj < 2; ++bj) {
                        const f32x4 v0 = acc[ai][bj][m][0] + rv[m][bj][0], v1 = acc[ai][bj][m][1] + rv[m][bj][1];
                        *(u32x4*)(hb + off0 + (size_t)(ai * 128 + m * 16) * D + bj * 128) = pack8(v0, v1);
                        ss += (v0[0] * v0[0] + v0[1] * v0[1]) + (v0[2] * v0[2] + v0[3] * v0[3]) + (v1[0] * v1[0] + v1[1] * v1[1]) + (v1[2] * v1[2] + v1[3] * v1[3]);
                    }
                    ss += __shfl_xor(ss, 16); ss += __shfl_xor(ss, 32);
                    if (fq == 0) ssq[(size_t)EPI_ROW(ai, m) * 16 + un.pn * 4 + wc] = ss;
                }
                asm volatile("" ::: "memory");
            }
        }
    }
};
struct EpiFinal {
    const bf16_t* hb; float* out; float* ssqp; unsigned* cnt; const float* g;
    __device__ __forceinline__ void operator()(f32x4 (&acc)[2][2][4][2], const Unit& un, int wr, int wc, int fr, int fq) const {
        const size_t off0 = (size_t)(un.pm * 256 + wr * 64 + fr) * D + un.pn * 256 + wc * 32 + 8 * fq;
        {
            u32x4 hv[2][4][2];
#pragma unroll
            for (int ai = 0; ai < 2; ++ai)
#pragma unroll
                for (int m = 0; m < 4; ++m)
#pragma unroll
                    for (int bj = 0; bj < 2; ++bj) hv[ai][m][bj] = *(const u32x4*)(hb + off0 + (size_t)(ai * 128 + m * 16) * D + bj * 128);
#pragma unroll
            for (int ai = 0; ai < 2; ++ai)
#pragma unroll
                for (int m = 0; m < 4; ++m) {
                    float ss = 0.f;
#pragma unroll
                    for (int bj = 0; bj < 2; ++bj) {
                        const u32x4 h4 = hv[ai][m][bj];
                        const f32x4 v0 = acc[ai][bj][m][0] + (f32x4){bf_lo(h4.x), bf_hi(h4.x), bf_lo(h4.y), bf_hi(h4.y)}, v1 = acc[ai][bj][m][1] + (f32x4){bf_lo(h4.z), bf_hi(h4.z), bf_lo(h4.w), bf_hi(h4.w)};
                        acc[ai][bj][m][0] = v0; acc[ai][bj][m][1] = v1;
                        ss += (v0[0] * v0[0] + v0[1] * v0[1]) + (v0[2] * v0[2] + v0[3] * v0[3]) + (v1[0] * v1[0] + v1[1] * v1[1]) + (v1[2] * v1[2] + v1[3] * v1[3]);
                    }
                    ss += __shfl_xor(ss, 16); ss += __shfl_xor(ss, 32);
                    if (fq == 0) __hip_atomic_store(ssqp + ((size_t)un.pn * M + EPI_ROW(ai, m)) * 4 + wc, ss, __ATOMIC_RELAXED, __HIP_MEMORY_SCOPE_AGENT);
                }
        }
        asm volatile("s_waitcnt vmcnt(0)" ::: "memory");
        if ((threadIdx.x & 63) == 0) __hip_atomic_fetch_add(cnt + 64 * un.pm, 1u, __ATOMIC_RELAXED, __HIP_MEMORY_SCOPE_AGENT);
        f32x4 gg[2][2];
#pragma unroll
        for (int bj = 0; bj < 2; ++bj)
#pragma unroll
            for (int n = 0; n < 2; ++n) gg[bj][n] = *(const f32x4*)(g + un.pn * 256 + bj * 128 + wc * 32 + 8 * fq + 4 * n);
        if (wr == 0 && wc == 0) {
            unsigned sp = 0;
            while ((unsigned)__builtin_amdgcn_readfirstlane(__hip_atomic_load(cnt + 64 * un.pm, __ATOMIC_RELAXED, __HIP_MEMORY_SCOPE_AGENT)) < 32u) { __builtin_amdgcn_s_sleep(2); if (++sp > (1u << 22)) break; }
            __builtin_amdgcn_fence(__ATOMIC_ACQUIRE, "agent");
        }
        asm volatile("s_waitcnt vmcnt(0) lgkmcnt(0)" ::: "memory"); __builtin_amdgcn_s_barrier(); asm volatile("" ::: "memory");
        float rr[2][4];
        {
            unsigned long long p0[2][4], p1[2][4];
#pragma unroll
            for (int ai = 0; ai < 2; ++ai)
#pragma unroll
                for (int m = 0; m < 4; ++m) { const unsigned long long* sp8 = (const unsigned long long*)(ssqp + ((size_t)fq * M + EPI_ROW(ai, m)) * 4);
                    p0[ai][m] = __hip_atomic_load(sp8, __ATOMIC_RELAXED, __HIP_MEMORY_SCOPE_AGENT); p1[ai][m] = __hip_atomic_load(sp8 + 1, __ATOMIC_RELAXED, __HIP_MEMORY_SCOPE_AGENT); }
#pragma unroll
            for (int ai = 0; ai < 2; ++ai)
#pragma unroll
                for (int m = 0; m < 4; ++m) {
                    float t = (__uint_as_float((unsigned)p0[ai][m]) + __uint_as_float((unsigned)(p0[ai][m] >> 32))) + (__uint_as_float((unsigned)p1[ai][m]) + __uint_as_float((unsigned)(p1[ai][m] >> 32)));
                    t += __shfl_xor(t, 16); t += __shfl_xor(t, 32);
                    rr[ai][m] = 1.0f / sqrtf(t * (1.0f / D) + RMS_EPS);
                }
        }
#pragma unroll
        for (int ai = 0; ai < 2; ++ai)
#pragma unroll
            for (int m = 0; m < 4; ++m) {
                const float r = rr[ai][m];
#pragma unroll
                for (int bj = 0; bj < 2; ++bj) {
                    float* op = out + off0 + (size_t)(ai * 128 + m * 16) * D + bj * 128;
                    *(f32x4*)op = acc[ai][bj][m][0] * r * gg[bj][0]; *(f32x4*)(op + 4) = acc[ai][bj][m][1] * r * gg[bj][1];
                }
            }
    }
};
__device__ __forceinline__ float row_rs(const float* ssq, int row, int fq) {
    const f32x4 p = *(const f32x4*)(ssq + (size_t)row * 16 + 4 * fq);
    float s = (p[0] + p[1]) + (p[2] + p[3]); s += __shfl_xor(s, 16); s += __shfl_xor(s, 32);
    return __builtin_amdgcn_rsqf(s * (1.0f / D) + RMS_EPS);
}
struct EpiQ {
    bf16_t* q; const float* ssq;
    __device__ __forceinline__ void operator()(const f32x4 (&acc)[2][2][4][2], const Unit& un, int wr, int wc, int fr, int fq) const {
#pragma unroll
        for (int ai = 0; ai < 2; ++ai)
#pragma unroll
            for (int m = 0; m < 4; ++m) {
                const int row = EPI_ROW(ai, m); const float r = row_rs(ssq, row, fq) * QSCALE;
#pragma unroll
                for (int bj = 0; bj < 2; ++bj)
                    *(u32x4*)(q + (size_t)row * D + un.pn * 256 + bj * 128 + wc * 32 + 8 * fq) = pack8(acc[ai][bj][m][0] * r, acc[ai][bj][m][1] * r);
            }
    }
};
struct EpiGU {
    bf16_t* act; const float* ssq;
    __device__ __forceinline__ void operator()(const f32x4 (&acc)[2][2][4][2], const Unit& un, int wr, int wc, int fr, int fq) const {
#pragma unroll
        for (int ai = 0; ai < 2; ++ai)
#pragma unroll
            for (int m = 0; m < 4; ++m) {
                const int row = EPI_ROW(ai, m); const float r = row_rs(ssq, row, fq);
                f32x4 v[2];
#pragma unroll
                for (int n = 0; n < 2; ++n)
#pragma unroll
                    for (int j = 0; j < 4; j += 2) { const float g0 = acc[ai][0][m][n][j] * r, g1 = acc[ai][0][m][n][j + 1] * r; const f32x2 sg = sigmoid2_(g0, g1);
                        v[n][j] = g0 * sg[0] * (acc[ai][1][m][n][j] * r); v[n][j + 1] = g1 * sg[1] * (acc[ai][1][m][n][j + 1] * r); }
                *(u32x4*)(act + (size_t)row * FF + un.pn * 128 + wc * 32 + 8 * fq) = pack8(v[0], v[1]);
            }
    }
};

__device__ __forceinline__ void p0_transpose_item(const float* W, int N, bf16_t* WT, int K, int dest_row0, const float* gk, LAS float* scr, int k0, int n0, int lane) {
    float v[32];
    const float* wp = W + (size_t)(k0 + (lane >> 5)) * N + n0 + (lane & 31);
#pragma unroll
    for (int i = 0; i < 32; ++i) v[i] = wp[(size_t)(2 * i) * N];
    if (gk) {
        const float gv = gk[k0 + lane];
#pragma unroll
        for (int i = 0; i < 32; ++i) v[i] *= __shfl(gv, 2 * i + (lane >> 5));
    }
#pragma unroll
    for (int i = 0; i < 32; ++i) scr[(2 * i + (lane >> 5)) * 33 + (lane & 31)] = v[i];
    asm volatile("s_waitcnt lgkmcnt(0)" ::: "memory");
    const int c = lane & 7;
#pragma unroll
    for (int j = 0; j < 4; ++j) { const int n = (lane >> 3) + 8 * j; const LAS float* s = scr + (8 * c) * 33 + n;
        u32x4 o; o.x = cvt_pk_bf16(s[0 * 33], s[1 * 33]); o.y = cvt_pk_bf16(s[2 * 33], s[3 * 33]); o.z = cvt_pk_bf16(s[4 * 33], s[5 * 33]); o.w = cvt_pk_bf16(s[6 * 33], s[7 * 33]);
        *(u32x4*)(WT + (size_t)(dest_row0 + n) * K + k0 + 8 * c) = o; }
    asm volatile("s_waitcnt lgkmcnt(0)" ::: "memory");
}
__device__ __forceinline__ void rms_row_to_bf16(const float* xrow, const float* g, bf16_t* orow, int lane) {
    const f32x4* xr = (const f32x4*)xrow + lane; const f32x4* gr = (const f32x4*)g + lane;
    f32x4 v[4]; float s = 0.f;
#pragma unroll
    for (int j = 0; j < 4; ++j) { v[j] = xr[64 * j]; s += (v[j][0] * v[j][0] + v[j][1] * v[j][1]) + (v[j][2] * v[j][2] + v[j][3] * v[j][3]); }
    const float r = 1.0f / sqrtf(wave_sum(s) * (1.0f / D) + RMS_EPS);
    u32x2* o8 = (u32x2*)orow + lane;
#pragma unroll
    for (int j = 0; j < 4; ++j) { const f32x4 gg = gr[64 * j]; u32x2 w; w.x = cvt_pk_bf16(v[j][0] * r * gg[0], v[j][1] * r * gg[1]); w.y = cvt_pk_bf16(v[j][2] * r * gg[2], v[j][3] * r * gg[3]); o8[64 * j] = w; }
}

struct Args { const float* in[23]; float* out; unsigned char* ws; unsigned long long never; };

__device__ __forceinline__ void rms_row2_to_bf16(const float* xrow, const float* g, bf16_t* orow, int lane) {
    const f32x4* xr = (const f32x4*)xrow + lane; const f32x4* gr = (const f32x4*)g + lane;
    f32x4 v[8]; float s0 = 0.f, s1 = 0.f;
#pragma unroll
    for (int j = 0; j < 8; ++j) v[j] = xr[64 * j];
#pragma unroll
    for (int j = 0; j < 4; ++j) { s0 += (v[j][0] * v[j][0] + v[j][1] * v[j][1]) + (v[j][2] * v[j][2] + v[j][3] * v[j][3]); s1 += (v[4 + j][0] * v[4 + j][0] + v[4 + j][1] * v[4 + j][1]) + (v[4 + j][2] * v[4 + j][2] + v[4 + j][3] * v[4 + j][3]); }
    const float r0 = 1.0f / sqrtf(wave_sum(s0) * (1.0f / D) + RMS_EPS), r1 = 1.0f / sqrtf(wave_sum(s1) * (1.0f / D) + RMS_EPS);
    u32x2* o8 = (u32x2*)orow + lane;
#pragma unroll
    for (int j = 0; j < 4; ++j) { const f32x4 gg = gr[64 * j]; u32x2 w;
        w.x = cvt_pk_bf16(v[j][0] * r0 * gg[0], v[j][1] * r0 * gg[1]); w.y = cvt_pk_bf16(v[j][2] * r0 * gg[2], v[j][3] * r0 * gg[3]); o8[64 * j] = w;
        w.x = cvt_pk_bf16(v[4 + j][0] * r1 * gg[0], v[4 + j][1] * r1 * gg[1]); w.y = cvt_pk_bf16(v[4 + j][2] * r1 * gg[2], v[4 + j][3] * r1 * gg[3]); o8[256 + 64 * j] = w; }
}
__device__ __forceinline__ void rms_row4_to_bf16(const float* xrow, const float* g, bf16_t* orow, int lane) {
    const f32x4* xr = (const f32x4*)xrow + lane; const f32x4* gr = (const f32x4*)g + lane;
    f32x4 v[16]; float ss[4];
#pragma unroll
    for (int j = 0; j < 16; ++j) v[j] = xr[64 * j];
#pragma unroll
    for (int r = 0; r < 4; ++r) { float s = 0.f;
#pragma unroll
        for (int j = 0; j < 4; ++j) s += (v[4 * r + j][0] * v[4 * r + j][0] + v[4 * r + j][1] * v[4 * r + j][1]) + (v[4 * r + j][2] * v[4 * r + j][2] + v[4 * r + j][3] * v[4 * r + j][3]);
        ss[r] = s; }
#pragma unroll
    for (int o = 1; o < 64; o <<= 1) {
#pragma unroll
        for (int r = 0; r < 4; ++r) ss[r] += __shfl_xor(ss[r], o); }
    u32x2* o8 = (u32x2*)orow + lane;
#pragma unroll
    for (int j = 0; j < 4; ++j) { const f32x4 gg = gr[64 * j];
#pragma unroll
        for (int r = 0; r < 4; ++r) { const float rr = 1.0f / sqrtf(ss[r] * (1.0f / D) + RMS_EPS); const f32x4 x = v[4 * r + j]; u32x2 w;
            w.x = cvt_pk_bf16(x[0] * rr * gg[0], x[1] * rr * gg[1]); w.y = cvt_pk_bf16(x[2] * rr * gg[2], x[3] * rr * gg[3]); o8[256 * r + 64 * j] = w; } }
}
__device__ __forceinline__ void x_row4_to_bf16(const float* xrow, bf16_t* orow, float* rx, int lane) {
    const f32x4* xr = (const f32x4*)xrow + lane;
    f32x4 v[16]; float ss[4];
#pragma unroll
    for (int j = 0; j < 16; ++j) v[j] = xr[64 * j];
    u32x2* o8 = (u32x2*)orow + lane;
#pragma unroll
    for (int r = 0; r < 4; ++r) { float s = 0.f;
#pragma unroll
        for (int j = 0; j < 4; ++j) { const f32x4 x = v[4 * r + j]; s += (x[0] * x[0] + x[1] * x[1]) + (x[2] * x[2] + x[3] * x[3]);
            u32x2 w; w.x = cvt_pk_bf16(x[0], x[1]); w.y = cvt_pk_bf16(x[2], x[3]); o8[256 * r + 64 * j] = w; }
        ss[r] = s; }
#pragma unroll
    for (int o = 1; o < 64; o <<= 1) {
#pragma unroll
        for (int r = 0; r < 4; ++r) ss[r] += __shfl_xor(ss[r], o); }
    if (lane < 4) rx[lane] = 1.0f / sqrtf((lane == 0 ? ss[0] : lane == 1 ? ss[1] : lane == 2 ? ss[2] : ss[3]) * (1.0f / D) + RMS_EPS);
}
__device__ __forceinline__ void p0_prologue(const Args& a, LAS unsigned char* lds, int bid, int G, int wid, int lane) {
    LAS float* scr = (LAS float*)(lds + wid * 16384);
    const int gw = bid * 8 + wid, NGW = G * 8;
    unsigned char* ws = a.ws;
    constexpr int I0 = 16 * 64, I1 = 16 * 32, I3 = 16 * 64;
    constexpr int NITEMS = I0 + I1 + I3;
    for (int it = gw; it < NITEMS; it += NGW) {
        int r = it;
        if (r < I0) { const int nb = r % 64, kb = r / 64, n0 = nb * 32; int dr = n0;
            if (n0 < 1024) { const int half = n0 / 512, c = n0 % 512; dr = 256 * (c / 128) + 128 * half + (c % 128); }
            p0_transpose_item(a.in[3], 2048, (bf16_t*)(ws + WS_BT1), 1024, dr, a.in[2], scr, kb * 64, n0, lane); continue; } r -= I0;
        if (r < I1) { p0_transpose_item(a.in[13], 1024, (bf16_t*)(ws + WS_WOUT), 1024, (r % 32) * 32, nullptr, scr, (r / 32) * 64, (r % 32) * 32, lane); continue; } r -= I1;
        p0_transpose_item(a.in[17], 2048, (bf16_t*)(ws + WS_WKV), 1024, (r % 64) * 32, nullptr, scr, (r / 64) * 64, (r % 64) * 32, lane);
    }
    for (int m = 4 * gw; m < M; m += 4 * NGW) x_row4_to_bf16(a.in[0] + (size_t)m * D, (bf16_t*)(ws + WS_HN) + (size_t)m * D, (float*)(ws + WS_RX) + m, lane);
    for (int m = gw; m < MR; m += NGW) rms_row_to_bf16(a.in[1] + (size_t)m * D, a.in[15], (bf16_t*)(ws + WS_MN) + (size_t)m * D, lane);
    for (int rr = gw; rr < 8 * 128; rr += NGW) {
        const int t = rr & 127; const f32x2 wv = *(const f32x2*)(a.in[11] + (size_t)rr * 128 + 2 * lane);
        ((unsigned*)(ws + WS_WSB))[(size_t)rr * 64 + lane] = cvt_pk_bf16(2 * lane <= t ? wv[0] : 0.f, 2 * lane + 1 <= t ? wv[1] : 0.f);
    }
}
struct LwItem { const float* wp; const float* gk; bf16_t* wt; int N, K, k0; };
__device__ __forceinline__ LwItem lw_decode(const Args& a, unsigned char* ws, int it, int lane) {
    constexpr int I2 = 16 * 32, I4 = 16 * 32, I5 = 16 * 176;
    const float* W; const float* gk = nullptr; bf16_t* WT; int N, K = 1024, k0, n0, dr;
    if (it < I2) { W = a.in[16]; gk = a.in[14]; WT = (bf16_t*)(ws + WS_WQ); N = 1024; k0 = (it / 32) * 64; n0 = (it % 32) * 32; dr = n0; }
    else if (it < I2 + I4) { const int r = it - I2; W = a.in[18]; WT = (bf16_t*)(ws + WS_WO); N = 1024; k0 = (r / 32) * 64; n0 = (r % 32) * 32; dr = n0; }
    else if (it < I2 + I4 + I5) { const int r = it - I2 - I4; W = a.in[20]; gk = a.in[19]; WT = (bf16_t*)(ws + WS_WGU); N = 2 * FF; k0 = (r / 176) * 64; n0 = (r % 176) * 32;
        const int half = n0 / FF, c = n0 % FF; dr = 256 * (c / 128) + 128 * half + (c % 128); }
    else { const int r = it - I2 - I4 - I5; W = a.in[21]; WT = (bf16_t*)(ws + WS_WD); N = 1024; K = FF; k0 = (r / 32) * 64; n0 = (r % 32) * 32; dr = n0; }
    LwItem d; d.wp = W + (size_t)(k0 + (lane >> 5)) * N + n0 + (lane & 31); d.gk = gk; d.wt = WT + (size_t)dr * K + k0; d.N = N; d.K = K; d.k0 = k0; return d;
}
__device__ __forceinline__ void late_weights(const Args& a, LAS unsigned char* lds, int gw, int NGW, int wid, int lane) {
    LAS float* scr = (LAS float*)(lds + wid * 16384);
    unsigned char* ws = a.ws;
    constexpr int NITEMS = 16 * 32 + 16 * 32 + 16 * 176 + 44 * 32;
    if (gw >= NITEMS) return;
    LwItem cur = lw_decode(a, ws, gw, lane);
    float v[32];
#pragma unroll
    for (int i = 0; i < 32; ++i) v[i] = cur.wp[(size_t)(2 * i) * cur.N];
    for (int it = gw; it < NITEMS; it += NGW) {
        const bool has_next = it + NGW < NITEMS;
        LwItem nxt = cur; float nv[32];
        if (has_next) { nxt = lw_decode(a, ws, it + NGW, lane);
#pragma unroll
            for (int i = 0; i < 32; ++i) nv[i] = nxt.wp[(size_t)(2 * i) * nxt.N]; }
        if (cur.gk) { const float gv = cur.gk[cur.k0 + lane];
#pragma unroll
            for (int i = 0; i < 32; ++i) v[i] *= __shfl(gv, 2 * i + (lane >> 5)); }
#pragma unroll
        for (int i = 0; i < 32; ++i) scr[(2 * i + (lane >> 5)) * 33 + (lane & 31)] = v[i];
        asm volatile("s_waitcnt lgkmcnt(0)" ::: "memory");
        const int c = lane & 7;
#pragma unroll
        for (int j = 0; j < 4; ++j) { const int n = (lane >> 3) + 8 * j; const LAS float* sp = scr + (8 * c) * 33 + n;
            u32x4 o; o.x = cvt_pk_bf16(sp[0 * 33], sp[1 * 33]); o.y = cvt_pk_bf16(sp[2 * 33], sp[3 * 33]); o.z = cvt_pk_bf16(sp[4 * 33], sp[5 * 33]); o.w = cvt_pk_bf16(sp[6 * 33], sp[7 * 33]);
            *(u32x4*)(cur.wt + (size_t)n * cur.K + 8 * c) = o; }
        asm volatile("s_waitcnt lgkmcnt(0)" ::: "memory");
        if (has_next) {
#pragma unroll
            for (int i = 0; i < 32; ++i) v[i] = nv[i];
            cur = nxt; }
    }
}

template <int NT> __device__ __forceinline__ void conv_unit(const Args& a, LAS unsigned char* lds, int unit, int tid, int wid, int lane) {
    unsigned char* ws = a.ws;
    const bf16_t* aglu = (const bf16_t*)(ws + WS_AGLU); const bf16_t* ub = (const bf16_t*)(ws + WS_U); const bf16_t* gvT = (const bf16_t*)(ws + WS_GVT);
    const bf16_t* wsb = (const bf16_t*)(ws + WS_WSB); bf16_t* mix = (bf16_t*)(ws + WS_MIX);
    const int t0 = unit * NT, p0 = t0 & (SEQ - 1);
    constexpr int HT = NT / 2, NB = NT / 16;
    {
        const int cp = tid & 255, th = tid >> 8;
        f32x2 w[31];
#pragma unroll
        for (int k = 0; k < 31; ++k) w[k] = *(const f32x2*)(a.in[5] + k * CW + 2 * cp);
        const f32x2 cb = *(const f32x2*)(a.in[6] + 2 * cp);
        const int base = t0 + HT * th;
        const int pbase = p0 + HT * th;
        const unsigned* arow = (const unsigned*)aglu + cp;
        f32x2 win[38];
#pragma unroll
        for (int i = 0; i < 30; ++i) { const bool ok = (pbase - 30 + i) >= 0; const unsigned v = ok ? arow[(size_t)(base - 30 + i) * 256] : 0u; win[i] = (f32x2){bf_lo(v), bf_hi(v)}; }
        unsigned nx[8], nx2[8];
#pragma unroll
        for (int i = 0; i < 8; ++i) nx[i] = arow[(size_t)(base + i) * 256];
#pragma unroll
        for (int i = 0; i < 8; ++i) nx2[i] = arow[(size_t)(base + 8 + i) * 256];
        for (int blk = 0; blk < NB; ++blk) {
#pragma unroll
            for (int i = 0; i < 8; ++i) win[30 + i] = (f32x2){bf_lo(nx[i]), bf_hi(nx[i])};
#pragma unroll
            for (int i = 0; i < 8; ++i) nx[i] = nx2[i];
            if (blk < NB - 2) {
#pragma unroll
                for (int i = 0; i < 8; ++i) nx2[i] = arow[(size_t)(base + 8 * (blk + 2) + i) * 256];
            }
#pragma unroll
            for (int o = 0; o < 8; ++o) {
                f32x2 s = cb;
#pragma unroll
                for (int k = 0; k < 31; ++k) s += w[k] * win[o + k];
                *(LAS unsigned*)(lds + (size_t)(HT * th + 8 * blk + o) * 1024 + cp * 4) = cvt_pk_bf16(s[0], s[1]);
            }
#pragma unroll
            for (int i = 0; i < 30; ++i) win[i] = win[i + 8];
        }
    }
    __syncthreads();
    {
        f32x4 g0 = *(const f32x4*)(a.in[7] + 8 * lane), g1 = *(const f32x4*)(a.in[7] + 8 * lane + 4);
        f32x4 b0 = *(const f32x4*)(a.in[8] + 8 * lane), b1 = *(const f32x4*)(a.in[8] + 8 * lane + 4);
        for (int i = 0; i < NT / 8; ++i) {
            const int tok = wid * (NT / 8) + i;
            const u32x4 raw = *(const LAS u32x4*)(lds + (size_t)tok * 1024 + lane * 16);
            f32x4 x0 = {bf_lo(raw.x), bf_hi(raw.x), bf_lo(raw.y), bf_hi(raw.y)}, x1 = {bf_lo(raw.z), bf_hi(raw.z), bf_lo(raw.w), bf_hi(raw.w)};
            const float mean = wave_sum((x0[0] + x0[1]) + (x0[2] + x0[3]) + (x1[0] + x1[1]) + (x1[2] + x1[3])) * (1.0f / CW);
            x0 = x0 - mean; x1 = x1 - mean;
            const float var = wave_sum((x0[0] * x0[0] + x0[1] * x0[1]) + (x0[2] * x0[2] + x0[3] * x0[3]) + (x1[0] * x1[0] + x1[1] * x1[1]) + (x1[2] * x1[2] + x1[3] * x1[3])) * (1.0f / CW);
            const float rstd = 1.0f / sqrtf(var + LN_EPS);
            f32x4 y0 = x0 * rstd * g0 + b0, y1 = x1 * rstd * g1 + b1;
#pragma unroll
            for (int j = 0; j < 4; ++j) { y0[j] = siluf_(y0[j]); y1[j] = siluf_(y1[j]); }
            *(u32x4*)(mix + (size_t)(t0 + tok) * D + 8 * lane) = pack8(y0, y1);
        }
    }
    __syncthreads();
}
__device__ __forceinline__ void gmlp_unit(const Args& a, LAS unsigned char* lds, int chunk, int tid, int wid, int lane) {
    unsigned char* ws = a.ws;
    const bf16_t* ub = (const bf16_t*)(ws + WS_U); const bf16_t* gvT = (const bf16_t*)(ws + WS_GVT);
    const bf16_t* wsb = (const bf16_t*)(ws + WS_WSB); bf16_t* mix = (bf16_t*)(ws + WS_MIX);
    const int t0 = chunk * CHUNK;
    constexpr int LDG = 264;
    LAS unsigned char* part = lds + 512 * LDG;
    LAS f32x2* stat = (LAS f32x2*)(lds + 512 * LDG + 8192);
    const int h = wid, fr = lane & 15, fq = lane >> 4;
    bf16x8 Bf[20];
    const bf16_t* wb = wsb + (size_t)(h * 128 + fr) * 128 + 8 * fq;
    {
        int n = 0;
#pragma unroll
        for (int ks = 0; ks < 2; ++ks)
#pragma unroll
            for (int tb = 0; tb < 4; ++tb) { if (tb < 2 * ks) continue; Bf[n++] = *(const bf16x8*)(wb + (size_t)(16 * tb) * 128 + 32 * ks); }
    }
    const bf16_t* ubase = ub + (size_t)(t0 + fr) * GW + 64 * h + 4 * fq;
    u32x2 uu[2][4][4];
#pragma unroll
    for (int tb = 0; tb < 4; ++tb)
#pragma unroll
        for (int db = 0; db < 4; ++db) uu[0][tb][db] = *(const u32x2*)(ubase + (size_t)(16 * tb) * GW + 16 * db);
    {
        const bf16_t* gp = gvT + (size_t)(tid >> 4) * M + t0 + (tid & 15) * 8;
        LAS unsigned char* lp = lds + (tid >> 4) * LDG + (tid & 15) * 16;
        u32x4 tr[16];
#pragma unroll
        for (int p = 0; p < 16; ++p) tr[p] = *(const u32x4*)(gp + (size_t)(32 * p) * M);
#pragma unroll
        for (int p = 0; p < 16; ++p) *(LAS u32x4*)(lp + 32 * p * LDG) = tr[p];
    }
    __syncthreads();
    {
        const int tg = tid & 15, cgp = tid >> 4;
        float sm[8], sq[8];
#pragma unroll
        for (int j = 0; j < 8; ++j) { sm[j] = 0.f; sq[j] = 0.f; }
        const LAS unsigned char* rp = lds + (16 * cgp) * LDG + tg * 16;
#pragma unroll
        for (int c = 0; c < 16; ++c) { const u32x4 r = *(const LAS u32x4*)(rp + c * LDG);
            const float v[8] = {bf_lo(r.x), bf_hi(r.x), bf_lo(r.y), bf_hi(r.y), bf_lo(r.z), bf_hi(r.z), bf_lo(r.w), bf_hi(r.w)};
#pragma unroll
            for (int j = 0; j < 8; ++j) { sm[j] += v[j]; sq[j] += v[j] * v[j]; } }
#pragma unroll
        for (int j = 0; j < 8; ++j) { sm[j] += __shfl_xor(sm[j], 16); sm[j] += __shfl_xor(sm[j], 32); sq[j] += __shfl_xor(sq[j], 16); sq[j] += __shfl_xor(sq[j], 32); }
        if (lane < 16) {
#pragma unroll
            for (int j = 0; j < 8; ++j) *(LAS f32x2*)(part + ((size_t)wid * 128 + 8 * tg + j) * 8) = (f32x2){sm[j], sq[j]};
        }
        __syncthreads();
        if (tid < 128) { float ts = 0.f, tq2 = 0.f;
#pragma unroll
            for (int w = 0; w < 8; ++w) { const f32x2 p = *(const LAS f32x2*)(part + ((size_t)w * 128 + tid) * 8); ts += p[0]; tq2 += p[1]; }
            const float mean = ts * (1.0f / GW); const float var = fmaxf(tq2 * (1.0f / GW) - mean * mean, 0.f);
            stat[tid] = (f32x2){mean, 1.0f / sqrtf(var + LN_EPS)}; }
        __syncthreads();
    }
    {
        float lg[4], lb[4];
#pragma unroll
        for (int db = 0; db < 4; ++db) { lg[db] = a.in[9][64 * h + 16 * db + fr]; lb[db] = a.in[10][64 * h + 16 * db + fr]; }
        const LAS unsigned char* abase = lds + (64 * h + fr) * LDG + fq * 16;
        bf16_t* obase = mix + (size_t)(t0 + fr) * D + 512 + 64 * h + 4 * fq;
        int nb = 0;
#pragma unroll
        for (int th = 0; th < 2; ++th) {
            if (th == 0) {
#pragma unroll
                for (int tb = 0; tb < 4; ++tb)
#pragma unroll
                    for (int db = 0; db < 4; ++db) uu[1][tb][db] = *(const u32x2*)(ubase + (size_t)(16 * (4 + tb)) * GW + 16 * db);
            }
            f32x4 acc[4][4];
#pragma unroll
            for (int db = 0; db < 4; ++db)
#pragma unroll
                for (int tb = 0; tb < 4; ++tb) acc[db][tb] = (f32x4){0.f, 0.f, 0.f, 0.f};
#pragma unroll
            for (int ks = 0; ks < 2 * th + 2; ++ks) {
                float mu[8], rs[8];
#pragma unroll
                for (int j = 0; j < 8; ++j) { const f32x2 st = stat[32 * ks + 8 * fq + j]; mu[j] = st[0]; rs[j] = st[1]; }
                bf16x8 Af[4];
#pragma unroll
                for (int db = 0; db < 4; ++db) {
                    const u32x4 r = *(const LAS u32x4*)(abase + 16 * db * LDG + 64 * ks);
                    const float gg = lg[db], bb = lb[db];
                    u32x4 o;
                    o.x = cvt_pk_bf16((bf_lo(r.x) - mu[0]) * rs[0] * gg + bb, (bf_hi(r.x) - mu[1]) * rs[1] * gg + bb);
                    o.y = cvt_pk_bf16((bf_lo(r.y) - mu[2]) * rs[2] * gg + bb, (bf_hi(r.y) - mu[3]) * rs[3] * gg + bb);
                    o.z = cvt_pk_bf16((bf_lo(r.z) - mu[4]) * rs[4] * gg + bb, (bf_hi(r.z) - mu[5]) * rs[5] * gg + bb);
                    o.w = cvt_pk_bf16((bf_lo(r.w) - mu[6]) * rs[6] * gg + bb, (bf_hi(r.w) - mu[7]) * rs[7] * gg + bb);
                    Af[db] = __builtin_bit_cast(bf16x8, o);
                }
#pragma unroll
                for (int tb = 0; tb < 4; ++tb) {
                    if (4 * th + tb < 2 * ks) continue;
                    const bf16x8 bfr = Bf[nb++];
#pragma unroll
                    for (int db = 0; db < 4; ++db) acc[db][tb] = __builtin_amdgcn_mfma_f32_16x16x32_bf16(Af[db], bfr, acc[db][tb], 0, 0, 0);
                }
            }
            if (th == 0) {
                asm volatile("" ::: "memory");
                int n = 6;
#pragma unroll
                for (int ks = 0; ks < 4; ++ks)
#pragma unroll
                    for (int tb = 0; tb < 4; ++tb) { if (4 + tb < 2 * ks) continue; Bf[n++] = *(const bf16x8*)(wb + (size_t)(16 * (4 + tb)) * 128 + 32 * ks); }
                asm volatile("" ::: "memory");
            }
#pragma unroll
            for (int tb = 0; tb < 4; ++tb) {
                const float bs = a.in[12][h * 128 + 16 * (4 * th + tb) + fr];
#pragma unroll
                for (int db = 0; db < 4; ++db) {
                    u32x2 o; o.x = cvt_pk_bf16(bf_lo(uu[th][tb][db].x) * (acc[db][tb][0] + bs), bf_hi(uu[th][tb][db].x) * (acc[db][tb][1] + bs));
                    o.y = cvt_pk_bf16(bf_lo(uu[th][tb][db].y) * (acc[db][tb][2] + bs), bf_hi(uu[th][tb][db].y) * (acc[db][tb][3] + bs));
                    *(u32x2*)(obase + (size_t)(16 * (4 * th + tb)) * D + 16 * db) = o;
                }
            }
        }
    }
}

__device__ __forceinline__ void attn_unit(LAS unsigned char* lds, const bf16_t* q, const bf16_t* Km, const bf16_t* Vt, bf16_t* o, int pm, int h, int tid, int wid, int lane) {
    constexpr int LDK = 544, LDV = 528;
    const int fr = lane & 15, fq = lane >> 4, b = pm >> 4, row0 = pm * 256 + wid * 32;
    {
        const bf16_t* kg = Km + (size_t)(b * 256 + (tid >> 5)) * 1024 + h * 256 + (tid & 31) * 8;
        LAS unsigned char* kl = lds + (tid >> 5) * LDK + (tid & 31) * 16;
#pragma unroll
        for (int half = 0; half < 2; ++half) {
            u32x4 kr[8];
#pragma unroll
            for (int i = 0; i < 8; ++i) kr[i] = *(const u32x4*)(kg + (size_t)(half * 8 + i) * 16 * 1024);
#pragma unroll
            for (int i = 0; i < 8; ++i) *(LAS u32x4*)(kl + (half * 8 + i) * 16 * LDK) = kr[i];
        }
    }
    __syncthreads();
    bf16x8 Pf[2][8]; float inv[2];
    const bf16_t* qbase = q + (size_t)(row0 + fr) * D + h * 256 + 8 * fq;
#pragma unroll
    for (int qb = 0; qb < 2; ++qb) {
        bf16x8 Qf[8];
#pragma unroll
        for (int ks = 0; ks < 8; ++ks) Qf[ks] = *(const bf16x8*)(qbase + (size_t)(16 * qb) * D + 32 * ks);
        f32x4 S[16];
#pragma unroll
        for (int kb = 0; kb < 16; ++kb) S[kb] = (f32x4){0.f, 0.f, 0.f, 0.f};
        bf16x8 kf[2][4];
        const LAS unsigned char* kbase = lds + fr * LDK + fq * 16;
#pragma unroll
        for (int k4 = 0; k4 < 4; ++k4) kf[0][k4] = *(const LAS bf16x8*)(kbase + 64 * k4);
#pragma unroll
        for (int it = 0; it < 32; ++it) {
            if (it < 31) {
#pragma unroll
                for (int k4 = 0; k4 < 4; ++k4) kf[(it + 1) & 1][k4] = *(const LAS bf16x8*)(kbase + 16 * ((it + 1) >> 1) * LDK + 64 * (4 * ((it + 1) & 1) + k4));
            }
#pragma unroll
            for (int k4 = 0; k4 < 4; ++k4) S[it >> 1] = __builtin_amdgcn_mfma_f32_16x16x32_bf16(kf[it & 1][k4], Qf[4 * (it & 1) + k4], S[it >> 1], 0, 0, 0);
#pragma unroll
            for (int k4 = 0; k4 < 4; ++k4) { __builtin_amdgcn_sched_group_barrier(0x100, 1, 0); __builtin_amdgcn_sched_group_barrier(0x008, 1, 0); }
            __builtin_amdgcn_sched_barrier(0);
        }
        float mx = -3.0e38f;
#pragma unroll
        for (int kb = 0; kb < 16; ++kb) mx = fmaxf(fmaxf(fmaxf(S[kb][0], S[kb][1]), fmaxf(S[kb][2], S[kb][3])), mx);
        mx = fmaxf(mx, __shfl_xor(mx, 16)); mx = fmaxf(mx, __shfl_xor(mx, 32));
        float sum = 0.f;
#pragma unroll
        for (int kb = 0; kb < 16; ++kb)
#pragma unroll
            for (int j = 0; j < 4; ++j) { const float p = __builtin_amdgcn_exp2f(S[kb][j] - mx); S[kb][j] = p; sum += p; }
        sum += __shfl_xor(sum, 16); sum += __shfl_xor(sum, 32);
        inv[qb] = 1.0f / sum;
#pragma unroll
        for (int ks = 0; ks < 8; ++ks) { const u32x4 w = pack8(S[2 * ks], S[2 * ks + 1]); Pf[qb][ks] = __builtin_bit_cast(bf16x8, w); }
        asm volatile("" ::: "memory");
    }
    __syncthreads();
    {
        const bf16_t* vg = Vt + (size_t)(h * 256 + (tid >> 5)) * 1024 + b * 256 + (tid & 31) * 8;
        LAS unsigned char* vl = lds + (tid >> 5) * LDV + (tid & 31) * 16;
#pragma unroll
        for (int half = 0; half < 2; ++half) {
            u32x4 kr[8];
#pragma unroll
            for (int i = 0; i < 8; ++i) kr[i] = *(const u32x4*)(vg + (size_t)(half * 8 + i) * 16 * 1024);
#pragma unroll
            for (int i = 0; i < 8; ++i) *(LAS u32x4*)(vl + (half * 8 + i) * 16 * LDV) = kr[i];
        }
    }
    __syncthreads();
    const LAS unsigned char* vbase = lds + fr * LDV + fq * 8;
    bf16_t* obase = o + (size_t)(row0 + fr) * D + h * 256 + 4 * fq;
#pragma unroll
    for (int dh = 0; dh < 2; ++dh) {
        f32x4 O[2][8];
#pragma unroll
        for (int qb = 0; qb < 2; ++qb)
#pragma unroll
            for (int db = 0; db < 8; ++db) O[qb][db] = (f32x4){0.f, 0.f, 0.f, 0.f};
        u32x2 vlo[2][4], vhi[2][4];
#pragma unroll
        for (int k4 = 0; k4 < 4; ++k4) { const LAS unsigned char* vp = vbase + 128 * dh * LDV + 64 * k4; vlo[0][k4] = *(const LAS u32x2*)vp; vhi[0][k4] = *(const LAS u32x2*)(vp + 32); }
#pragma unroll
        for (int it = 0; it < 16; ++it) {
            if (it < 15) {
#pragma unroll
                for (int k4 = 0; k4 < 4; ++k4) { const LAS unsigned char* vp = vbase + (128 * dh + 16 * ((it + 1) >> 1)) * LDV + 64 * (4 * ((it + 1) & 1) + k4); vlo[(it + 1) & 1][k4] = *(const LAS u32x2*)vp; vhi[(it + 1) & 1][k4] = *(const LAS u32x2*)(vp + 32); }
            }
#pragma unroll
            for (int k4 = 0; k4 < 4; ++k4) {
                const u32x4 w = {vlo[it & 1][k4].x, vlo[it & 1][k4].y, vhi[it & 1][k4].x, vhi[it & 1][k4].y}; const bf16x8 vf = __builtin_bit_cast(bf16x8, w);
#pragma unroll
                for (int qb = 0; qb < 2; ++qb) O[qb][it >> 1] = __builtin_amdgcn_mfma_f32_16x16x32_bf16(vf, Pf[qb][4 * (it & 1) + k4], O[qb][it >> 1], 0, 0, 0);
            }
#pragma unroll
            for (int k4 = 0; k4 < 4; ++k4) { __builtin_amdgcn_sched_group_barrier(0x100, 2, 0); __builtin_amdgcn_sched_group_barrier(0x008, 2, 0); }
            __builtin_amdgcn_sched_barrier(0);
        }
#pragma unroll
        for (int qb = 0; qb < 2; ++qb)
#pragma unroll
            for (int db = 0; db < 8; ++db) {
                const f32x4 v = O[qb][db] * inv[qb]; u32x2 w; w.x = cvt_pk_bf16(v[0], v[1]); w.y = cvt_pk_bf16(v[2], v[3]);
                *(u32x2*)(obase + (size_t)(16 * qb) * D + 128 * dh + 16 * db) = w;
            }
    }
    __syncthreads();
}

#define PHASE_ARGS const Args& a, LAS unsigned char* lds, unsigned char* ws, int tid, int wid, int lane, int bid, int G
#define PHASE_CALL a, lds, ws, tid, wid, lane, bid, G
constexpr size_t TS1024 = (size_t)256 * 1024 * 2;

__device__ __forceinline__ void phase_p1(PHASE_ARGS) {
    pg8::Sched S{}; S.G = G; S.c = bid; S.tstep = TS1024;
    S.A0 = (const char*)(ws + WS_HN); S.B0 = (const char*)(ws + WS_BT1); S.nM0 = 64; S.nN0 = 4;
    S.A1 = (const char*)(ws + WS_HN); S.B1 = (const char*)(ws + WS_BT1) + (size_t)1024 * 2048; S.nM1 = 64; S.nN1 = 2;
    S.A2 = (const char*)(ws + WS_BT1) + (size_t)1536 * 2048; S.B2 = (const char*)(ws + WS_HN); S.nM2 = 2; S.nN2 = 64;
    EpiP1 E{(bf16_t*)(ws + WS_AGLU), (bf16_t*)(ws + WS_U), (bf16_t*)(ws + WS_GVT), a.in[4], (const float*)(ws + WS_RX)};
    pg8::gemm_phase(lds, 1024, S, E);
}
__device__ __forceinline__ void phase_p2(PHASE_ARGS) {
    conv_unit<64>(a, lds, bid, tid, wid, lane);
    if (bid < 128) {
        gmlp_unit(a, lds, bid, tid, wid, lane);
    } else if (bid < 160) {
        pg8::Sched S{}; S.G = 32; S.c = bid - 128; S.tstep = TS1024;
        S.A0 = (const char*)(ws + WS_MN); S.B0 = (const char*)(ws + WS_WKV); S.nM0 = 4; S.nN0 = 4;
        S.A1 = (const char*)(ws + WS_WKV) + (size_t)1024 * 2048; S.B1 = (const char*)(ws + WS_MN); S.nM1 = 4; S.nN1 = 4;
        EpiKV E{(bf16_t*)(ws + WS_KM), (bf16_t*)(ws + WS_VT)};
        pg8::gemm_phase(lds, 1024, S, E);
    } else {
        late_weights(a, lds, (bid - 160) * 8 + wid, 96 * 8, wid, lane);
    }
}
__device__ __forceinline__ void phase_p3(PHASE_ARGS) {
    pg8::Sched S{}; S.G = G; S.c = bid; S.tstep = TS1024;
    S.A0 = (const char*)(ws + WS_MIX); S.B0 = (const char*)(ws + WS_WOUT); S.nM0 = 64; S.nN0 = 4;
    EpiRes<true> E{(const bf16_t*)(ws + WS_HN), (bf16_t*)(ws + WS_HB), (float*)(ws + WS_SSQ1)};
    pg8::gemm_phase(lds, 1024, S, E);
}
__device__ __forceinline__ void phase_p4(PHASE_ARGS) {
    pg8::Sched S{}; S.G = 1 << 20; S.c = bid; S.tstep = TS1024;
    S.A0 = (const char*)(ws + WS_HB); S.B0 = (const char*)(ws + WS_WQ); S.nM0 = 64; S.nN0 = 4;
    Unit un; S.next(0, un);
    EpiQ E{(bf16_t*)(ws + WS_Q), (const float*)(ws + WS_SSQ1)};
    pg8::gemm_phase(lds, 1024, S, E);
    asm volatile("s_waitcnt vmcnt(0)" ::: "memory");
    __syncthreads();
    attn_unit(lds, (const bf16_t*)(ws + WS_Q), (const bf16_t*)(ws + WS_KM), (const bf16_t*)(ws + WS_VT), (bf16_t*)(ws + WS_HN), un.pm, un.pn, tid, wid, lane);
}
__device__ __forceinline__ void phase_p5(PHASE_ARGS) {
    pg8::Sched S{}; S.G = G; S.c = bid; S.tstep = TS1024;
    S.A0 = (const char*)(ws + WS_HN); S.B0 = (const char*)(ws + WS_WO); S.nM0 = 64; S.nN0 = 4;
    EpiRes<true> E{(const bf16_t*)(ws + WS_HB), (bf16_t*)(ws + WS_HB), (float*)(ws + WS_SSQ2)};
    pg8::gemm_phase(lds, 1024, S, E);
}
__device__ __forceinline__ void phase_p6(PHASE_ARGS) {
    pg8::Sched S{}; S.G = G; S.c = bid; S.tstep = TS1024;
    S.A0 = (const char*)(ws + WS_HB); S.B0 = (const char*)(ws + WS_WGU); S.nM0 = 64; S.nN0 = 22;
    EpiGU E{(bf16_t*)(ws + WS_ACT), (const float*)(ws + WS_SSQ2)};
    pg8::gemm_phase(lds, 1024, S, E);
}
__device__ __forceinline__ void phase_p7(PHASE_ARGS) {
    pg8::Sched S{}; S.G = G; S.c = bid; S.tstep = (size_t)256 * FF * 2;
    S.A0 = (const char*)(ws + WS_ACT); S.B0 = (const char*)(ws + WS_WD); S.nM0 = 64; S.nN0 = 4;
    EpiFinal E{(const bf16_t*)(ws + WS_HB), a.out, (float*)(ws + WS_SSQ3), (unsigned*)(ws + WS_CTL + 16384), a.in[22]};
    pg8::gemm_phase(lds, FF, S, E);
}
__global__ void __launch_bounds__(512, 2) fwd_mega(Args a) {
    extern __shared__ __attribute__((aligned(16))) unsigned char lds_raw[];
    LAS unsigned char* lds = (LAS unsigned char*)lds_raw;
    cg::grid_group grid = cg::this_grid();
    const int tid = threadIdx.x, wid = __builtin_amdgcn_readfirstlane(tid >> 6), lane = tid & 63, bid = blockIdx.x, G = gridDim.x;
    unsigned char* ws = a.ws;
    if (tid < 2) ((volatile LAS unsigned*)(lds + LDS_BYTES - 64))[tid] = 0u;
    __syncthreads();
    const XcdBarrier xbar = xcd_barrier_post((unsigned*)(ws + WS_CTL), (volatile LAS unsigned*)(lds + LDS_BYTES - 64));
    if (a.never != 0) grid.sync();
#define GRID_BAR() xcd_barrier(xbar)
    { p0_prologue(a, lds, bid, G, wid, lane); }
    GRID_BAR();
    phase_p1(PHASE_CALL); GRID_BAR();
    { phase_p2(PHASE_CALL);
    } GRID_BAR();
    phase_p3(PHASE_CALL); GRID_BAR();
    { phase_p4(PHASE_CALL); } GRID_BAR();
    { phase_p5(PHASE_CALL); } GRID_BAR();
    phase_p6(PHASE_CALL); GRID_BAR();
    phase_p7(PHASE_CALL);
}

extern "C" void kernel_launch(void* const* d_in, const int* in_sizes, int n_in, void* d_out, int out_size, void* d_ws, size_t ws_size, hipStream_t stream) {
    static int grid = 0;
    if (grid == 0) {
        int dev = 0, cus = 0, per_cu = 0;
        (void)hipGetDevice(&dev);
        (void)hipDeviceGetAttribute(&cus, hipDeviceAttributeMultiprocessorCount, dev);
        (void)hipFuncSetAttribute((const void*)fwd_mega, hipFuncAttributeMaxDynamicSharedMemorySize, LDS_BYTES);
        (void)hipOccupancyMaxActiveBlocksPerMultiprocessor(&per_cu, (const void*)fwd_mega, 512, LDS_BYTES);
        (void)hipGetLastError();
        grid = cus > 0 ? cus : 256;
        if (grid > 256) grid = 256;
    }
    Args a{};
    for (int i = 0; i < 23; ++i) a.in[i] = (const float*)d_in[i];
    a.out = (float*)d_out; a.ws = (unsigned char*)d_ws; a.never = 0ull;
    (void)hipMemsetAsync((char*)d_ws + WS_CTL, 0, CTL_ZERO_BYTES, stream);
    void* args[] = {&a};
    hipError_t e = hipLaunchCooperativeKernel((const void*)fwd_mega, dim3(grid), dim3(512), args, LDS_BYTES, stream);
    if (e != hipSuccess) fprintf(stderr, "cooperative launch failed: %s (grid %d)\n", hipGetErrorString(e), grid);
}
```

```cpp
#include <hip/hip_runtime.h>
#include <hip/hip_cooperative_groups.h>
#include <cstdio>
#include <cstdint>
namespace cg = cooperative_groups;

#define LAS __attribute__((address_space(3)))
typedef unsigned short bf16_t;
typedef short bf16x8 __attribute__((ext_vector_type(8)));
typedef float f32x4 __attribute__((ext_vector_type(4)));
typedef float f32x2 __attribute__((ext_vector_type(2)));
typedef unsigned u32x4 __attribute__((ext_vector_type(4)));
typedef unsigned u32x2 __attribute__((ext_vector_type(2)));

constexpr int D = 1024, NB = 4, SEQ = 4096, M = NB * SEQ, CW = 512, GW = 512, CHUNK = 128, MEML = 256, MR = NB * MEML, FF = 2816;
constexpr float RMS_EPS = 1e-6f, LN_EPS = 1e-5f;
constexpr float LOG2E = 1.4426950408889634f;
constexpr float QSCALE = 0.0625f * LOG2E;

constexpr size_t MiB = 1u << 20;
constexpr size_t WS_BT1 = 0 * MiB;
constexpr size_t WS_WOUT = 4 * MiB;
constexpr size_t WS_WQ = 6 * MiB;
constexpr size_t WS_WKV = 8 * MiB;
constexpr size_t WS_WO = 12 * MiB;
constexpr size_t WS_WGU = 14 * MiB;
constexpr size_t WS_WD = 25 * MiB;
constexpr size_t WS_WSB = 31 * MiB;
constexpr size_t WS_MN = 32 * MiB;
constexpr size_t WS_KM = 34 * MiB;
constexpr size_t WS_VT = 36 * MiB;
constexpr size_t WS_SSQ1 = 38 * MiB, WS_SSQ2 = 39 * MiB, WS_SSQ3 = 40 * MiB;
constexpr size_t WS_HB = 48 * MiB;
constexpr size_t WS_HN = 80 * MiB;
constexpr size_t WS_MIX = 176 * MiB;
constexpr size_t WS_RX = 42 * MiB;
constexpr size_t WS_AGLU = 112 * MiB;
constexpr size_t WS_U = 128 * MiB;
constexpr size_t WS_GVT = 144 * MiB;
constexpr size_t WS_Q = 112 * MiB;
constexpr size_t WS_ACT = 80 * MiB;
constexpr int LDS_BYTES = 147456;


constexpr size_t WS_CTL = 41 * MiB;
constexpr size_t CTL_ZERO_BYTES = 32768;
#define XB_TMO      128
#define XB_XCNT(j)  (256  + 64 * (j))
#define XB_XSUB(j)  (1280 + 64 * (j))
#define XB_XGEN(j)  (2304 + 64 * (j))
#define XB_TOP      3328
#define XB_TOPGEN   3392
#define XB_SPIN_CAP (1u << 18)
__device__ __forceinline__ unsigned xb_ld(unsigned* p)              { return __hip_atomic_load(p, __ATOMIC_RELAXED, __HIP_MEMORY_SCOPE_AGENT); }
__device__ __forceinline__ unsigned xb_add(unsigned* p, unsigned v) { return __hip_atomic_fetch_add(p, v, __ATOMIC_RELAXED, __HIP_MEMORY_SCOPE_AGENT); }
__device__ __forceinline__ unsigned xb_xcc_id() { return (unsigned)__builtin_amdgcn_s_getreg((3 << 11) | 20) & 0xFu; }
#define XB_SPIN(cond, bar) do { unsigned _sp = 0; while (cond) { __builtin_amdgcn_s_sleep(1); \
    if ((++_sp & 255u) == 0u) { if (xb_ld(&(bar)[XB_TMO])) break; if (_sp > XB_SPIN_CAP) { atomicAdd(&(bar)[XB_TMO], 1u); break; } } } } while (0)
struct XcdBarrier { unsigned* bar; unsigned x; volatile LAS unsigned* st; };
__device__ __forceinline__ XcdBarrier xcd_barrier_post(unsigned* bar, volatile LAS unsigned* st) {
    XcdBarrier b; b.bar = bar; b.x = xb_xcc_id(); b.st = st;
    if (threadIdx.x == 0) (void)xb_add(&bar[XB_XCNT(b.x)], 1u);
    return b;
}
__device__ __forceinline__ void xcd_barrier_complete(unsigned* bar, unsigned x, unsigned& nloc, unsigned& nx) {
    const unsigned G = gridDim.x * gridDim.y * gridDim.z;
    unsigned sum, cnt, mine, sp = 0u;
    for (;;) {
        sum = 0u; cnt = 0u; mine = 0u;
#pragma unroll
        for (unsigned j = 0; j < 16; ++j) { const unsigned c = xb_ld(&bar[XB_XCNT(j)]); sum += c; cnt += (c > 0u) ? 1u : 0u; mine = (j == x) ? c : mine; }
        if (sum == G) break;
        __builtin_amdgcn_s_sleep(1);
        if ((++sp & 255u) == 0u) { if (xb_ld(&bar[XB_TMO])) break; if (sp > XB_SPIN_CAP) { atomicAdd(&bar[XB_TMO], 1u); break; } }
    }
    nloc = mine > 0u ? mine : 1u; nx = cnt > 0u ? cnt : 1u;
}
__device__ __forceinline__ void xcd_barrier(const XcdBarrier& b) {
    asm volatile("s_waitcnt vmcnt(0)" ::: "memory");
    __syncthreads();
    if (threadIdx.x == 0) {
        unsigned* bar = b.bar;
        __builtin_amdgcn_s_waitcnt(0);
        unsigned nloc = b.st[0], nx = b.st[1];
        if (nloc == 0u) { xcd_barrier_complete(bar, b.x, nloc, nx); b.st[0] = nloc; b.st[1] = nx; }
        const unsigned old = xb_add(&bar[XB_XSUB(b.x)], 1u);
        const unsigned gen = old / nloc;
        if (old + 1u == (gen + 1u) * nloc) {
            __builtin_amdgcn_fence(__ATOMIC_RELEASE, "agent");
            asm volatile("s_waitcnt vmcnt(0)" ::: "memory");
            const unsigned og = xb_add(&bar[XB_TOP], 1u);
            const unsigned tg = og / nx;
            if (og + 1u == (tg + 1u) * nx) xb_add(&bar[XB_TOPGEN], 1u);
            else XB_SPIN(xb_ld(&bar[XB_TOPGEN]) == tg, bar);
            __builtin_amdgcn_fence(__ATOMIC_ACQUIRE, "agent");
            xb_add(&bar[XB_XGEN(b.x)], 1u);
            asm volatile("s_waitcnt vmcnt(0)" ::: "memory");
        } else {
            XB_SPIN(xb_ld(&bar[XB_XGEN(b.x)]) == gen, bar);
            __builtin_amdgcn_fence(__ATOMIC_ACQUIRE, "agent");
            asm volatile("s_waitcnt vmcnt(0)" ::: "memory");
        }
    }
    __syncthreads();
}

__device__ __forceinline__ unsigned cvt_pk_bf16(float lo, float hi) { unsigned r; asm volatile("v_cvt_pk_bf16_f32 %0, %1, %2" : "=v"(r) : "v"(lo), "v"(hi)); return r; }
__device__ __forceinline__ float bf_lo(unsigned u) { return __uint_as_float(u << 16); }
__device__ __forceinline__ float bf_hi(unsigned u) { return __uint_as_float(u & 0xffff0000u); }
__device__ __forceinline__ float sigmoidf_(float x) { return __builtin_amdgcn_rcpf(1.0f + __builtin_amdgcn_exp2f(-LOG2E * x)); }
__device__ __forceinline__ float siluf_(float x) { return x * sigmoidf_(x); }
__device__ __forceinline__ float geluf_(float x) { const float u = 0.7978845608028654f * (x + 0.044715f * x * x * x); return x * __builtin_amdgcn_rcpf(1.0f + __builtin_amdgcn_exp2f(-2.0f * LOG2E * u)); }
__device__ __forceinline__ f32x2 sigmoid2_(float x0, float x1) {
    const float a = 1.0f + __builtin_amdgcn_exp2f(fminf(-LOG2E * x0, 60.0f)), b = 1.0f + __builtin_amdgcn_exp2f(fminf(-LOG2E * x1, 60.0f));
    const float r = __builtin_amdgcn_rcpf(a * b);
    return (f32x2){r * b, r * a};
}
__device__ __forceinline__ f32x2 gelu2_(float x0, float x1) {
    const float u0 = 1.5957691216057308f * (x0 + 0.044715f * x0 * x0 * x0), u1 = 1.5957691216057308f * (x1 + 0.044715f * x1 * x1 * x1);
    const f32x2 sg = sigmoid2_(u0, u1); return (f32x2){x0 * sg[0], x1 * sg[1]};
}
__device__ __forceinline__ float wave_sum(float v) {
#pragma unroll
    for (int o = 1; o < 64; o <<= 1) v += __shfl_xor(v, o);
    return v;
}
__device__ __forceinline__ u32x4 pack8(f32x4 a, f32x4 b) { u32x4 w; w.x = cvt_pk_bf16(a[0], a[1]); w.y = cvt_pk_bf16(a[2], a[3]); w.z = cvt_pk_bf16(b[0], b[1]); w.w = cvt_pk_bf16(b[2], b[3]); return w; }

namespace pg8 {
constexpr int BM = 256, BK = 64, HALF = 128, HTB = HALF * BK * 2, NXCD = 8, WGM = 8;
__device__ __forceinline__ int lds_byte(int r, int c) { const int st = (r >> 4) * 2 + (c >> 5), rr = r & 15, cc = c & 31, ob = rr * 64 + cc * 2; return st * 1024 + (ob ^ (((ob >> 9) & 1) << 5)); }
__device__ __forceinline__ void stage_rc(int b, int& R, int& C) { const int st = b / 1024, sb = b % 1024, swz = sb ^ (((sb >> 9) & 1) << 5); R = (st >> 1) * 16 + swz / 64; C = (st & 1) * 32 + (swz % 64) / 2; }
__device__ __forceinline__ int perm32(int rho) { const int n = rho >> 4, i = rho & 15; return 8 * (i >> 2) + 4 * n + (i & 3); }

struct Unit { const char* A; const char* B; int pm, pn, kind; };

__device__ __forceinline__ void tile_order(int wgid, int nM, int nN, int& pm, int& pn) {
    const int nwg = nM * nN;
    { const int q = nwg / NXCD, r = nwg % NXCD, xcd = wgid % NXCD, off = wgid / NXCD; wgid = (xcd < r ? xcd * (q + 1) : r * (q + 1) + (xcd - r) * q) + off; }
    const int nig = WGM * nN, gid = wgid / nig, fm = gid * WGM, gsz = (nM - fm) < WGM ? (nM - fm) : WGM;
    pm = fm + ((wgid % nig) % gsz); pn = (wgid % nig) / gsz;
}
struct Sched {
    const char *A0, *B0, *A1, *B1, *A2, *B2; int nM0, nN0, nM1, nN1, nM2, nN2; int G, c; size_t tstep;
    __device__ __forceinline__ bool next(int i, Unit& u) const {
        int L = i * G + c;
        if (L < nM0 * nN0) { tile_order(L, nM0, nN0, u.pm, u.pn); u.A = A0 + (size_t)u.pm * tstep; u.B = B0 + (size_t)u.pn * tstep; u.kind = 0; return true; }
        L -= nM0 * nN0;
        if (L < nM1 * nN1) { tile_order(L, nM1, nN1, u.pm, u.pn); u.A = A1 + (size_t)u.pm * tstep; u.B = B1 + (size_t)u.pn * tstep; u.kind = 1; return true; }
        L -= nM1 * nN1;
        if (L < nM2 * nN2) { tile_order(L, nM2, nN2, u.pm, u.pn); u.A = A2 + (size_t)u.pm * tstep; u.B = B2 + (size_t)u.pn * tstep; u.kind = 2; return true; }
        return false;
    }
};
template <class Epi, class Sch>
__device__ __forceinline__ void gemm_phase(LAS unsigned char* lds, const int K, const Sch& S, const Epi& E) {
    int tid_ = threadIdx.x; asm volatile("" : "+v"(tid_));
    const int tid = tid_, wid = __builtin_amdgcn_readfirstlane(tid >> 6), lane = tid & 63, wr = wid >> 2, wc = wid & 3, fr = lane & 15, fq = lane >> 4;
    const int nt = K / BK;
    unsigned voffA[2], voffB[2];
#pragma unroll
    for (int i = 0; i < 2; ++i) { int R, C; stage_rc(tid * 16 + i * 8192, R, C); const int Rb = (R & ~31) + perm32(R & 31);
        voffA[i] = (unsigned)(R * K + C) * 2u; voffB[i] = (unsigned)(Rb * K + C) * 2u; }
    const size_t kstep = (size_t)(BK * 2);
    const size_t hstep = (size_t)HALF * K * 2;
    const unsigned ldsw = (unsigned)wid * 1024u;
    const int aoff = lds_byte(wr * 64 + fr, fq * 8), boff = lds_byte(wc * 32 + fr, fq * 8);
#define PG8_SA(b, h) (((b) * 2 + (h)) * HTB)
#define PG8_SB(b, h) ((4 + (b) * 2 + (h)) * HTB)
#define PG8_STAGE(bufoff, gbase, voff) do { _Pragma("unroll") for (int _i = 0; _i < 2; ++_i) \
        __builtin_amdgcn_global_load_lds((const unsigned*)((const char*)(gbase) + (voff)[_i]), (LAS unsigned*)(lds + (bufoff) + ldsw + _i * 8192), 16, 0, 0); } while (0)
#define PG8_LDA(dst, b, h) do { _Pragma("unroll") for (int m = 0; m < 4; ++m) _Pragma("unroll") for (int k = 0; k < 2; ++k) dst[m][k] = *(const LAS bf16x8*)(lds + PG8_SA(b, h) + aoff + m * 2048 + k * 1024); } while (0)
#define PG8_LDB(dst, b, h) do { _Pragma("unroll") for (int n = 0; n < 2; ++n) _Pragma("unroll") for (int k = 0; k < 2; ++k) dst[n][k] = *(const LAS bf16x8*)(lds + PG8_SB(b, h) + boff + n * 2048 + k * 1024); } while (0)
#define PG8_MMA(ai, bj, At, Bt) do { __builtin_amdgcn_s_setprio(1); _Pragma("unroll") for (int m = 0; m < 4; ++m) _Pragma("unroll") for (int n = 0; n < 2; ++n) _Pragma("unroll") for (int k = 0; k < 2; ++k) \
        acc[ai][bj][m][n] = __builtin_amdgcn_mfma_f32_16x16x32_bf16(Bt[n][k], At[m][k], acc[ai][bj][m][n], 0, 0, 0); __builtin_amdgcn_s_setprio(0); } while (0)
#define PG8_WAIT_V(n) asm volatile("s_waitcnt vmcnt(" #n ")" ::: "memory")
#define PG8_WAIT_L(n) asm volatile("s_waitcnt lgkmcnt(" #n ")" ::: "memory")
#define PG8_BAR __builtin_amdgcn_s_barrier()
#define PG8_SCHED __builtin_amdgcn_sched_barrier(0)
    Unit cur, nxt; int ui = 0;
    if (!S.next(0, cur)) return;
    f32x4 acc[2][2][4][2];
#pragma unroll
    for (int a = 0; a < 2; ++a)
#pragma unroll
        for (int b = 0; b < 2; ++b)
#pragma unroll
            for (int m = 0; m < 4; ++m)
#pragma unroll
                for (int n = 0; n < 2; ++n) acc[a][b][m][n] = (f32x4){0.f, 0.f, 0.f, 0.f};
    bf16x8 At[4][2], B0[2][2], B1[2][2];
    const char* cA = cur.A; const char* cB = cur.B;
    PG8_STAGE(PG8_SB(0, 0), cB, voffB); PG8_STAGE(PG8_SB(0, 1), cB + hstep, voffB); PG8_STAGE(PG8_SA(0, 0), cA, voffA); PG8_STAGE(PG8_SA(0, 1), cA + hstep, voffA);
    if (wr == 1) PG8_BAR;
    PG8_WAIT_V(2); PG8_BAR;
    PG8_STAGE(PG8_SB(1, 0), cB + kstep, voffB); PG8_STAGE(PG8_SA(1, 0), cA + kstep, voffA); PG8_STAGE(PG8_SB(1, 1), cB + hstep + kstep, voffB);
    PG8_WAIT_V(6); PG8_BAR;
    for (;;) {
        const bool has_next = S.next(ui + 1, nxt);
        const char* nA = has_next ? nxt.A : cA; const char* nB = has_next ? nxt.B : cB;
        for (int t = 0; t < nt; t += 2) {
            const bool last = (t == nt - 2);
            const char* a1 = cA + (size_t)(t + 1) * kstep;
            const char* a2 = last ? nA : cA + (size_t)(t + 2) * kstep; const char* b2 = last ? nB : cB + (size_t)(t + 2) * kstep;
            const char* a3 = a2 + kstep; const char* b3 = b2 + kstep;
            PG8_LDB(B0, 0, 0); PG8_LDB(B1, 0, 1); PG8_SCHED; PG8_LDA(At, 0, 0); PG8_STAGE(PG8_SA(1, 1), a1 + hstep, voffA);
            PG8_WAIT_V(8); PG8_WAIT_L(0); PG8_BAR; PG8_MMA(0, 0, At, B0); PG8_MMA(0, 1, At, B1); PG8_BAR; PG8_SCHED;
            PG8_LDA(At, 0, 1); PG8_STAGE(PG8_SB(0, 0), b2, voffB); PG8_STAGE(PG8_SB(0, 1), b2 + hstep, voffB); PG8_STAGE(PG8_SA(0, 0), a2, voffA);
            PG8_WAIT_V(8); PG8_WAIT_L(0); PG8_BAR; PG8_MMA(1, 0, At, B0); PG8_MMA(1, 1, At, B1); PG8_BAR; PG8_SCHED;
            PG8_LDB(B0, 1, 0); PG8_LDB(B1, 1, 1); PG8_SCHED; PG8_LDA(At, 1, 0); PG8_STAGE(PG8_SA(0, 1), a2 + hstep, voffA);
            PG8_WAIT_V(8); PG8_WAIT_L(0); PG8_BAR; PG8_MMA(0, 0, At, B0); PG8_MMA(0, 1, At, B1); PG8_BAR; PG8_SCHED;
            PG8_LDA(At, 1, 1); PG8_STAGE(PG8_SB(1, 0), b3, voffB); PG8_STAGE(PG8_SB(1, 1), b3 + hstep, voffB); PG8_STAGE(PG8_SA(1, 0), a3, voffA);
            PG8_WAIT_V(8); PG8_WAIT_L(0); PG8_BAR; PG8_MMA(1, 0, At, B0); PG8_MMA(1, 1, At, B1); PG8_BAR; PG8_SCHED;
        }
        if (wr == 0) PG8_BAR;
        E(acc, cur, wr, wc, fr, fq);
        if (!has_next) break;
#pragma unroll
        for (int a = 0; a < 2; ++a)
#pragma unroll
            for (int b = 0; b < 2; ++b)
#pragma unroll
                for (int m = 0; m < 4; ++m)
#pragma unroll
                    for (int n = 0; n < 2; ++n) acc[a][b][m][n] = (f32x4){0.f, 0.f, 0.f, 0.f};
        cur = nxt; cA = nA; cB = nB; ++ui;
        if (wr == 1) PG8_BAR;
    }
    PG8_WAIT_V(0);
    PG8_BAR;
#undef PG8_SA
#undef PG8_SB
#undef PG8_STAGE
#undef PG8_LDA
#undef PG8_LDB
#undef PG8_MMA
#undef PG8_WAIT_V
#undef PG8_WAIT_L
#undef PG8_BAR
#undef PG8_SCHED
}
}
using pg8::Unit;

#define EPI_ROW(ai, m) (un.pm * 256 + (ai) * 128 + wr * 64 + (m) * 16 + fr)
struct EpiP1 {
    bf16_t* aglu; bf16_t* u; bf16_t* gvT; const float* b_in; const float* rx;
    __device__ __forceinline__ void operator()(const f32x4 (&acc)[2][2][4][2], const Unit& un, int wr, int wc, int fr, int fq) const {
        if (un.kind == 0) {
            const int c0 = un.pn * 128 + wc * 32 + 8 * fq;
            f32x4 ba[2], bg[2];
#pragma unroll
            for (int n = 0; n < 2; ++n) { ba[n] = *(const f32x4*)(b_in + c0 + 4 * n); bg[n] = *(const f32x4*)(b_in + 512 + c0 + 4 * n); }
            float rsv[2][4];
#pragma unroll
            for (int ai = 0; ai < 2; ++ai)
#pragma unroll
                for (int m = 0; m < 4; ++m) rsv[ai][m] = rx[EPI_ROW(ai, m)];
#pragma unroll
            for (int ai = 0; ai < 2; ++ai)
#pragma unroll
                for (int m = 0; m < 4; ++m) {
                    f32x4 v[2]; const float rs = rsv[ai][m];
#pragma unroll
                    for (int n = 0; n < 2; ++n) { const f32x4 za = acc[ai][0][m][n] * rs + ba[n], zg = acc[ai][1][m][n] * rs + bg[n];
#pragma unroll
                        for (int j = 0; j < 4; j += 2) { const f32x2 sg = sigmoid2_(zg[j], zg[j + 1]); v[n][j] = za[j] * sg[0]; v[n][j + 1] = za[j + 1] * sg[1]; } }
                    *(u32x4*)(aglu + (size_t)EPI_ROW(ai, m) * CW + c0) = pack8(v[0], v[1]);
                }
        } else if (un.kind == 1) {
            float rsv[2][4];
#pragma unroll
            for (int ai = 0; ai < 2; ++ai)
#pragma unroll
                for (int m = 0; m < 4; ++m) rsv[ai][m] = rx[EPI_ROW(ai, m)];
#pragma unroll
            for (int bj = 0; bj < 2; ++bj) {
                const int cu = un.pn * 256 + bj * 128 + wc * 32 + 8 * fq;
                f32x4 bb[2];
#pragma unroll
                for (int n = 0; n < 2; ++n) bb[n] = *(const f32x4*)(b_in + 1024 + cu + 4 * n);
#pragma unroll
                for (int ai = 0; ai < 2; ++ai)
#pragma unroll
                    for (int m = 0; m < 4; ++m) {
                        f32x4 v[2]; const float rs = rsv[ai][m];
#pragma unroll
                        for (int n = 0; n < 2; ++n) { const f32x4 z = acc[ai][bj][m][n] * rs + bb[n];
#pragma unroll
                            for (int j = 0; j < 4; j += 2) { const f32x2 ge = gelu2_(z[j], z[j + 1]); v[n][j] = ge[0]; v[n][j + 1] = ge[1]; } }
                        *(u32x4*)(u + (size_t)EPI_ROW(ai, m) * GW + cu) = pack8(v[0], v[1]);
                    }
            }
        } else {
            f32x4 rt[2][2];
#pragma unroll
            for (int bj = 0; bj < 2; ++bj)
#pragma unroll
                for (int n = 0; n < 2; ++n) rt[bj][n] = *(const f32x4*)(rx + un.pn * 256 + bj * 128 + wc * 32 + 8 * fq + 4 * n);
            float bbv[2][4];
#pragma unroll
            for (int ai = 0; ai < 2; ++ai)
#pragma unroll
                for (int m = 0; m < 4; ++m) bbv[ai][m] = b_in[1536 + EPI_ROW(ai, m)];
#pragma unroll
            for (int ai = 0; ai < 2; ++ai)
#pragma unroll
                for (int m = 0; m < 4; ++m) {
                    const int ch = EPI_ROW(ai, m);
                    const float bb = bbv[ai][m];
#pragma unroll
                    for (int bj = 0; bj < 2; ++bj) {
                        const int tok = un.pn * 256 + bj * 128 + wc * 32 + 8 * fq;
                        f32x4 v[2];
#pragma unroll
                        for (int n = 0; n < 2; ++n)
#pragma unroll
                            for (int j = 0; j < 4; j += 2) { const f32x2 ge = gelu2_(acc[ai][bj][m][n][j] * rt[bj][n][j] + bb, acc[ai][bj][m][n][j + 1] * rt[bj][n][j + 1] + bb); v[n][j] = ge[0]; v[n][j + 1] = ge[1]; }
                        *(u32x4*)(gvT + (size_t)ch * M + tok) = pack8(v[0], v[1]);
                    }
                }
        }
    }
};
struct EpiKV {
    bf16_t* o0; bf16_t* o1;
    __device__ __forceinline__ void operator()(const f32x4 (&acc)[2][2][4][2], const Unit& un, int wr, int wc, int fr, int fq) const {
        bf16_t* o = un.kind == 0 ? o0 : o1;
#pragma unroll
        for (int ai = 0; ai < 2; ++ai)
#pragma unroll
            for (int m = 0; m < 4; ++m)
#pragma unroll
                for (int bj = 0; bj < 2; ++bj)
                    *(u32x4*)(o + (size_t)EPI_ROW(ai, m) * 1024 + un.pn * 256 + bj * 128 + wc * 32 + 8 * fq) = pack8(acc[ai][bj][m][0], acc[ai][bj][m][1]);
    }
};
template <bool RES_BF16> struct EpiRes {
    const bf16_t* resb; bf16_t* hb; float* ssq;
    __device__ __forceinline__ void operator()(const f32x4 (&acc)[2][2][4][2], const Unit& un, int wr, int wc, int fr, int fq) const {
        const size_t off0 = (size_t)(un.pm * 256 + wr * 64 + fr) * D + un.pn * 256 + wc * 32 + 8 * fq;
        if (RES_BF16) {
            u32x4 hv[2][4][2];
#pragma unroll
            for (int ai = 0; ai < 2; ++ai)
#pragma unroll
                for (int m = 0; m < 4; ++m)
#pragma unroll
                    for (int bj = 0; bj < 2; ++bj) hv[ai][m][bj] = *(const u32x4*)(resb + off0 + (size_t)(ai * 128 + m * 16) * D + bj * 128);
#pragma unroll
            for (int ai = 0; ai < 2; ++ai)
#pragma unroll
                for (int m = 0; m < 4; ++m) {
                    float ss = 0.f;
#pragma unroll
                    for (int bj = 0; bj < 2; ++bj) {
                        const u32x4 h4 = hv[ai][m][bj];
                        const f32x4 v0 = acc[ai][bj][m][0] + (f32x4){bf_lo(h4.x), bf_hi(h4.x), bf_lo(h4.y), bf_hi(h4.y)}, v1 = acc[ai][bj][m][1] + (f32x4){bf_lo(h4.z), bf_hi(h4.z), bf_lo(h4.w), bf_hi(h4.w)};
                        *(u32x4*)(hb + off0 + (size_t)(ai * 128 + m * 16) * D + bj * 128) = pack8(v0, v1);
                        ss += (v0[0] * v0[0] + v0[1] * v0[1]) + (v0[2] * v0[2] + v0[3] * v0[3]) + (v1[0] * v1[0] + v1[1] * v1[1]) + (v1[2] * v1[2] + v1[3] * v1[3]);
                    }
                    ss += __shfl_xor(ss, 16); ss += __shfl_xor(ss, 32);
                    if (fq == 0) ssq[(size_t)EPI_ROW(ai, m) * 16 + un.pn * 4 + wc] = ss;
                }
        } else {
#pragma unroll
            for (int aim = 0; aim < 4; ++aim) {
                const int ai = aim >> 1;
                f32x4 rv[4][2][2];
#pragma unroll
                for (int m = 2 * (aim & 1); m < 2 * (aim & 1) + 2; ++m)
#pragma unroll
                    for (int bj = 0; bj < 2; ++bj) { const float* p = (const float*)resb + off0 + (size_t)(ai * 128 + m * 16) * D + bj * 128; rv[m][bj][0] = *(const f32x4*)p; rv[m][bj][1] = *(const f32x4*)(p + 4); }
#pragma unroll
                for (int m = 2 * (aim & 1); m < 2 * (aim & 1) + 2; ++m) {
                    float ss = 0.f;
#pragma unroll
                    for (int bj = 0; bj < 2; ++bj) {
                        const f32x4 v0 = acc[ai][bj][m][0] + rv[m][bj][0], v1 = acc[ai][bj][m][1] + rv[m][bj][1];
                        *(u32x4*)(hb + off0 + (size_t)(ai * 128 + m * 16) * D + bj * 128) = pack8(v0, v1);
                        ss += (v0[0] * v0[0] + v0[1] * v0[1]) + (v0[2] * v0[2] + v0[3] * v0[3]) + (v1[0] * v1[0] + v1[1] * v1[1]) + (v1[2] * v1[2] + v1[3] * v1[3]);
                    }
                    ss += __shfl_xor(ss, 16); ss += __shfl_xor(ss, 32);
                    if (fq == 0) ssq[(size_t)EPI_ROW(ai, m) * 16 + un.pn * 4 + wc] = ss;
                }
                asm volatile("" ::: "memory");
            }
        }
    }
};
struct EpiFinal {
    const bf16_t* hb; float* out; float* ssqp; unsigned* cnt; const float* g;
    __device__ __forceinline__ void operator()(f32x4 (&acc)[2][2][4][2], const Unit& un, int wr, int wc, int fr, int fq) const {
        const size_t off0 = (size_t)(un.pm * 256 + wr * 64 + fr) * D + un.pn * 256 + wc * 32 + 8 * fq;
        {
            u32x4 hv[2][4][2];
#pragma unroll
            for (int ai = 0; ai < 2; ++ai)
#pragma unroll
                for (int m = 0; m < 4; ++m)
#pragma unroll
                    for (int bj = 0; bj < 2; ++bj) hv[ai][m][bj] = *(const u32x4*)(hb + off0 + (size_t)(ai * 128 + m * 16) * D + bj * 128);
#pragma unroll
            for (int ai = 0; ai < 2; ++ai)
#pragma unroll
                for (int m = 0; m < 4; ++m) {
                    float ss = 0.f;
#pragma unroll
                    for (int bj = 0; bj < 2; ++bj) {
                        const u32x4 h4 = hv[ai][m][bj];
                        const f32x4 v0 = acc[ai][bj][m][0] + (f32x4){bf_lo(h4.x), bf_hi(h4.x), bf_lo(h4.y), bf_hi(h4.y)}, v1 = acc[ai][bj][m][1] + (f32x4){bf_lo(h4.z), bf_hi(h4.z), bf_lo(h4.w), bf_hi(h4.w)};
                        acc[ai][bj][m][0] = v0; acc[ai][bj][m][1] = v1;
                        ss += (v0[0] * v0[0] + v0[1] * v0[1]) + (v0[2] * v0[2] + v0[3] * v0[3]) + (v1[0] * v1[0] + v1[1] * v1[1]) + (v1[2] * v1[2] + v1[3] * v1[3]);
                    }
                    ss += __shfl_xor(ss, 16); ss += __shfl_xor(ss, 32);
                    if (fq == 0) __hip_atomic_store(ssqp + ((size_t)un.pn * M + EPI_ROW(ai, m)) * 4 + wc, ss, __ATOMIC_RELAXED, __HIP_MEMORY_SCOPE_AGENT);
                }
        }
        asm volatile("s_waitcnt vmcnt(0)" ::: "memory");
        if ((threadIdx.x & 63) == 0) __hip_atomic_fetch_add(cnt + 64 * un.pm, 1u, __ATOMIC_RELAXED, __HIP_MEMORY_SCOPE_AGENT);
        f32x4 gg[2][2];
#pragma unroll
        for (int bj = 0; bj < 2; ++bj)
#pragma unroll
            for (int n = 0; n < 2; ++n) gg[bj][n] = *(const f32x4*)(g + un.pn * 256 + bj * 128 + wc * 32 + 8 * fq + 4 * n);
        if (wr == 0 && wc == 0) {
            unsigned sp = 0;
            while ((unsigned)__builtin_amdgcn_readfirstlane(__hip_atomic_load(cnt + 64 * un.pm, __ATOMIC_RELAXED, __HIP_MEMORY_SCOPE_AGENT)) < 32u) { __builtin_amdgcn_s_sleep(2); if (++sp > (1u << 22)) break; }
            __builtin_amdgcn_fence(__ATOMIC_ACQUIRE, "agent");
        }
        asm volatile("s_waitcnt vmcnt(0) lgkmcnt(0)" ::: "memory"); __builtin_amdgcn_s_barrier(); asm volatile("" ::: "memory");
        float rr[2][4];
        {
            unsigned long long p0[2][4], p1[2][4];
#pragma unroll
            for (int ai = 0; ai < 2; ++ai)
#pragma unroll
                for (int m = 0; m < 4; ++m) { const unsigned long long* sp8 = (const unsigned long long*)(ssqp + ((size_t)fq * M + EPI_ROW(ai, m)) * 4);
                    p0[ai][m] = __hip_atomic_load(sp8, __ATOMIC_RELAXED, __HIP_MEMORY_SCOPE_AGENT); p1[ai][m] = __hip_atomic_load(sp8 + 1, __ATOMIC_RELAXED, __HIP_MEMORY_SCOPE_AGENT); }
#pragma unroll
            for (int ai = 0; ai < 2; ++ai)
#pragma unroll
                for (int m = 0; m < 4; ++m) {
                    float t = (__uint_as_float((unsigned)p0[ai][m]) + __uint_as_float((unsigned)(p0[ai][m] >> 32))) + (__uint_as_float((unsigned)p1[ai][m]) + __uint_as_float((unsigned)(p1[ai][m] >> 32)));
                    t += __shfl_xor(t, 16); t += __shfl_xor(t, 32);
                    rr[ai][m] = 1.0f / sqrtf(t * (1.0f / D) + RMS_EPS);
                }
        }
#pragma unroll
        for (int ai = 0; ai < 2; ++ai)
#pragma unroll
            for (int m = 0; m < 4; ++m) {
                const float r = rr[ai][m];
#pragma unroll
                for (int bj = 0; bj < 2; ++bj) {
                    float* op = out + off0 + (size_t)(ai * 128 + m * 16) * D + bj * 128;
                    *(f32x4*)op = acc[ai][bj][m][0] * r * gg[bj][0]; *(f32x4*)(op + 4) = acc[ai][bj][m][1] * r * gg[bj][1];
                }
            }
    }
};
__device__ __forceinline__ float row_rs(const float* ssq, int row, int fq) {
    const f32x4 p = *(const f32x4*)(ssq + (size_t)row * 16 + 4 * fq);
    float s = (p[0] + p[1]) + (p[2] + p[3]); s += __shfl_xor(s, 16); s += __shfl_xor(s, 32);
    return __builtin_amdgcn_rsqf(s * (1.0f / D) + RMS_EPS);
}
struct EpiQ {
    bf16_t* q; const float* ssq;
    __device__ __forceinline__ void operator()(const f32x4 (&acc)[2][2][4][2], const Unit& un, int wr, int wc, int fr, int fq) const {
        float rsv[2][4];
#pragma unroll
        for (int ai = 0; ai < 2; ++ai)
#pragma unroll
            for (int m = 0; m < 4; ++m) rsv[ai][m] = row_rs(ssq, EPI_ROW(ai, m), fq);
#pragma unroll
        for (int ai = 0; ai < 2; ++ai)
#pragma unroll
            for (int m = 0; m < 4; ++m) {
                const int row = EPI_ROW(ai, m); const float r = rsv[ai][m] * QSCALE;
#pragma unroll
                for (int bj = 0; bj < 2; ++bj)
                    *(u32x4*)(q + (size_t)row * D + un.pn * 256 + bj * 128 + wc * 32 + 8 * fq) = pack8(acc[ai][bj][m][0] * r, acc[ai][bj][m][1] * r);
            }
    }
};
struct EpiGU {
    bf16_t* act; const float* ssq;
    __device__ __forceinline__ void operator()(const f32x4 (&acc)[2][2][4][2], const Unit& un, int wr, int wc, int fr, int fq) const {
        float rsv[2][4];
#pragma unroll
        for (int ai = 0; ai < 2; ++ai)
#pragma unroll
            for (int m = 0; m < 4; ++m) rsv[ai][m] = row_rs(ssq, EPI_ROW(ai, m), fq);
#pragma unroll
        for (int ai = 0; ai < 2; ++ai)
#pragma unroll
            for (int m = 0; m < 4; ++m) {
                const int row = EPI_ROW(ai, m); const float r = rsv[ai][m];
                f32x4 v[2];
#pragma unroll
                for (int n = 0; n < 2; ++n)
#pragma unroll
                    for (int j = 0; j < 4; j += 2) { const float g0 = acc[ai][0][m][n][j] * r, g1 = acc[ai][0][m][n][j + 1] * r; const f32x2 sg = sigmoid2_(g0, g1);
                        v[n][j] = g0 * sg[0] * (acc[ai][1][m][n][j] * r); v[n][j + 1] = g1 * sg[1] * (acc[ai][1][m][n][j + 1] * r); }
                *(u32x4*)(act + (size_t)row * FF + un.pn * 128 + wc * 32 + 8 * fq) = pack8(v[0], v[1]);
            }
    }
};

__device__ __forceinline__ void p0_transpose_item(const float* W, int N, bf16_t* WT, int K, int dest_row0, const float* gk, LAS float* scr, int k0, int n0, int lane) {
    float v[32];
    const float* wp = W + (size_t)(k0 + (lane >> 5)) * N + n0 + (lane & 31);
#pragma unroll
    for (int i = 0; i < 32; ++i) v[i] = wp[(size_t)(2 * i) * N];
    if (gk) {
        const float gv = gk[k0 + lane];
#pragma unroll
        for (int i = 0; i < 32; ++i) v[i] *= __shfl(gv, 2 * i + (lane >> 5));
    }
#pragma unroll
    for (int i = 0; i < 32; ++i) scr[(2 * i + (lane >> 5)) * 33 + (lane & 31)] = v[i];
    asm volatile("s_waitcnt lgkmcnt(0)" ::: "memory");
    const int c = lane & 7;
#pragma unroll
    for (int j = 0; j < 4; ++j) { const int n = (lane >> 3) + 8 * j; const LAS float* s = scr + (8 * c) * 33 + n;
        u32x4 o; o.x = cvt_pk_bf16(s[0 * 33], s[1 * 33]); o.y = cvt_pk_bf16(s[2 * 33], s[3 * 33]); o.z = cvt_pk_bf16(s[4 * 33], s[5 * 33]); o.w = cvt_pk_bf16(s[6 * 33], s[7 * 33]);
        *(u32x4*)(WT + (size_t)(dest_row0 + n) * K + k0 + 8 * c) = o; }
    asm volatile("s_waitcnt lgkmcnt(0)" ::: "memory");
}
__device__ __forceinline__ void rms_row_to_bf16(const float* xrow, const float* g, bf16_t* orow, int lane) {
    const f32x4* xr = (const f32x4*)xrow + lane; const f32x4* gr = (const f32x4*)g + lane;
    f32x4 v[4]; float s = 0.f;
#pragma unroll
    for (int j = 0; j < 4; ++j) { v[j] = xr[64 * j]; s += (v[j][0] * v[j][0] + v[j][1] * v[j][1]) + (v[j][2] * v[j][2] + v[j][3] * v[j][3]); }
    const float r = 1.0f / sqrtf(wave_sum(s) * (1.0f / D) + RMS_EPS);
    u32x2* o8 = (u32x2*)orow + lane;
#pragma unroll
    for (int j = 0; j < 4; ++j) { const f32x4 gg = gr[64 * j]; u32x2 w; w.x = cvt_pk_bf16(v[j][0] * r * gg[0], v[j][1] * r * gg[1]); w.y = cvt_pk_bf16(v[j][2] * r * gg[2], v[j][3] * r * gg[3]); o8[64 * j] = w; }
}

struct Args { const float* in[23]; float* out; unsigned char* ws; unsigned long long never; };

__device__ __forceinline__ void rms_row2_to_bf16(const float* xrow, const float* g, bf16_t* orow, int lane) {
    const f32x4* xr = (const f32x4*)xrow + lane; const f32x4* gr = (const f32x4*)g + lane;
    f32x4 v[8]; float s0 = 0.f, s1 = 0.f;
#pragma unroll
    for (int j = 0; j < 8; ++j) v[j] = xr[64 * j];
#pragma unroll
    for (int j = 0; j < 4; ++j) { s0 += (v[j][0] * v[j][0] + v[j][1] * v[j][1]) + (v[j][2] * v[j][2] + v[j][3] * v[j][3]); s1 += (v[4 + j][0] * v[4 + j][0] + v[4 + j][1] * v[4 + j][1]) + (v[4 + j][2] * v[4 + j][2] + v[4 + j][3] * v[4 + j][3]); }
    const float r0 = 1.0f / sqrtf(wave_sum(s0) * (1.0f / D) + RMS_EPS), r1 = 1.0f / sqrtf(wave_sum(s1) * (1.0f / D) + RMS_EPS);
    u32x2* o8 = (u32x2*)orow + lane;
#pragma unroll
    for (int j = 0; j < 4; ++j) { const f32x4 gg = gr[64 * j]; u32x2 w;
        w.x = cvt_pk_bf16(v[j][0] * r0 * gg[0], v[j][1] * r0 * gg[1]); w.y = cvt_pk_bf16(v[j][2] * r0 * gg[2], v[j][3] * r0 * gg[3]); o8[64 * j] = w;
        w.x = cvt_pk_bf16(v[4 + j][0] * r1 * gg[0], v[4 + j][1] * r1 * gg[1]); w.y = cvt_pk_bf16(v[4 + j][2] * r1 * gg[2], v[4 + j][3] * r1 * gg[3]); o8[256 + 64 * j] = w; }
}
__device__ __forceinline__ void rms_row4_to_bf16(const float* xrow, const float* g, bf16_t* orow, int lane) {
    const f32x4* xr = (const f32x4*)xrow + lane; const f32x4* gr = (const f32x4*)g + lane;
    f32x4 v[16]; float ss[4];
#pragma unroll
    for (int j = 0; j < 16; ++j) v[j] = xr[64 * j];
#pragma unroll
    for (int r = 0; r < 4; ++r) { float s = 0.f;
#pragma unroll
        for (int j = 0; j < 4; ++j) s += (v[4 * r + j][0] * v[4 * r + j][0] + v[4 * r + j][1] * v[4 * r + j][1]) + (v[4 * r + j][2] * v[4 * r + j][2] + v[4 * r + j][3] * v[4 * r + j][3]);
        ss[r] = s; }
#pragma unroll
    for (int o = 1; o < 64; o <<= 1) {
#pragma unroll
        for (int r = 0; r < 4; ++r) ss[r] += __shfl_xor(ss[r], o); }
    u32x2* o8 = (u32x2*)orow + lane;
#pragma unroll
    for (int j = 0; j < 4; ++j) { const f32x4 gg = gr[64 * j];
#pragma unroll
        for (int r = 0; r < 4; ++r) { const float rr = 1.0f / sqrtf(ss[r] * (1.0f / D) + RMS_EPS); const f32x4 x = v[4 * r + j]; u32x2 w;
            w.x = cvt_pk_bf16(x[0] * rr * gg[0], x[1] * rr * gg[1]); w.y = cvt_pk_bf16(x[2] * rr * gg[2], x[3] * rr * gg[3]); o8[256 * r + 64 * j] = w; } }
}
__device__ __forceinline__ void x_row4_to_bf16(const float* xrow, bf16_t* orow, float* rx, int lane) {
    const f32x4* xr = (const f32x4*)xrow + lane;
    f32x4 v[16]; float ss[4];
#pragma unroll
    for (int j = 0; j < 16; ++j) v[j] = xr[64 * j];
    u32x2* o8 = (u32x2*)orow + lane;
#pragma unroll
    for (int r = 0; r < 4; ++r) { float s = 0.f;
#pragma unroll
        for (int j = 0; j < 4; ++j) { const f32x4 x = v[4 * r + j]; s += (x[0] * x[0] + x[1] * x[1]) + (x[2] * x[2] + x[3] * x[3]);
            u32x2 w; w.x = cvt_pk_bf16(x[0], x[1]); w.y = cvt_pk_bf16(x[2], x[3]); o8[256 * r + 64 * j] = w; }
        ss[r] = s; }
#pragma unroll
    for (int o = 1; o < 64; o <<= 1) {
#pragma unroll
        for (int r = 0; r < 4; ++r) ss[r] += __shfl_xor(ss[r], o); }
    if (lane < 4) rx[lane] = 1.0f / sqrtf((lane == 0 ? ss[0] : lane == 1 ? ss[1] : lane == 2 ? ss[2] : ss[3]) * (1.0f / D) + RMS_EPS);
}
__device__ __forceinline__ void p0_prologue(const Args& a, LAS unsigned char* lds, int bid, int G, int wid, int lane) {
    LAS float* scr = (LAS float*)(lds + wid * 16384);
    const int gw = bid * 8 + wid, NGW = G * 8;
    unsigned char* ws = a.ws;
    constexpr int I0 = 16 * 64, I1 = 16 * 32, I3 = 16 * 64;
    constexpr int NITEMS = I0 + I1 + I3;
    for (int it = gw; it < NITEMS; it += NGW) {
        int r = it;
        if (r < I0) { const int nb = r % 64, kb = r / 64, n0 = nb * 32; int dr = n0;
            if (n0 < 1024) { const int half = n0 / 512, c = n0 % 512; dr = 256 * (c / 128) + 128 * half + (c % 128); }
            p0_transpose_item(a.in[3], 2048, (bf16_t*)(ws + WS_BT1), 1024, dr, a.in[2], scr, kb * 64, n0, lane); continue; } r -= I0;
        if (r < I1) { p0_transpose_item(a.in[13], 1024, (bf16_t*)(ws + WS_WOUT), 1024, (r % 32) * 32, nullptr, scr, (r / 32) * 64, (r % 32) * 32, lane); continue; } r -= I1;
        p0_transpose_item(a.in[17], 2048, (bf16_t*)(ws + WS_WKV), 1024, (r % 64) * 32, nullptr, scr, (r / 64) * 64, (r % 64) * 32, lane);
    }
    for (int m = 4 * gw; m < M; m += 4 * NGW) x_row4_to_bf16(a.in[0] + (size_t)m * D, (bf16_t*)(ws + WS_HN) + (size_t)m * D, (float*)(ws + WS_RX) + m, lane);
    for (int m = gw; m < MR; m += NGW) rms_row_to_bf16(a.in[1] + (size_t)m * D, a.in[15], (bf16_t*)(ws + WS_MN) + (size_t)m * D, lane);
    for (int rr = gw; rr < 8 * 128; rr += NGW) {
        const int t = rr & 127; const f32x2 wv = *(const f32x2*)(a.in[11] + (size_t)rr * 128 + 2 * lane);
        ((unsigned*)(ws + WS_WSB))[(size_t)rr * 64 + lane] = cvt_pk_bf16(2 * lane <= t ? wv[0] : 0.f, 2 * lane + 1 <= t ? wv[1] : 0.f);
    }
}
struct LwItem { const float* wp; const float* gk; bf16_t* wt; int N, K, k0; };
__device__ __forceinline__ LwItem lw_decode(const Args& a, unsigned char* ws, int it, int lane) {
    constexpr int I2 = 16 * 32, I4 = 16 * 32, I5 = 16 * 176;
    const float* W; const float* gk = nullptr; bf16_t* WT; int N, K = 1024, k0, n0, dr;
    if (it < I2) { W = a.in[16]; gk = a.in[14]; WT = (bf16_t*)(ws + WS_WQ); N = 1024; k0 = (it / 32) * 64; n0 = (it % 32) * 32; dr = n0; }
    else if (it < I2 + I4) { const int r = it - I2; W = a.in[18]; WT = (bf16_t*)(ws + WS_WO); N = 1024; k0 = (r / 32) * 64; n0 = (r % 32) * 32; dr = n0; }
    else if (it < I2 + I4 + I5) { const int r = it - I2 - I4; W = a.in[20]; gk = a.in[19]; WT = (bf16_t*)(ws + WS_WGU); N = 2 * FF; k0 = (r / 176) * 64; n0 = (r % 176) * 32;
        const int half = n0 / FF, c = n0 % FF; dr = 256 * (c / 128) + 128 * half + (c % 128); }
    else { const int r = it - I2 - I4 - I5; W = a.in[21]; WT = (bf16_t*)(ws + WS_WD); N = 1024; K = FF; k0 = (r / 32) * 64; n0 = (r % 32) * 32; dr = n0; }
    LwItem d; d.wp = W + (size_t)(k0 + (lane >> 5)) * N + n0 + (lane & 31); d.gk = gk; d.wt = WT + (size_t)dr * K + k0; d.N = N; d.K = K; d.k0 = k0; return d;
}
__device__ __forceinline__ void late_weights(const Args& a, LAS unsigned char* lds, int gw, int NGW, int wid, int lane) {
    LAS float* scr = (LAS float*)(lds + wid * 16384);
    unsigned char* ws = a.ws;
    constexpr int NITEMS = 16 * 32 + 16 * 32 + 16 * 176 + 44 * 32;
    if (gw >= NITEMS) return;
    LwItem cur = lw_decode(a, ws, gw, lane);
    float v[32];
#pragma unroll
    for (int i = 0; i < 32; ++i) v[i] = cur.wp[(size_t)(2 * i) * cur.N];
    for (int it = gw; it < NITEMS; it += NGW) {
        const bool has_next = it + NGW < NITEMS;
        LwItem nxt = cur; float nv[32];
        if (has_next) { nxt = lw_decode(a, ws, it + NGW, lane);
#pragma unroll
            for (int i = 0; i < 32; ++i) nv[i] = nxt.wp[(size_t)(2 * i) * nxt.N]; }
        if (cur.gk) { const float gv = cur.gk[cur.k0 + lane];
#pragma unroll
            for (int i = 0; i < 32; ++i) v[i] *= __shfl(gv, 2 * i + (lane >> 5)); }
#pragma unroll
        for (int i = 0; i < 32; ++i) scr[(2 * i + (lane >> 5)) * 33 + (lane & 31)] = v[i];
        asm volatile("s_waitcnt lgkmcnt(0)" ::: "memory");
        const int c = lane & 7;
#pragma unroll
        for (int j = 0; j < 4; ++j) { const int n = (lane >> 3) + 8 * j; const LAS float* sp = scr + (8 * c) * 33 + n;
            u32x4 o; o.x = cvt_pk_bf16(sp[0 * 33], sp[1 * 33]); o.y = cvt_pk_bf16(sp[2 * 33], sp[3 * 33]); o.z = cvt_pk_bf16(sp[4 * 33], sp[5 * 33]); o.w = cvt_pk_bf16(sp[6 * 33], sp[7 * 33]);
            *(u32x4*)(cur.wt + (size_t)n * cur.K + 8 * c) = o; }
        asm volatile("s_waitcnt lgkmcnt(0)" ::: "memory");
        if (has_next) {
#pragma unroll
            for (int i = 0; i < 32; ++i) v[i] = nv[i];
            cur = nxt; }
    }
}

template <int NT> __device__ __forceinline__ void conv_unit(const Args& a, LAS unsigned char* lds, int unit, int tid, int wid, int lane) {
    unsigned char* ws = a.ws;
    const bf16_t* aglu = (const bf16_t*)(ws + WS_AGLU); const bf16_t* ub = (const bf16_t*)(ws + WS_U); const bf16_t* gvT = (const bf16_t*)(ws + WS_GVT);
    const bf16_t* wsb = (const bf16_t*)(ws + WS_WSB); bf16_t* mix = (bf16_t*)(ws + WS_MIX);
    const int t0 = unit * NT, p0 = t0 & (SEQ - 1);
    constexpr int HT = NT / 2, NB = NT / 16;
    {
        const int cp = tid & 255, th = tid >> 8;
        f32x2 w[31];
#pragma unroll
        for (int k = 0; k < 31; ++k) w[k] = *(const f32x2*)(a.in[5] + k * CW + 2 * cp);
        const f32x2 cb = *(const f32x2*)(a.in[6] + 2 * cp);
        const int base = t0 + HT * th;
        const int pbase = p0 + HT * th;
        const unsigned* arow = (const unsigned*)aglu + cp;
        f32x2 win[38];
#pragma unroll
        for (int i = 0; i < 30; ++i) { const bool ok = (pbase - 30 + i) >= 0; const unsigned v = ok ? arow[(size_t)(base - 30 + i) * 256] : 0u; win[i] = (f32x2){bf_lo(v), bf_hi(v)}; }
        unsigned nx[8], nx2[8];
#pragma unroll
        for (int i = 0; i < 8; ++i) nx[i] = arow[(size_t)(base + i) * 256];
#pragma unroll
        for (int i = 0; i < 8; ++i) nx2[i] = arow[(size_t)(base + 8 + i) * 256];
        for (int blk = 0; blk < NB; ++blk) {
#pragma unroll
            for (int i = 0; i < 8; ++i) win[30 + i] = (f32x2){bf_lo(nx[i]), bf_hi(nx[i])};
#pragma unroll
            for (int i = 0; i < 8; ++i) nx[i] = nx2[i];
            if (blk < NB - 2) {
#pragma unroll
                for (int i = 0; i < 8; ++i) nx2[i] = arow[(size_t)(base + 8 * (blk + 2) + i) * 256];
            }
#pragma unroll
            for (int o = 0; o < 8; ++o) {
                f32x2 s = cb;
#pragma unroll
                for (int k = 0; k < 31; ++k) s += w[k] * win[o + k];
                *(LAS unsigned*)(lds + (size_t)(HT * th + 8 * blk + o) * 1024 + cp * 4) = cvt_pk_bf16(s[0], s[1]);
            }
#pragma unroll
            for (int i = 0; i < 30; ++i) win[i] = win[i + 8];
        }
    }
    __syncthreads();
    {
        f32x4 g0 = *(const f32x4*)(a.in[7] + 8 * lane), g1 = *(const f32x4*)(a.in[7] + 8 * lane + 4);
        f32x4 b0 = *(const f32x4*)(a.in[8] + 8 * lane), b1 = *(const f32x4*)(a.in[8] + 8 * lane + 4);
        for (int i = 0; i < NT / 8; ++i) {
            const int tok = wid * (NT / 8) + i;
            const u32x4 raw = *(const LAS u32x4*)(lds + (size_t)tok * 1024 + lane * 16);
            f32x4 x0 = {bf_lo(raw.x), bf_hi(raw.x), bf_lo(raw.y), bf_hi(raw.y)}, x1 = {bf_lo(raw.z), bf_hi(raw.z), bf_lo(raw.w), bf_hi(raw.w)};
            const float mean = wave_sum((x0[0] + x0[1]) + (x0[2] + x0[3]) + (x1[0] + x1[1]) + (x1[2] + x1[3])) * (1.0f / CW);
            x0 = x0 - mean; x1 = x1 - mean;
            const float var = wave_sum((x0[0] * x0[0] + x0[1] * x0[1]) + (x0[2] * x0[2] + x0[3] * x0[3]) + (x1[0] * x1[0] + x1[1] * x1[1]) + (x1[2] * x1[2] + x1[3] * x1[3])) * (1.0f / CW);
            const float rstd = 1.0f / sqrtf(var + LN_EPS);
            f32x4 y0 = x0 * rstd * g0 + b0, y1 = x1 * rstd * g1 + b1;
#pragma unroll
            for (int j = 0; j < 4; ++j) { y0[j] = siluf_(y0[j]); y1[j] = siluf_(y1[j]); }
            *(u32x4*)(mix + (size_t)(t0 + tok) * D + 8 * lane) = pack8(y0, y1);
        }
    }
    __syncthreads();
}
__device__ __forceinline__ void gmlp_unit(const Args& a, LAS unsigned char* lds, int chunk, int tid, int wid, int lane) {
    unsigned char* ws = a.ws;
    const bf16_t* ub = (const bf16_t*)(ws + WS_U); const bf16_t* gvT = (const bf16_t*)(ws + WS_GVT);
    const bf16_t* wsb = (const bf16_t*)(ws + WS_WSB); bf16_t* mix = (bf16_t*)(ws + WS_MIX);
    const int t0 = chunk * CHUNK;
    constexpr int LDG = 264;
    LAS unsigned char* part = lds + 512 * LDG;
    LAS f32x2* stat = (LAS f32x2*)(lds + 512 * LDG + 8192);
    const int h = wid, fr = lane & 15, fq = lane >> 4;
    bf16x8 Bf[20];
    const bf16_t* wb = wsb + (size_t)(h * 128 + fr) * 128 + 8 * fq;
    {
        int n = 0;
#pragma unroll
        for (int ks = 0; ks < 2; ++ks)
#pragma unroll
            for (int tb = 0; tb < 4; ++tb) { if (tb < 2 * ks) continue; Bf[n++] = *(const bf16x8*)(wb + (size_t)(16 * tb) * 128 + 32 * ks); }
    }
    const bf16_t* ubase = ub + (size_t)(t0 + fr) * GW + 64 * h + 4 * fq;
    u32x2 uu[2][4][4];
#pragma unroll
    for (int tb = 0; tb < 4; ++tb)
#pragma unroll
        for (int db = 0; db < 4; ++db) uu[0][tb][db] = *(const u32x2*)(ubase + (size_t)(16 * tb) * GW + 16 * db);
    {
        const bf16_t* gp = gvT + (size_t)(tid >> 4) * M + t0 + (tid & 15) * 8;
        LAS unsigned char* lp = lds + (tid >> 4) * LDG + (tid & 15) * 16;
        u32x4 tr[16];
#pragma unroll
        for (int p = 0; p < 16; ++p) tr[p] = *(const u32x4*)(gp + (size_t)(32 * p) * M);
#pragma unroll
        for (int p = 0; p < 16; ++p) *(LAS u32x4*)(lp + 32 * p * LDG) = tr[p];
    }
    __syncthreads();
    {
        const int tg = tid & 15, cgp = tid >> 4;
        float sm[8], sq[8];
#pragma unroll
        for (int j = 0; j < 8; ++j) { sm[j] = 0.f; sq[j] = 0.f; }
        const LAS unsigned char* rp = lds + (16 * cgp) * LDG + tg * 16;
#pragma unroll
        for (int c = 0; c < 16; ++c) { const u32x4 r = *(const LAS u32x4*)(rp + c * LDG);
            const float v[8] = {bf_lo(r.x), bf_hi(r.x), bf_lo(r.y), bf_hi(r.y), bf_lo(r.z), bf_hi(r.z), bf_lo(r.w), bf_hi(r.w)};
#pragma unroll
            for (int j = 0; j < 8; ++j) { sm[j] += v[j]; sq[j] += v[j] * v[j]; } }
#pragma unroll
        for (int j = 0; j < 8; ++j) { sm[j] += __shfl_xor(sm[j], 16); sm[j] += __shfl_xor(sm[j], 32); sq[j] += __shfl_xor(sq[j], 16); sq[j] += __shfl_xor(sq[j], 32); }
        if (lane < 16) {
#pragma unroll
            for (int j = 0; j < 8; ++j) *(LAS f32x2*)(part + ((size_t)wid * 128 + 8 * tg + j) * 8) = (f32x2){sm[j], sq[j]};
        }
        __syncthreads();
        if (tid < 128) { float ts = 0.f, tq2 = 0.f;
#pragma unroll
            for (int w = 0; w < 8; ++w) { const f32x2 p = *(const LAS f32x2*)(part + ((size_t)w * 128 + tid) * 8); ts += p[0]; tq2 += p[1]; }
            const float mean = ts * (1.0f / GW); const float var = fmaxf(tq2 * (1.0f / GW) - mean * mean, 0.f);
            stat[tid] = (f32x2){mean, 1.0f / sqrtf(var + LN_EPS)}; }
        __syncthreads();
    }
    {
        float lg[4], lb[4];
#pragma unroll
        for (int db = 0; db < 4; ++db) { lg[db] = a.in[9][64 * h + 16 * db + fr]; lb[db] = a.in[10][64 * h + 16 * db + fr]; }
        const LAS unsigned char* abase = lds + (64 * h + fr) * LDG + fq * 16;
        bf16_t* obase = mix + (size_t)(t0 + fr) * D + 512 + 64 * h + 4 * fq;
        int nb = 0;
#pragma unroll
        for (int th = 0; th < 2; ++th) {
            if (th == 0) {
#pragma unroll
                for (int tb = 0; tb < 4; ++tb)
#pragma unroll
                    for (int db = 0; db < 4; ++db) uu[1][tb][db] = *(const u32x2*)(ubase + (size_t)(16 * (4 + tb)) * GW + 16 * db);
            }
            f32x4 acc[4][4];
#pragma unroll
            for (int db = 0; db < 4; ++db)
#pragma unroll
                for (int tb = 0; tb < 4; ++tb) acc[db][tb] = (f32x4){0.f, 0.f, 0.f, 0.f};
#pragma unroll
            for (int ks = 0; ks < 2 * th + 2; ++ks) {
                float mu[8], rs[8];
#pragma unroll
                for (int j = 0; j < 8; ++j) { const f32x2 st = stat[32 * ks + 8 * fq + j]; mu[j] = st[0]; rs[j] = st[1]; }
                bf16x8 Af[4];
#pragma unroll
                for (int db = 0; db < 4; ++db) {
                    const u32x4 r = *(const LAS u32x4*)(abase + 16 * db * LDG + 64 * ks);
                    const float gg = lg[db], bb = lb[db];
                    u32x4 o;
                    o.x = cvt_pk_bf16((bf_lo(r.x) - mu[0]) * rs[0] * gg + bb, (bf_hi(r.x) - mu[1]) * rs[1] * gg + bb);
                    o.y = cvt_pk_bf16((bf_lo(r.y) - mu[2]) * rs[2] * gg + bb, (bf_hi(r.y) - mu[3]) * rs[3] * gg + bb);
                    o.z = cvt_pk_bf16((bf_lo(r.z) - mu[4]) * rs[4] * gg + bb, (bf_hi(r.z) - mu[5]) * rs[5] * gg + bb);
                    o.w = cvt_pk_bf16((bf_lo(r.w) - mu[6]) * rs[6] * gg + bb, (bf_hi(r.w) - mu[7]) * rs[7] * gg + bb);
                    Af[db] = __builtin_bit_cast(bf16x8, o);
                }
#pragma unroll
                for (int tb = 0; tb < 4; ++tb) {
                    if (4 * th + tb < 2 * ks) continue;
                    const bf16x8 bfr = Bf[nb++];
#pragma unroll
                    for (int db = 0; db < 4; ++db) acc[db][tb] = __builtin_amdgcn_mfma_f32_16x16x32_bf16(Af[db], bfr, acc[db][tb], 0, 0, 0);
                }
            }
            if (th == 0) {
                asm volatile("" ::: "memory");
                int n = 6;
#pragma unroll
                for (int ks = 0; ks < 4; ++ks)
#pragma unroll
                    for (int tb = 0; tb < 4; ++tb) { if (4 + tb < 2 * ks) continue; Bf[n++] = *(const bf16x8*)(wb + (size_t)(16 * (4 + tb)) * 128 + 32 * ks); }
                asm volatile("" ::: "memory");
            }
#pragma unroll
            for (int tb = 0; tb < 4; ++tb) {
                const float bs = a.in[12][h * 128 + 16 * (4 * th + tb) + fr];
#pragma unroll
                for (int db = 0; db < 4; ++db) {
                    u32x2 o; o.x = cvt_pk_bf16(bf_lo(uu[th][tb][db].x) * (acc[db][tb][0] + bs), bf_hi(uu[th][tb][db].x) * (acc[db][tb][1] + bs));
                    o.y = cvt_pk_bf16(bf_lo(uu[th][tb][db].y) * (acc[db][tb][2] + bs), bf_hi(uu[th][tb][db].y) * (acc[db][tb][3] + bs));
                    *(u32x2*)(obase + (size_t)(16 * (4 * th + tb)) * D + 16 * db) = o;
                }
            }
        }
    }
}

__device__ __forceinline__ void attn_unit(LAS unsigned char* lds, const bf16_t* q, const bf16_t* Km, const bf16_t* Vt, bf16_t* o, int pm, int h, int tid, int wid, int lane) {
    constexpr int LDK = 544, LDV = 528;
    const int fr = lane & 15, fq = lane >> 4, b = pm >> 4, row0 = pm * 256 + wid * 32;
    {
        const bf16_t* kg = Km + (size_t)(b * 256 + (tid >> 5)) * 1024 + h * 256 + (tid & 31) * 8;
        LAS unsigned char* kl = lds + (tid >> 5) * LDK + (tid & 31) * 16;
#pragma unroll
        for (int half = 0; half < 2; ++half) {
            u32x4 kr[8];
#pragma unroll
            for (int i = 0; i < 8; ++i) kr[i] = *(const u32x4*)(kg + (size_t)(half * 8 + i) * 16 * 1024);
#pragma unroll
            for (int i = 0; i < 8; ++i) *(LAS u32x4*)(kl + (half * 8 + i) * 16 * LDK) = kr[i];
        }
    }
    __syncthreads();
    bf16x8 Pf[2][8]; float inv[2];
    const bf16_t* qbase = q + (size_t)(row0 + fr) * D + h * 256 + 8 * fq;
#pragma unroll
    for (int qb = 0; qb < 2; ++qb) {
        bf16x8 Qf[8];
#pragma unroll
        for (int ks = 0; ks < 8; ++ks) Qf[ks] = *(const bf16x8*)(qbase + (size_t)(16 * qb) * D + 32 * ks);
        f32x4 S[16];
#pragma unroll
        for (int kb = 0; kb < 16; ++kb) S[kb] = (f32x4){0.f, 0.f, 0.f, 0.f};
        bf16x8 kf[2][4];
        const LAS unsigned char* kbase = lds + fr * LDK + fq * 16;
#pragma unroll
        for (int k4 = 0; k4 < 4; ++k4) kf[0][k4] = *(const LAS bf16x8*)(kbase + 64 * k4);
#pragma unroll
        for (int it = 0; it < 32; ++it) {
            if (it < 31) {
#pragma unroll
                for (int k4 = 0; k4 < 4; ++k4) kf[(it + 1) & 1][k4] = *(const LAS bf16x8*)(kbase + 16 * ((it + 1) >> 1) * LDK + 64 * (4 * ((it + 1) & 1) + k4));
            }
#pragma unroll
            for (int k4 = 0; k4 < 4; ++k4) S[it >> 1] = __builtin_amdgcn_mfma_f32_16x16x32_bf16(kf[it & 1][k4], Qf[4 * (it & 1) + k4], S[it >> 1], 0, 0, 0);
#pragma unroll
            for (int k4 = 0; k4 < 4; ++k4) { __builtin_amdgcn_sched_group_barrier(0x100, 1, 0); __builtin_amdgcn_sched_group_barrier(0x008, 1, 0); }
            __builtin_amdgcn_sched_barrier(0);
        }
        float mx = -3.0e38f;
#pragma unroll
        for (int kb = 0; kb < 16; ++kb) mx = fmaxf(fmaxf(fmaxf(S[kb][0], S[kb][1]), fmaxf(S[kb][2], S[kb][3])), mx);
        mx = fmaxf(mx, __shfl_xor(mx, 16)); mx = fmaxf(mx, __shfl_xor(mx, 32));
        float sum = 0.f;
#pragma unroll
        for (int kb = 0; kb < 16; ++kb)
#pragma unroll
            for (int j = 0; j < 4; ++j) { const float p = __builtin_amdgcn_exp2f(S[kb][j] - mx); S[kb][j] = p; sum += p; }
        sum += __shfl_xor(sum, 16); sum += __shfl_xor(sum, 32);
        inv[qb] = 1.0f / sum;
#pragma unroll
        for (int ks = 0; ks < 8; ++ks) { const u32x4 w = pack8(S[2 * ks], S[2 * ks + 1]); Pf[qb][ks] = __builtin_bit_cast(bf16x8, w); }
        asm volatile("" ::: "memory");
    }
    __syncthreads();
    {
        const bf16_t* vg = Vt + (size_t)(h * 256 + (tid >> 5)) * 1024 + b * 256 + (tid & 31) * 8;
        LAS unsigned char* vl = lds + (tid >> 5) * LDV + (tid & 31) * 16;
#pragma unroll
        for (int half = 0; half < 2; ++half) {
            u32x4 kr[8];
#pragma unroll
            for (int i = 0; i < 8; ++i) kr[i] = *(const u32x4*)(vg + (size_t)(half * 8 + i) * 16 * 1024);
#pragma unroll
            for (int i = 0; i < 8; ++i) *(LAS u32x4*)(vl + (half * 8 + i) * 16 * LDV) = kr[i];
        }
    }
    __syncthreads();
    const LAS unsigned char* vbase = lds + fr * LDV + fq * 8;
    bf16_t* obase = o + (size_t)(row0 + fr) * D + h * 256 + 4 * fq;
#pragma unroll
    for (int dh = 0; dh < 2; ++dh) {
        f32x4 O[2][8];
#pragma unroll
        for (int qb = 0; qb < 2; ++qb)
#pragma unroll
            for (int db = 0; db < 8; ++db) O[qb][db] = (f32x4){0.f, 0.f, 0.f, 0.f};
        u32x2 vlo[2][4], vhi[2][4];
#pragma unroll
        for (int k4 = 0; k4 < 4; ++k4) { const LAS unsigned char* vp = vbase + 128 * dh * LDV + 64 * k4; vlo[0][k4] = *(const LAS u32x2*)vp; vhi[0][k4] = *(const LAS u32x2*)(vp + 32); }
#pragma unroll
        for (int it = 0; it < 16; ++it) {
            if (it < 15) {
#pragma unroll
                for (int k4 = 0; k4 < 4; ++k4) { const LAS unsigned char* vp = vbase + (128 * dh + 16 * ((it + 1) >> 1)) * LDV + 64 * (4 * ((it + 1) & 1) + k4); vlo[(it + 1) & 1][k4] = *(const LAS u32x2*)vp; vhi[(it + 1) & 1][k4] = *(const LAS u32x2*)(vp + 32); }
            }
#pragma unroll
            for (int k4 = 0; k4 < 4; ++k4) {
                const u32x4 w = {vlo[it & 1][k4].x, vlo[it & 1][k4].y, vhi[it & 1][k4].x, vhi[it & 1][k4].y}; const bf16x8 vf = __builtin_bit_cast(bf16x8, w);
#pragma unroll
                for (int qb = 0; qb < 2; ++qb) O[qb][it >> 1] = __builtin_amdgcn_mfma_f32_16x16x32_bf16(vf, Pf[qb][4 * (it & 1) + k4], O[qb][it >> 1], 0, 0, 0);
            }
#pragma unroll
            for (int k4 = 0; k4 < 4; ++k4) { __builtin_amdgcn_sched_group_barrier(0x100, 2, 0); __builtin_amdgcn_sched_group_barrier(0x008, 2, 0); }
            __builtin_amdgcn_sched_barrier(0);
        }
#pragma unroll
        for (int qb = 0; qb < 2; ++qb)
#pragma unroll
            for (int db = 0; db < 8; ++db) {
                const f32x4 v = O[qb][db] * inv[qb]; u32x2 w; w.x = cvt_pk_bf16(v[0], v[1]); w.y = cvt_pk_bf16(v[2], v[3]);
                *(u32x2*)(obase + (size_t)(16 * qb) * D + 128 * dh + 16 * db) = w;
            }
    }
    __syncthreads();
}

#define PHASE_ARGS const Args& a, LAS unsigned char* lds, unsigned char* ws, int tid, int wid, int lane, int bid, int G
#define PHASE_CALL a, lds, ws, tid, wid, lane, bid, G
constexpr size_t TS1024 = (size_t)256 * 1024 * 2;

__device__ __forceinline__ void phase_p1(PHASE_ARGS) {
    pg8::Sched S{}; S.G = G; S.c = bid; S.tstep = TS1024;
    S.A0 = (const char*)(ws + WS_HN); S.B0 = (const char*)(ws + WS_BT1); S.nM0 = 64; S.nN0 = 4;
    S.A1 = (const char*)(ws + WS_HN); S.B1 = (const char*)(ws + WS_BT1) + (size_t)1024 * 2048; S.nM1 = 64; S.nN1 = 2;
    S.A2 = (const char*)(ws + WS_BT1) + (size_t)1536 * 2048; S.B2 = (const char*)(ws + WS_HN); S.nM2 = 2; S.nN2 = 64;
    EpiP1 E{(bf16_t*)(ws + WS_AGLU), (bf16_t*)(ws + WS_U), (bf16_t*)(ws + WS_GVT), a.in[4], (const float*)(ws + WS_RX)};
    pg8::gemm_phase(lds, 1024, S, E);
}
__device__ __forceinline__ void phase_p2(PHASE_ARGS) {
    conv_unit<64>(a, lds, bid, tid, wid, lane);
    if (bid < 128) {
        gmlp_unit(a, lds, bid, tid, wid, lane);
    } else if (bid < 160) {
        pg8::Sched S{}; S.G = 32; S.c = bid - 128; S.tstep = TS1024;
        S.A0 = (const char*)(ws + WS_MN); S.B0 = (const char*)(ws + WS_WKV); S.nM0 = 4; S.nN0 = 4;
        S.A1 = (const char*)(ws + WS_WKV) + (size_t)1024 * 2048; S.B1 = (const char*)(ws + WS_MN); S.nM1 = 4; S.nN1 = 4;
        EpiKV E{(bf16_t*)(ws + WS_KM), (bf16_t*)(ws + WS_VT)};
        pg8::gemm_phase(lds, 1024, S, E);
    } else {
        late_weights(a, lds, (bid - 160) * 8 + wid, 96 * 8, wid, lane);
    }
}
__device__ __forceinline__ void phase_p3(PHASE_ARGS) {
    pg8::Sched S{}; S.G = G; S.c = bid; S.tstep = TS1024;
    S.A0 = (const char*)(ws + WS_MIX); S.B0 = (const char*)(ws + WS_WOUT); S.nM0 = 64; S.nN0 = 4;
    EpiRes<true> E{(const bf16_t*)(ws + WS_HN), (bf16_t*)(ws + WS_HB), (float*)(ws + WS_SSQ1)};
    pg8::gemm_phase(lds, 1024, S, E);
}
__device__ __forceinline__ void phase_p4(PHASE_ARGS) {
    pg8::Sched S{}; S.G = 1 << 20; S.c = bid; S.tstep = TS1024;
    S.A0 = (const char*)(ws + WS_HB); S.B0 = (const char*)(ws + WS_WQ); S.nM0 = 64; S.nN0 = 4;
    Unit un; S.next(0, un);
    EpiQ E{(bf16_t*)(ws + WS_Q), (const float*)(ws + WS_SSQ1)};
    pg8::gemm_phase(lds, 1024, S, E);
    asm volatile("s_waitcnt vmcnt(0)" ::: "memory");
    __syncthreads();
    attn_unit(lds, (const bf16_t*)(ws + WS_Q), (const bf16_t*)(ws + WS_KM), (const bf16_t*)(ws + WS_VT), (bf16_t*)(ws + WS_HN), un.pm, un.pn, tid, wid, lane);
}
__device__ __forceinline__ void phase_p5(PHASE_ARGS) {
    pg8::Sched S{}; S.G = G; S.c = bid; S.tstep = TS1024;
    S.A0 = (const char*)(ws + WS_HN); S.B0 = (const char*)(ws + WS_WO); S.nM0 = 64; S.nN0 = 4;
    EpiRes<true> E{(const bf16_t*)(ws + WS_HB), (bf16_t*)(ws + WS_HB), (float*)(ws + WS_SSQ2)};
    pg8::gemm_phase(lds, 1024, S, E);
}
__device__ __forceinline__ void phase_p6(PHASE_ARGS) {
    pg8::Sched S{}; S.G = G; S.c = bid; S.tstep = TS1024;
    S.A0 = (const char*)(ws + WS_HB); S.B0 = (const char*)(ws + WS_WGU); S.nM0 = 64; S.nN0 = 22;
    EpiGU E{(bf16_t*)(ws + WS_ACT), (const float*)(ws + WS_SSQ2)};
    pg8::gemm_phase(lds, 1024, S, E);
}
__device__ __forceinline__ void phase_p7(PHASE_ARGS) {
    pg8::Sched S{}; S.G = G; S.c = bid; S.tstep = (size_t)256 * FF * 2;
    S.A0 = (const char*)(ws + WS_ACT); S.B0 = (const char*)(ws + WS_WD); S.nM0 = 64; S.nN0 = 4;
    EpiFinal E{(const bf16_t*)(ws + WS_HB), a.out, (float*)(ws + WS_SSQ3), (unsigned*)(ws + WS_CTL + 16384), a.in[22]};
    pg8::gemm_phase(lds, FF, S, E);
}
__global__ void __launch_bounds__(512, 2) fwd_mega(Args a) {
    extern __shared__ __attribute__((aligned(16))) unsigned char lds_raw[];
    LAS unsigned char* lds = (LAS unsigned char*)lds_raw;
    cg::grid_group grid = cg::this_grid();
    const int tid = threadIdx.x, wid = __builtin_amdgcn_readfirstlane(tid >> 6), lane = tid & 63, bid = blockIdx.x, G = gridDim.x;
    unsigned char* ws = a.ws;
    if (tid < 2) ((volatile LAS unsigned*)(lds + LDS_BYTES - 64))[tid] = 0u;
    __syncthreads();
    const XcdBarrier xbar = xcd_barrier_post((unsigned*)(ws + WS_CTL), (volatile LAS unsigned*)(lds + LDS_BYTES - 64));
    if (a.never != 0) grid.sync();
#define GRID_BAR() xcd_barrier(xbar)
    { p0_prologue(a, lds, bid, G, wid, lane); }
    GRID_BAR();
    phase_p1(PHASE_CALL); GRID_BAR();
    { phase_p2(PHASE_CALL);
    } GRID_BAR();
    phase_p3(PHASE_CALL); GRID_BAR();
    { phase_p4(PHASE_CALL); } GRID_BAR();
    { phase_p5(PHASE_CALL); } GRID_BAR();
    phase_p6(PHASE_CALL); GRID_BAR();
    phase_p7(PHASE_CALL);
}

extern "C" void kernel_launch(void* const* d_in, const int* in_sizes, int n_in, void* d_out, int out_size, void* d_ws, size_t ws_size, hipStream_t stream) {
    static int grid = 0;
    if (grid == 0) {
        int dev = 0, cus = 0, per_cu = 0;
        (void)hipGetDevice(&dev);
        (void)hipDeviceGetAttribute(&cus, hipDeviceAttributeMultiprocessorCount, dev);
        (void)hipFuncSetAttribute((const void*)fwd_mega, hipFuncAttributeMaxDynamicSharedMemorySize, LDS_BYTES);
        (void)hipOccupancyMaxActiveBlocksPerMultiprocessor(&per_cu, (const void*)fwd_mega, 512, LDS_BYTES);
        (void)hipGetLastError();
        grid = cus > 0 ? cus : 256;
        if (grid > 256) grid = 256;
    }
    Args a{};
    for (int i = 0; i < 23; ++i) a.in[i] = (const float*)d_in[i];
    a.out = (float*)d_out; a.ws = (unsigned char*)d_ws; a.never = 0ull;
    (void)hipMemsetAsync((char*)d_ws + WS_CTL, 0, CTL_ZERO_BYTES, stream);
    void* args[] = {&a};
    hipError_t e = hipLaunchCooperativeKernel((const void*)fwd_mega, dim3(grid), dim3(512), args, LDS_BYTES, stream);
    if (e != hipSuccess) fprintf(stderr, "cooperative launch failed: %s (grid %d)\n", hipGetErrorString(e), grid);
}
```

```cpp
#include <hip/hip_runtime.h>
#include <hip/hip_cooperative_groups.h>
#include <cstdio>
#include <cstdint>
namespace cg = cooperative_groups;

#define LAS __attribute__((address_space(3)))
typedef unsigned short bf16_t;
typedef short bf16x8 __attribute__((ext_vector_type(8)));
typedef float f32x4 __attribute__((ext_vector_type(4)));
typedef float f32x2 __attribute__((ext_vector_type(2)));
typedef unsigned u32x4 __attribute__((ext_vector_type(4)));
typedef unsigned u32x2 __attribute__((ext_vector_type(2)));

constexpr int D = 1024, NB = 4, SEQ = 4096, M = NB * SEQ, CW = 512, GW = 512, CHUNK = 128, MEML = 256, MR = NB * MEML, FF = 2816;
constexpr float RMS_EPS = 1e-6f, LN_EPS = 1e-5f;
constexpr float LOG2E = 1.4426950408889634f;
constexpr float QSCALE = 0.0625f * LOG2E;

constexpr size_t MiB = 1u << 20;
constexpr size_t WS_BT1 = 0 * MiB;
constexpr size_t WS_WOUT = 4 * MiB;
constexpr size_t WS_WQ = 6 * MiB;
constexpr size_t WS_WKV = 8 * MiB;
constexpr size_t WS_WO = 12 * MiB;
constexpr size_t WS_WGU = 14 * MiB;
constexpr size_t WS_WD = 25 * MiB;
constexpr size_t WS_WSB = 31 * MiB;
constexpr size_t WS_MN = 32 * MiB;
constexpr size_t WS_KM = 34 * MiB;
constexpr size_t WS_VT = 36 * MiB;
constexpr size_t WS_SSQ1 = 38 * MiB, WS_SSQ2 = 39 * MiB, WS_SSQ3 = 40 * MiB;
constexpr size_t WS_HB = 48 * MiB;
constexpr size_t WS_HN = 80 * MiB;
constexpr size_t WS_MIX = 176 * MiB;
constexpr size_t WS_RX = 42 * MiB;
constexpr size_t WS_AGLU = 112 * MiB;
constexpr size_t WS_U = 128 * MiB;
constexpr size_t WS_GVT = 144 * MiB;
constexpr size_t WS_Q = 112 * MiB;
constexpr size_t WS_ACT = 80 * MiB;
constexpr int LDS_BYTES = 147456;


constexpr size_t WS_CTL = 41 * MiB;
constexpr size_t CTL_ZERO_BYTES = 32768;
#define XB_TMO      128
#define XB_XCNT(j)  (256  + 64 * (j))
#define XB_XSUB(j)  (1280 + 64 * (j))
#define XB_XGEN(j)  (2304 + 64 * (j))
#define XB_TOP      3328
#define XB_TOPGEN   3392
#define XB_SPIN_CAP (1u << 18)
__device__ __forceinline__ unsigned xb_ld(unsigned* p)              { return __hip_atomic_load(p, __ATOMIC_RELAXED, __HIP_MEMORY_SCOPE_AGENT); }
__device__ __forceinline__ unsigned xb_add(unsigned* p, unsigned v) { return __hip_atomic_fetch_add(p, v, __ATOMIC_RELAXED, __HIP_MEMORY_SCOPE_AGENT); }
__device__ __forceinline__ unsigned xb_xcc_id() { return (unsigned)__builtin_amdgcn_s_getreg((3 << 11) | 20) & 0xFu; }
#define XB_SPIN(cond, bar) do { unsigned _sp = 0; while (cond) { __builtin_amdgcn_s_sleep(1); \
    if ((++_sp & 255u) == 0u) { if (xb_ld(&(bar)[XB_TMO])) break; if (_sp > XB_SPIN_CAP) { atomicAdd(&(bar)[XB_TMO], 1u); break; } } } } while (0)
struct XcdBarrier { unsigned* bar; unsigned x; volatile LAS unsigned* st; };
__device__ __forceinline__ XcdBarrier xcd_barrier_post(unsigned* bar, volatile LAS unsigned* st) {
    XcdBarrier b; b.bar = bar; b.x = xb_xcc_id(); b.st = st;
    if (threadIdx.x == 0) (void)xb_add(&bar[XB_XCNT(b.x)], 1u);
    return b;
}
__device__ __forceinline__ void xcd_barrier_complete(unsigned* bar, unsigned x, unsigned& nloc, unsigned& nx) {
    const unsigned G = gridDim.x * gridDim.y * gridDim.z;
    unsigned sum, cnt, mine, sp = 0u;
    for (;;) {
        sum = 0u; cnt = 0u; mine = 0u;
#pragma unroll
        for (unsigned j = 0; j < 16; ++j) { const unsigned c = xb_ld(&bar[XB_XCNT(j)]); sum += c; cnt += (c > 0u) ? 1u : 0u; mine = (j == x) ? c : mine; }
        if (sum == G) break;
        __builtin_amdgcn_s_sleep(1);
        if ((++sp & 255u) == 0u) { if (xb_ld(&bar[XB_TMO])) break; if (sp > XB_SPIN_CAP) { atomicAdd(&bar[XB_TMO], 1u); break; } }
    }
    nloc = mine > 0u ? mine : 1u; nx = cnt > 0u ? cnt : 1u;
}
__device__ __forceinline__ void xcd_barrier(const XcdBarrier& b) {
    asm volatile("s_waitcnt vmcnt(0)" ::: "memory");
    __syncthreads();
    if (threadIdx.x == 0) {
        unsigned* bar = b.bar;
        __builtin_amdgcn_s_waitcnt(0);
        unsigned nloc = b.st[0], nx = b.st[1];
        if (nloc == 0u) { xcd_barrier_complete(bar, b.x, nloc, nx); b.st[0] = nloc; b.st[1] = nx; }
        const unsigned old = xb_add(&bar[XB_XSUB(b.x)], 1u);
        const unsigned gen = old / nloc;
        if (old + 1u == (gen + 1u) * nloc) {
            __builtin_amdgcn_fence(__ATOMIC_RELEASE, "agent");
            asm volatile("s_waitcnt vmcnt(0)" ::: "memory");
            const unsigned og = xb_add(&bar[XB_TOP], 1u);
            const unsigned tg = og / nx;
            if (og + 1u == (tg + 1u) * nx) xb_add(&bar[XB_TOPGEN], 1u);
            else XB_SPIN(xb_ld(&bar[XB_TOPGEN]) == tg, bar);
            __builtin_amdgcn_fence(__ATOMIC_ACQUIRE, "agent");
            xb_add(&bar[XB_XGEN(b.x)], 1u);
            asm volatile("s_waitcnt vmcnt(0)" ::: "memory");
        } else {
            XB_SPIN(xb_ld(&bar[XB_XGEN(b.x)]) == gen, bar);
            __builtin_amdgcn_fence(__ATOMIC_ACQUIRE, "agent");
            asm volatile("s_waitcnt vmcnt(0)" ::: "memory");
        }
    }
    __syncthreads();
}

__device__ __forceinline__ unsigned cvt_pk_bf16(float lo, float hi) { unsigned r; asm volatile("v_cvt_pk_bf16_f32 %0, %1, %2" : "=v"(r) : "v"(lo), "v"(hi)); return r; }
__device__ __forceinline__ float bf_lo(unsigned u) { return __uint_as_float(u << 16); }
__device__ __forceinline__ float bf_hi(unsigned u) { return __uint_as_float(u & 0xffff0000u); }
__device__ __forceinline__ float sigmoidf_(float x) { return __builtin_amdgcn_rcpf(1.0f + __builtin_amdgcn_exp2f(-LOG2E * x)); }
__device__ __forceinline__ float siluf_(float x) { return x * sigmoidf_(x); }
__device__ __forceinline__ float geluf_(float x) { const float u = 0.7978845608028654f * (x + 0.044715f * x * x * x); return x * __builtin_amdgcn_rcpf(1.0f + __builtin_amdgcn_exp2f(-2.0f * LOG2E * u)); }
__device__ __forceinline__ f32x2 sigmoid2_(float x0, float x1) {
    const float a = 1.0f + __builtin_amdgcn_exp2f(fminf(-LOG2E * x0, 60.0f)), b = 1.0f + __builtin_amdgcn_exp2f(fminf(-LOG2E * x1, 60.0f));
    const float r = __builtin_amdgcn_rcpf(a * b);
    return (f32x2){r * b, r * a};
}
__device__ __forceinline__ f32x2 gelu2_(float x0, float x1) {
    const float u0 = 1.5957691216057308f * (x0 + 0.044715f * x0 * x0 * x0), u1 = 1.5957691216057308f * (x1 + 0.044715f * x1 * x1 * x1);
    const f32x2 sg = sigmoid2_(u0, u1); return (f32x2){x0 * sg[0], x1 * sg[1]};
}
__device__ __forceinline__ f32x4 swiglu4_(f32x4 ag, f32x4 au, float c1, float rr) {
    f32x4 t = ag * c1;
    t = __builtin_elementwise_min(t, (f32x4){60.f, 60.f, 60.f, 60.f});
    f32x4 e; e[0] = __builtin_amdgcn_exp2f(t[0]); e[1] = __builtin_amdgcn_exp2f(t[1]); e[2] = __builtin_amdgcn_exp2f(t[2]); e[3] = __builtin_amdgcn_exp2f(t[3]);
    const f32x4 a4 = e + 1.0f;
    const float r01 = __builtin_amdgcn_rcpf(a4[0] * a4[1]), r23 = __builtin_amdgcn_rcpf(a4[2] * a4[3]);
    const f32x4 sw = {a4[1], a4[0], a4[3], a4[2]}, rc = {r01, r01, r23, r23};
    return (ag * au) * ((rc * sw) * rr);
}
__device__ __forceinline__ f32x4 sig4_from_t_(f32x4 t) {
    t = __builtin_elementwise_min(t, (f32x4){60.f, 60.f, 60.f, 60.f});
    f32x4 e; e[0] = __builtin_amdgcn_exp2f(t[0]); e[1] = __builtin_amdgcn_exp2f(t[1]); e[2] = __builtin_amdgcn_exp2f(t[2]); e[3] = __builtin_amdgcn_exp2f(t[3]);
    const f32x4 a4 = e + 1.0f;
    const float r01 = __builtin_amdgcn_rcpf(a4[0] * a4[1]), r23 = __builtin_amdgcn_rcpf(a4[2] * a4[3]);
    const f32x4 sw = {a4[1], a4[0], a4[3], a4[2]}, rc = {r01, r01, r23, r23};
    return rc * sw;
}
__device__ __forceinline__ f32x4 glu4_(f32x4 za, f32x4 zg) { return za * sig4_from_t_(zg * (-LOG2E)); }
__device__ __forceinline__ f32x4 gelu4_(f32x4 x) {
    constexpr float CA = -LOG2E * 1.5957691216057308f, CB = CA * 0.044715f;
    return x * sig4_from_t_(x * ((x * x) * CB + CA));
}
__device__ __forceinline__ float wave_sum(float v) {
#pragma unroll
    for (int o = 1; o < 64; o <<= 1) v += __shfl_xor(v, o);
    return v;
}
__device__ __forceinline__ u32x4 pack8(f32x4 a, f32x4 b) { u32x4 w; w.x = cvt_pk_bf16(a[0], a[1]); w.y = cvt_pk_bf16(a[2], a[3]); w.z = cvt_pk_bf16(b[0], b[1]); w.w = cvt_pk_bf16(b[2], b[3]); return w; }

namespace pg8 {
constexpr int BM = 256, BK = 64, HALF = 128, HTB = HALF * BK * 2, NXCD = 8, WGM = 8;
__device__ __forceinline__ int lds_byte(int r, int c) { const int st = (r >> 4) * 2 + (c >> 5), rr = r & 15, cc = c & 31, ob = rr * 64 + cc * 2; return st * 1024 + (ob ^ (((ob >> 9) & 1) << 5)); }
__device__ __forceinline__ void stage_rc(int b, int& R, int& C) { const int st = b / 1024, sb = b % 1024, swz = sb ^ (((sb >> 9) & 1) << 5); R = (st >> 1) * 16 + swz / 64; C = (st & 1) * 32 + (swz % 64) / 2; }
__device__ __forceinline__ int perm32(int rho) { const int n = rho >> 4, i = rho & 15; return 8 * (i >> 2) + 4 * n + (i & 3); }

struct Unit { const char* A; const char* B; int pm, pn, kind; };

__device__ __forceinline__ void tile_order(int wgid, int nM, int nN, int& pm, int& pn) {
    const int nwg = nM * nN;
    { const int q = nwg / NXCD, r = nwg % NXCD, xcd = wgid % NXCD, off = wgid / NXCD; wgid = (xcd < r ? xcd * (q + 1) : r * (q + 1) + (xcd - r) * q) + off; }
    const int nig = WGM * nN, gid = wgid / nig, fm = gid * WGM, gsz = (nM - fm) < WGM ? (nM - fm) : WGM;
    pm = fm + ((wgid % nig) % gsz); pn = (wgid % nig) / gsz;
}
struct Sched {
    const char *A0, *B0, *A1, *B1, *A2, *B2; int nM0, nN0, nM1, nN1, nM2, nN2; int G, c; size_t tstep;
    __device__ __forceinline__ bool next(int i, Unit& u) const {
        int L = i * G + c;
        if (L < nM0 * nN0) { tile_order(L, nM0, nN0, u.pm, u.pn); u.A = A0 + (size_t)u.pm * tstep; u.B = B0 + (size_t)u.pn * tstep; u.kind = 0; return true; }
        L -= nM0 * nN0;
        if (L < nM1 * nN1) { tile_order(L, nM1, nN1, u.pm, u.pn); u.A = A1 + (size_t)u.pm * tstep; u.B = B1 + (size_t)u.pn * tstep; u.kind = 1; return true; }
        L -= nM1 * nN1;
        if (L < nM2 * nN2) { tile_order(L, nM2, nN2, u.pm, u.pn); u.A = A2 + (size_t)u.pm * tstep; u.B = B2 + (size_t)u.pn * tstep; u.kind = 2; return true; }
        return false;
    }
};
template <class Epi, class Sch>
__device__ __forceinline__ void gemm_phase(LAS unsigned char* lds, const int K, const Sch& S, const Epi& E) {
    int tid_ = threadIdx.x; asm volatile("" : "+v"(tid_));
    const int tid = tid_, wid = __builtin_amdgcn_readfirstlane(tid >> 6), lane = tid & 63, wr = wid >> 2, wc = wid & 3, fr = lane & 15, fq = lane >> 4;
    const int nt = K / BK;
    unsigned voffA[2], voffB[2];
#pragma unroll
    for (int i = 0; i < 2; ++i) { int R, C; stage_rc(tid * 16 + i * 8192, R, C); const int Rb = (R & ~31) + perm32(R & 31);
        voffA[i] = (unsigned)(R * K + C) * 2u; voffB[i] = (unsigned)(Rb * K + C) * 2u; }
    const size_t kstep = (size_t)(BK * 2);
    const size_t hstep = (size_t)HALF * K * 2;
    const unsigned ldsw = (unsigned)wid * 1024u;
    const int aoff = lds_byte(wr * 64 + fr, fq * 8), boff = lds_byte(wc * 32 + fr, fq * 8);
#define PG8_SA(b, h) (((b) * 2 + (h)) * HTB)
#define PG8_SB(b, h) ((4 + (b) * 2 + (h)) * HTB)
#define PG8_STAGE(bufoff, gbase, voff) do { _Pragma("unroll") for (int _i = 0; _i < 2; ++_i) \
        __builtin_amdgcn_global_load_lds((const unsigned*)((const char*)(gbase) + (voff)[_i]), (LAS unsigned*)(lds + (bufoff) + ldsw + _i * 8192), 16, 0, 0); } while (0)
#define PG8_LDA(dst, b, h) do { _Pragma("unroll") for (int m = 0; m < 4; ++m) _Pragma("unroll") for (int k = 0; k < 2; ++k) dst[m][k] = *(const LAS bf16x8*)(lds + PG8_SA(b, h) + aoff + m * 2048 + k * 1024); } while (0)
#define PG8_LDB(dst, b, h) do { _Pragma("unroll") for (int n = 0; n < 2; ++n) _Pragma("unroll") for (int k = 0; k < 2; ++k) dst[n][k] = *(const LAS bf16x8*)(lds + PG8_SB(b, h) + boff + n * 2048 + k * 1024); } while (0)
#define PG8_MMA(ai, bj, At, Bt) do { __builtin_amdgcn_s_setprio(1); _Pragma("unroll") for (int m = 0; m < 4; ++m) _Pragma("unroll") for (int n = 0; n < 2; ++n) _Pragma("unroll") for (int k = 0; k < 2; ++k) \
        acc[ai][bj][m][n] = __builtin_amdgcn_mfma_f32_16x16x32_bf16(Bt[n][k], At[m][k], acc[ai][bj][m][n], 0, 0, 0); __builtin_amdgcn_s_setprio(0); } while (0)
#define PG8_WAIT_V(n) asm volatile("s_waitcnt vmcnt(" #n ")" ::: "memory")
#define PG8_WAIT_L(n) asm volatile("s_waitcnt lgkmcnt(" #n ")" ::: "memory")
#define PG8_BAR __builtin_amdgcn_s_barrier()
#define PG8_SCHED __builtin_amdgcn_sched_barrier(0)
    Unit cur, nxt; int ui = 0;
    if (!S.next(0, cur)) return;
    f32x4 acc[2][2][4][2];
#pragma unroll
    for (int a = 0; a < 2; ++a)
#pragma unroll
        for (int b = 0; b < 2; ++b)
#pragma unroll
            for (int m = 0; m < 4; ++m)
#pragma unroll
                for (int n = 0; n < 2; ++n) acc[a][b][m][n] = (f32x4){0.f, 0.f, 0.f, 0.f};
    bf16x8 At[4][2], B0[2][2], B1[2][2];
    const char* cA = cur.A; const char* cB = cur.B;
    PG8_STAGE(PG8_SB(0, 0), cB, voffB); PG8_STAGE(PG8_SB(0, 1), cB + hstep, voffB); PG8_STAGE(PG8_SA(0, 0), cA, voffA); PG8_STAGE(PG8_SA(0, 1), cA + hstep, voffA);
    if (wr == 1) PG8_BAR;
    PG8_WAIT_V(2); PG8_BAR;
    PG8_STAGE(PG8_SB(1, 0), cB + kstep, voffB); PG8_STAGE(PG8_SA(1, 0), cA + kstep, voffA); PG8_STAGE(PG8_SB(1, 1), cB + hstep + kstep, voffB);
    PG8_WAIT_V(6); PG8_BAR;
    for (;;) {
        const bool has_next = S.next(ui + 1, nxt);
        const char* nA = has_next ? nxt.A : cA; const char* nB = has_next ? nxt.B : cB;
        for (int t = 0; t < nt; t += 2) {
            const bool last = (t == nt - 2);
            const char* a1 = cA + (size_t)(t + 1) * kstep;
            const char* a2 = last ? nA : cA + (size_t)(t + 2) * kstep; const char* b2 = last ? nB : cB + (size_t)(t + 2) * kstep;
            const char* a3 = a2 + kstep; const char* b3 = b2 + kstep;
            PG8_LDB(B0, 0, 0); PG8_LDB(B1, 0, 1); PG8_SCHED; PG8_LDA(At, 0, 0); PG8_STAGE(PG8_SA(1, 1), a1 + hstep, voffA);
            PG8_WAIT_V(8); PG8_WAIT_L(0); PG8_BAR; PG8_MMA(0, 0, At, B0); PG8_MMA(0, 1, At, B1); PG8_BAR; PG8_SCHED;
            PG8_LDA(At, 0, 1); PG8_STAGE(PG8_SB(0, 0), b2, voffB); PG8_STAGE(PG8_SB(0, 1), b2 + hstep, voffB); PG8_STAGE(PG8_SA(0, 0), a2, voffA);
            PG8_WAIT_V(8); PG8_WAIT_L(0); PG8_BAR; PG8_MMA(1, 0, At, B0); PG8_MMA(1, 1, At, B1); PG8_BAR; PG8_SCHED;
            PG8_LDB(B0, 1, 0); PG8_LDB(B1, 1, 1); PG8_SCHED; PG8_LDA(At, 1, 0); PG8_STAGE(PG8_SA(0, 1), a2 + hstep, voffA);
            PG8_WAIT_V(8); PG8_WAIT_L(0); PG8_BAR; PG8_MMA(0, 0, At, B0); PG8_MMA(0, 1, At, B1); PG8_BAR; PG8_SCHED;
            PG8_LDA(At, 1, 1); PG8_STAGE(PG8_SB(1, 0), b3, voffB); PG8_STAGE(PG8_SB(1, 1), b3 + hstep, voffB); PG8_STAGE(PG8_SA(1, 0), a3, voffA);
            PG8_WAIT_V(8); PG8_WAIT_L(0); PG8_BAR; PG8_MMA(1, 0, At, B0); PG8_MMA(1, 1, At, B1); PG8_BAR; PG8_SCHED;
        }
        if (wr == 0) PG8_BAR;
        E(acc, cur, wr, wc, fr, fq);
        if (!has_next) break;
#pragma unroll
        for (int a = 0; a < 2; ++a)
#pragma unroll
            for (int b = 0; b < 2; ++b)
#pragma unroll
                for (int m = 0; m < 4; ++m)
#pragma unroll
                    for (int n = 0; n < 2; ++n) acc[a][b][m][n] = (f32x4){0.f, 0.f, 0.f, 0.f};
        cur = nxt; cA = nA; cB = nB; ++ui;
        if (wr == 1) PG8_BAR;
    }
    PG8_WAIT_V(0);
    PG8_BAR;
#undef PG8_SA
#undef PG8_SB
#undef PG8_STAGE
#undef PG8_LDA
#undef PG8_LDB
#undef PG8_MMA
#undef PG8_WAIT_V
#undef PG8_WAIT_L
#undef PG8_BAR
#undef PG8_SCHED
}
}
using pg8::Unit;

#define EPI_ROW(ai, m) (un.pm * 256 + (ai) * 128 + wr * 64 + (m) * 16 + fr)
struct EpiP1 {
    bf16_t* aglu; bf16_t* u; bf16_t* gvT; const float* b_in; const float* rx;
    __device__ __forceinline__ void operator()(const f32x4 (&acc)[2][2][4][2], const Unit& un, int wr, int wc, int fr, int fq) const {
        if (un.kind == 0) {
            const int c0 = un.pn * 128 + wc * 32 + 8 * fq;
            f32x4 ba[2], bg[2];
#pragma unroll
            for (int n = 0; n < 2; ++n) { ba[n] = *(const f32x4*)(b_in + c0 + 4 * n); bg[n] = *(const f32x4*)(b_in + 512 + c0 + 4 * n); }
            float rsv[2][4];
#pragma unroll
            for (int ai = 0; ai < 2; ++ai)
#pragma unroll
                for (int m = 0; m < 4; ++m) rsv[ai][m] = rx[EPI_ROW(ai, m)];
#pragma unroll
            for (int ai = 0; ai < 2; ++ai)
#pragma unroll
                for (int m = 0; m < 4; ++m) {
                    f32x4 v[2]; const float rs = rsv[ai][m];
#pragma unroll
                    for (int n = 0; n < 2; ++n) v[n] = glu4_(acc[ai][0][m][n] * rs + ba[n], acc[ai][1][m][n] * rs + bg[n]);
                    *(u32x4*)(aglu + (size_t)EPI_ROW(ai, m) * CW + c0) = pack8(v[0], v[1]);
                }
        } else if (un.kind == 1) {
            float rsv[2][4];
#pragma unroll
            for (int ai = 0; ai < 2; ++ai)
#pragma unroll
                for (int m = 0; m < 4; ++m) rsv[ai][m] = rx[EPI_ROW(ai, m)];
#pragma unroll
            for (int bj = 0; bj < 2; ++bj) {
                const int cu = un.pn * 256 + bj * 128 + wc * 32 + 8 * fq;
                f32x4 bb[2];
#pragma unroll
                for (int n = 0; n < 2; ++n) bb[n] = *(const f32x4*)(b_in + 1024 + cu + 4 * n);
#pragma unroll
                for (int ai = 0; ai < 2; ++ai)
#pragma unroll
                    for (int m = 0; m < 4; ++m) {
                        f32x4 v[2]; const float rs = rsv[ai][m];
#pragma unroll
                        for (int n = 0; n < 2; ++n) v[n] = gelu4_(acc[ai][bj][m][n] * rs + bb[n]);
                        *(u32x4*)(u + (size_t)EPI_ROW(ai, m) * GW + cu) = pack8(v[0], v[1]);
                    }
            }
        } else {
            f32x4 rt[2][2];
#pragma unroll
            for (int bj = 0; bj < 2; ++bj)
#pragma unroll
                for (int n = 0; n < 2; ++n) rt[bj][n] = *(const f32x4*)(rx + un.pn * 256 + bj * 128 + wc * 32 + 8 * fq + 4 * n);
            float bbv[2][4];
#pragma unroll
            for (int ai = 0; ai < 2; ++ai)
#pragma unroll
                for (int m = 0; m < 4; ++m) bbv[ai][m] = b_in[1536 + EPI_ROW(ai, m)];
#pragma unroll
            for (int ai = 0; ai < 2; ++ai)
#pragma unroll
                for (int m = 0; m < 4; ++m) {
                    const int ch = EPI_ROW(ai, m);
                    const float bb = bbv[ai][m];
#pragma unroll
                    for (int bj = 0; bj < 2; ++bj) {
                        const int tok = un.pn * 256 + bj * 128 + wc * 32 + 8 * fq;
                        f32x4 v[2];
#pragma unroll
                        for (int n = 0; n < 2; ++n) v[n] = gelu4_(acc[ai][bj][m][n] * rt[bj][n] + bb);
                        *(u32x4*)(gvT + (size_t)ch * M + tok) = pack8(v[0], v[1]);
                    }
                }
        }
    }
};
struct EpiKV {
    bf16_t* o0; bf16_t* o1;
    __device__ __forceinline__ void operator()(const f32x4 (&acc)[2][2][4][2], const Unit& un, int wr, int wc, int fr, int fq) const {
        bf16_t* o = un.kind == 0 ? o0 : o1;
#pragma unroll
        for (int ai = 0; ai < 2; ++ai)
#pragma unroll
            for (int m = 0; m < 4; ++m)
#pragma unroll
                for (int bj = 0; bj < 2; ++bj)
                    *(u32x4*)(o + (size_t)EPI_ROW(ai, m) * 1024 + un.pn * 256 + bj * 128 + wc * 32 + 8 * fq) = pack8(acc[ai][bj][m][0], acc[ai][bj][m][1]);
    }
};
template <bool RES_BF16> struct EpiRes {
    const bf16_t* resb; bf16_t* hb; float* ssq;
    __device__ __forceinline__ void operator()(const f32x4 (&acc)[2][2][4][2], const Unit& un, int wr, int wc, int fr, int fq) const {
        const size_t off0 = (size_t)(un.pm * 256 + wr * 64 + fr) * D + un.pn * 256 + wc * 32 + 8 * fq;
        if (RES_BF16) {
            u32x4 hv[2][4][2];
#pragma unroll
            for (int ai = 0; ai < 2; ++ai)
#pragma unroll
                for (int m = 0; m < 4; ++m)
#pragma unroll
                    for (int bj = 0; bj < 2; ++bj) hv[ai][m][bj] = *(const u32x4*)(resb + off0 + (size_t)(ai * 128 + m * 16) * D + bj * 128);
#pragma unroll
            for (int ai = 0; ai < 2; ++ai)
#pragma unroll
                for (int m = 0; m < 4; ++m) {
                    float ss = 0.f;
#pragma unroll
                    for (int bj = 0; bj < 2; ++bj) {
                        const u32x4 h4 = hv[ai][m][bj];
                        const f32x4 v0 = acc[ai][bj][m][0] + (f32x4){bf_lo(h4.x), bf_hi(h4.x), bf_lo(h4.y), bf_hi(h4.y)}, v1 = acc[ai][bj][m][1] + (f32x4){bf_lo(h4.z), bf_hi(h4.z), bf_lo(h4.w), bf_hi(h4.w)};
                        *(u32x4*)(hb + off0 + (size_t)(ai * 128 + m * 16) * D + bj * 128) = pack8(v0, v1);
                        ss += (v0[0] * v0[0] + v0[1] * v0[1]) + (v0[2] * v0[2] + v0[3] * v0[3]) + (v1[0] * v1[0] + v1[1] * v1[1]) + (v1[2] * v1[2] + v1[3] * v1[3]);
                    }
                    ss += __shfl_xor(ss, 16); ss += __shfl_xor(ss, 32);
                    if (fq == 0) ssq[(size_t)EPI_ROW(ai, m) * 16 + un.pn * 4 + wc] = ss;
                }
        } else {
#pragma unroll
            for (int aim = 0; aim < 4; ++aim) {
                const int ai = aim >> 1;
                f32x4 rv[4][2][2];
#pragma unroll
                for (int m = 2 * (aim & 1); m < 2 * (aim & 1) + 2; ++m)
#pragma unroll
                    for (int bj = 0; bj < 2; ++bj) { const float* p = (const float*)resb + off0 + (size_t)(ai * 128 + m * 16) * D + bj * 128; rv[m][bj][0] = *(const f32x4*)p; rv[m][bj][1] = *(const f32x4*)(p + 4); }
#pragma unroll
                for (int m = 2 * (aim & 1); m < 2 * (aim & 1) + 2; ++m) {
                    float ss = 0.f;
#pragma unroll
                    for (int bj = 0; bj < 2; ++bj) {
                        const f32x4 v0 = acc[ai][bj][m][0] + rv[m][bj][0], v1 = acc[ai][bj][m][1] + rv[m][bj][1];
                        *(u32x4*)(hb + off0 + (size_t)(ai * 128 + m * 16) * D + bj * 128) = pack8(v0, v1);
                        ss += (v0[0] * v0[0] + v0[1] * v0[1]) + (v0[2] * v0[2] + v0[3] * v0[3]) + (v1[0] * v1[0] + v1[1] * v1[1]) + (v1[2] * v1[2] + v1[3] * v1[3]);
                    }
                    ss += __shfl_xor(ss, 16); ss += __shfl_xor(ss, 32);
                    if (fq == 0) ssq[(size_t)EPI_ROW(ai, m) * 16 + un.pn * 4 + wc] = ss;
                }
                asm volatile("" ::: "memory");
            }
        }
    }
};
struct EpiFinal {
    const bf16_t* hb; float* out; float* ssqp; unsigned* cnt; const float* g;
    __device__ __forceinline__ void operator()(f32x4 (&acc)[2][2][4][2], const Unit& un, int wr, int wc, int fr, int fq) const {
        const size_t off0 = (size_t)(un.pm * 256 + wr * 64 + fr) * D + un.pn * 256 + wc * 32 + 8 * fq;
        {
            u32x4 hv[2][4][2];
#pragma unroll
            for (int ai = 0; ai < 2; ++ai)
#pragma unroll
                for (int m = 0; m < 4; ++m)
#pragma unroll
                    for (int bj = 0; bj < 2; ++bj) hv[ai][m][bj] = *(const u32x4*)(hb + off0 + (size_t)(ai * 128 + m * 16) * D + bj * 128);
#pragma unroll
            for (int ai = 0; ai < 2; ++ai)
#pragma unroll
                for (int m = 0; m < 4; ++m) {
                    float ss = 0.f;
#pragma unroll
                    for (int bj = 0; bj < 2; ++bj) {
                        const u32x4 h4 = hv[ai][m][bj];
                        const f32x4 v0 = acc[ai][bj][m][0] + (f32x4){bf_lo(h4.x), bf_hi(h4.x), bf_lo(h4.y), bf_hi(h4.y)}, v1 = acc[ai][bj][m][1] + (f32x4){bf_lo(h4.z), bf_hi(h4.z), bf_lo(h4.w), bf_hi(h4.w)};
                        acc[ai][bj][m][0] = v0; acc[ai][bj][m][1] = v1;
                        ss += (v0[0] * v0[0] + v0[1] * v0[1]) + (v0[2] * v0[2] + v0[3] * v0[3]) + (v1[0] * v1[0] + v1[1] * v1[1]) + (v1[2] * v1[2] + v1[3] * v1[3]);
                    }
                    ss += __shfl_xor(ss, 16); ss += __shfl_xor(ss, 32);
                    if (fq == 0) __hip_atomic_store(ssqp + ((size_t)un.pn * M + EPI_ROW(ai, m)) * 4 + wc, ss, __ATOMIC_RELAXED, __HIP_MEMORY_SCOPE_AGENT);
                }
        }
        asm volatile("s_waitcnt vmcnt(0)" ::: "memory");
        if ((threadIdx.x & 63) == 0) __hip_atomic_fetch_add(cnt + 64 * un.pm, 1u, __ATOMIC_RELAXED, __HIP_MEMORY_SCOPE_AGENT);
        f32x4 gg[2][2];
#pragma unroll
        for (int bj = 0; bj < 2; ++bj)
#pragma unroll
            for (int n = 0; n < 2; ++n) gg[bj][n] = *(const f32x4*)(g + un.pn * 256 + bj * 128 + wc * 32 + 8 * fq + 4 * n);
        if (wr == 0 && wc == 0) {
            unsigned sp = 0;
            while ((unsigned)__builtin_amdgcn_readfirstlane(__hip_atomic_load(cnt + 64 * un.pm, __ATOMIC_RELAXED, __HIP_MEMORY_SCOPE_AGENT)) < 32u) { __builtin_amdgcn_s_sleep(2); if (++sp > (1u << 22)) break; }
            __builtin_amdgcn_fence(__ATOMIC_ACQUIRE, "agent");
        }
        asm volatile("s_waitcnt vmcnt(0) lgkmcnt(0)" ::: "memory"); __builtin_amdgcn_s_barrier(); asm volatile("" ::: "memory");
        float rr[2][4];
        {
            unsigned long long p0[2][4], p1[2][4];
#pragma unroll
            for (int ai = 0; ai < 2; ++ai)
#pragma unroll
                for (int m = 0; m < 4; ++m) { const unsigned long long* sp8 = (const unsigned long long*)(ssqp + ((size_t)fq * M + EPI_ROW(ai, m)) * 4);
                    p0[ai][m] = __hip_atomic_load(sp8, __ATOMIC_RELAXED, __HIP_MEMORY_SCOPE_AGENT); p1[ai][m] = __hip_atomic_load(sp8 + 1, __ATOMIC_RELAXED, __HIP_MEMORY_SCOPE_AGENT); }
#pragma unroll
            for (int ai = 0; ai < 2; ++ai)
#pragma unroll
                for (int m = 0; m < 4; ++m) {
                    float t = (__uint_as_float((unsigned)p0[ai][m]) + __uint_as_float((unsigned)(p0[ai][m] >> 32))) + (__uint_as_float((unsigned)p1[ai][m]) + __uint_as_float((unsigned)(p1[ai][m] >> 32)));
                    t += __shfl_xor(t, 16); t += __shfl_xor(t, 32);
                    rr[ai][m] = 1.0f / sqrtf(t * (1.0f / D) + RMS_EPS);
                }
        }
#pragma unroll
        for (int ai = 0; ai < 2; ++ai)
#pragma unroll
            for (int m = 0; m < 4; ++m) {
                const float r = rr[ai][m];
#pragma unroll
                for (int bj = 0; bj < 2; ++bj) {
                    float* op = out + off0 + (size_t)(ai * 128 + m * 16) * D + bj * 128;
                    *(f32x4*)op = acc[ai][bj][m][0] * r * gg[bj][0]; *(f32x4*)(op + 4) = acc[ai][bj][m][1] * r * gg[bj][1];
                }
            }
    }
};
__device__ __forceinline__ float row_rs(const float* ssq, int row, int fq) {
    const f32x4 p = *(const f32x4*)(ssq + (size_t)row * 16 + 4 * fq);
    float s = (p[0] + p[1]) + (p[2] + p[3]); s += __shfl_xor(s, 16); s += __shfl_xor(s, 32);
    return __builtin_amdgcn_rsqf(s * (1.0f / D) + RMS_EPS);
}
struct EpiQ {
    bf16_t* q; const float* ssq;
    __device__ __forceinline__ void operator()(const f32x4 (&acc)[2][2][4][2], const Unit& un, int wr, int wc, int fr, int fq) const {
        float rsv[2][4];
#pragma unroll
        for (int ai = 0; ai < 2; ++ai)
#pragma unroll
            for (int m = 0; m < 4; ++m) rsv[ai][m] = row_rs(ssq, EPI_ROW(ai, m), fq);
#pragma unroll
        for (int ai = 0; ai < 2; ++ai)
#pragma unroll
            for (int m = 0; m < 4; ++m) {
                const int row = EPI_ROW(ai, m); const float r = rsv[ai][m] * QSCALE;
#pragma unroll
                for (int bj = 0; bj < 2; ++bj)
                    *(u32x4*)(q + (size_t)row * D + un.pn * 256 + bj * 128 + wc * 32 + 8 * fq) = pack8(acc[ai][bj][m][0] * r, acc[ai][bj][m][1] * r);
            }
    }
};
struct EpiGU {
    bf16_t* act; const float* ssq;
    __device__ __forceinline__ void operator()(const f32x4 (&acc)[2][2][4][2], const Unit& un, int wr, int wc, int fr, int fq) const {
        float rsv[2][4];
#pragma unroll
        for (int ai = 0; ai < 2; ++ai)
#pragma unroll
            for (int m = 0; m < 4; ++m) rsv[ai][m] = row_rs(ssq, EPI_ROW(ai, m), fq);
#pragma unroll
        for (int ai = 0; ai < 2; ++ai)
#pragma unroll
            for (int m = 0; m < 4; ++m) {
                const int row = EPI_ROW(ai, m); const float r = rsv[ai][m];
                f32x4 v[2];
#pragma unroll
                for (int n = 0; n < 2; ++n) v[n] = swiglu4_(acc[ai][0][m][n], acc[ai][1][m][n], -LOG2E * r, r * r);
                *(u32x4*)(act + (size_t)row * FF + un.pn * 128 + wc * 32 + 8 * fq) = pack8(v[0], v[1]);
            }
    }
};

__device__ __forceinline__ void p0_transpose_item(const float* W, int N, bf16_t* WT, int K, int dest_row0, const float* gk, LAS float* scr, int k0, int n0, int lane) {
    float v[32];
    const float* wp = W + (size_t)(k0 + (lane >> 5)) * N + n0 + (lane & 31);
#pragma unroll
    for (int i = 0; i < 32; ++i) v[i] = wp[(size_t)(2 * i) * N];
    if (gk) {
        const float gv = gk[k0 + lane];
#pragma unroll
        for (int i = 0; i < 32; ++i) v[i] *= __shfl(gv, 2 * i + (lane >> 5));
    }
#pragma unroll
    for (int i = 0; i < 32; ++i) scr[(2 * i + (lane >> 5)) * 33 + (lane & 31)] = v[i];
    asm volatile("s_waitcnt lgkmcnt(0)" ::: "memory");
    const int c = lane & 7;
#pragma unroll
    for (int j = 0; j < 4; ++j) { const int n = (lane >> 3) + 8 * j; const LAS float* s = scr + (8 * c) * 33 + n;
        u32x4 o; o.x = cvt_pk_bf16(s[0 * 33], s[1 * 33]); o.y = cvt_pk_bf16(s[2 * 33], s[3 * 33]); o.z = cvt_pk_bf16(s[4 * 33], s[5 * 33]); o.w = cvt_pk_bf16(s[6 * 33], s[7 * 33]);
        *(u32x4*)(WT + (size_t)(dest_row0 + n) * K + k0 + 8 * c) = o; }
    asm volatile("s_waitcnt lgkmcnt(0)" ::: "memory");
}
__device__ __forceinline__ void rms_row_to_bf16(const float* xrow, const float* g, bf16_t* orow, int lane) {
    const f32x4* xr = (const f32x4*)xrow + lane; const f32x4* gr = (const f32x4*)g + lane;
    f32x4 v[4]; float s = 0.f;
#pragma unroll
    for (int j = 0; j < 4; ++j) { v[j] = xr[64 * j]; s += (v[j][0] * v[j][0] + v[j][1] * v[j][1]) + (v[j][2] * v[j][2] + v[j][3] * v[j][3]); }
    const float r = 1.0f / sqrtf(wave_sum(s) * (1.0f / D) + RMS_EPS);
    u32x2* o8 = (u32x2*)orow + lane;
#pragma unroll
    for (int j = 0; j < 4; ++j) { const f32x4 gg = gr[64 * j]; u32x2 w; w.x = cvt_pk_bf16(v[j][0] * r * gg[0], v[j][1] * r * gg[1]); w.y = cvt_pk_bf16(v[j][2] * r * gg[2], v[j][3] * r * gg[3]); o8[64 * j] = w; }
}

struct Args { const float* in[23]; float* out; unsigned char* ws; unsigned long long never; };

__device__ __forceinline__ void rms_row2_to_bf16(const float* xrow, const float* g, bf16_t* orow, int lane) {
    const f32x4* xr = (const f32x4*)xrow + lane; const f32x4* gr = (const f32x4*)g + lane;
    f32x4 v[8]; float s0 = 0.f, s1 = 0.f;
#pragma unroll
    for (int j = 0; j < 8; ++j) v[j] = xr[64 * j];
#pragma unroll
    for (int j = 0; j < 4; ++j) { s0 += (v[j][0] * v[j][0] + v[j][1] * v[j][1]) + (v[j][2] * v[j][2] + v[j][3] * v[j][3]); s1 += (v[4 + j][0] * v[4 + j][0] + v[4 + j][1] * v[4 + j][1]) + (v[4 + j][2] * v[4 + j][2] + v[4 + j][3] * v[4 + j][3]); }
    const float r0 = 1.0f / sqrtf(wave_sum(s0) * (1.0f / D) + RMS_EPS), r1 = 1.0f / sqrtf(wave_sum(s1) * (1.0f / D) + RMS_EPS);
    u32x2* o8 = (u32x2*)orow + lane;
#pragma unroll
    for (int j = 0; j < 4; ++j) { const f32x4 gg = gr[64 * j]; u32x2 w;
        w.x = cvt_pk_bf16(v[j][0] * r0 * gg[0], v[j][1] * r0 * gg[1]); w.y = cvt_pk_bf16(v[j][2] * r0 * gg[2], v[j][3] * r0 * gg[3]); o8[64 * j] = w;
        w.x = cvt_pk_bf16(v[4 + j][0] * r1 * gg[0], v[4 + j][1] * r1 * gg[1]); w.y = cvt_pk_bf16(v[4 + j][2] * r1 * gg[2], v[4 + j][3] * r1 * gg[3]); o8[256 + 64 * j] = w; }
}
__device__ __forceinline__ void rms_row4_to_bf16(const float* xrow, const float* g, bf16_t* orow, int lane) {
    const f32x4* xr = (const f32x4*)xrow + lane; const f32x4* gr = (const f32x4*)g + lane;
    f32x4 v[16]; float ss[4];
#pragma unroll
    for (int j = 0; j < 16; ++j) v[j] = xr[64 * j];
#pragma unroll
    for (int r = 0; r < 4; ++r) { float s = 0.f;
#pragma unroll
        for (int j = 0; j < 4; ++j) s += (v[4 * r + j][0] * v[4 * r + j][0] + v[4 * r + j][1] * v[4 * r + j][1]) + (v[4 * r + j][2] * v[4 * r + j][2] + v[4 * r + j][3] * v[4 * r + j][3]);
        ss[r] = s; }
#pragma unroll
    for (int o = 1; o < 64; o <<= 1) {
#pragma unroll
        for (int r = 0; r < 4; ++r) ss[r] += __shfl_xor(ss[r], o); }
    u32x2* o8 = (u32x2*)orow + lane;
#pragma unroll
    for (int j = 0; j < 4; ++j) { const f32x4 gg = gr[64 * j];
#pragma unroll
        for (int r = 0; r < 4; ++r) { const float rr = 1.0f / sqrtf(ss[r] * (1.0f / D) + RMS_EPS); const f32x4 x = v[4 * r + j]; u32x2 w;
            w.x = cvt_pk_bf16(x[0] * rr * gg[0], x[1] * rr * gg[1]); w.y = cvt_pk_bf16(x[2] * rr * gg[2], x[3] * rr * gg[3]); o8[256 * r + 64 * j] = w; } }
}
__device__ __forceinline__ void x_row4_to_bf16(const float* xrow, bf16_t* orow, float* rx, int lane) {
    const f32x4* xr = (const f32x4*)xrow + lane;
    f32x4 v[16]; float ss[4];
#pragma unroll
    for (int j = 0; j < 16; ++j) v[j] = xr[64 * j];
    u32x2* o8 = (u32x2*)orow + lane;
#pragma unroll
    for (int r = 0; r < 4; ++r) { float s = 0.f;
#pragma unroll
        for (int j = 0; j < 4; ++j) { const f32x4 x = v[4 * r + j]; s += (x[0] * x[0] + x[1] * x[1]) + (x[2] * x[2] + x[3] * x[3]);
            u32x2 w; w.x = cvt_pk_bf16(x[0], x[1]); w.y = cvt_pk_bf16(x[2], x[3]); o8[256 * r + 64 * j] = w; }
        ss[r] = s; }
#pragma unroll
    for (int o = 1; o < 64; o <<= 1) {
#pragma unroll
        for (int r = 0; r < 4; ++r) ss[r] += __shfl_xor(ss[r], o); }
    if (lane < 4) rx[lane] = 1.0f / sqrtf((lane == 0 ? ss[0] : lane == 1 ? ss[1] : lane == 2 ? ss[2] : ss[3]) * (1.0f / D) + RMS_EPS);
}
__device__ __forceinline__ void p0_prologue(const Args& a, LAS unsigned char* lds, int bid, int G, int wid, int lane) {
    LAS float* scr = (LAS float*)(lds + wid * 16384);
    const int gw = bid * 8 + wid, NGW = G * 8;
    unsigned char* ws = a.ws;
    constexpr int I0 = 16 * 64, I1 = 16 * 32, I3 = 16 * 64;
    constexpr int NITEMS = I0 + I1 + I3;
    for (int it = gw; it < NITEMS; it += NGW) {
        int r = it;
        if (r < I0) { const int nb = r % 64, kb = r / 64, n0 = nb * 32; int dr = n0;
            if (n0 < 1024) { const int half = n0 / 512, c = n0 % 512; dr = 256 * (c / 128) + 128 * half + (c % 128); }
            p0_transpose_item(a.in[3], 2048, (bf16_t*)(ws + WS_BT1), 1024, dr, a.in[2], scr, kb * 64, n0, lane); continue; } r -= I0;
        if (r < I1) { p0_transpose_item(a.in[13], 1024, (bf16_t*)(ws + WS_WOUT), 1024, (r % 32) * 32, nullptr, scr, (r / 32) * 64, (r % 32) * 32, lane); continue; } r -= I1;
        p0_transpose_item(a.in[17], 2048, (bf16_t*)(ws + WS_WKV), 1024, (r % 64) * 32, nullptr, scr, (r / 64) * 64, (r % 64) * 32, lane);
    }
    for (int m = 4 * gw; m < M; m += 4 * NGW) x_row4_to_bf16(a.in[0] + (size_t)m * D, (bf16_t*)(ws + WS_HN) + (size_t)m * D, (float*)(ws + WS_RX) + m, lane);
    for (int m = gw; m < MR; m += NGW) rms_row_to_bf16(a.in[1] + (size_t)m * D, a.in[15], (bf16_t*)(ws + WS_MN) + (size_t)m * D, lane);
    for (int rr = gw; rr < 8 * 128; rr += NGW) {
        const int t = rr & 127; const f32x2 wv = *(const f32x2*)(a.in[11] + (size_t)rr * 128 + 2 * lane);
        ((unsigned*)(ws + WS_WSB))[(size_t)rr * 64 + lane] = cvt_pk_bf16(2 * lane <= t ? wv[0] : 0.f, 2 * lane + 1 <= t ? wv[1] : 0.f);
    }
}
struct LwItem { const float* wp; const float* gk; bf16_t* wt; int N, K, k0; };
__device__ __forceinline__ LwItem lw_decode(const Args& a, unsigned char* ws, int it, int lane) {
    constexpr int I2 = 16 * 32, I4 = 16 * 32, I5 = 16 * 176;
    const float* W; const float* gk = nullptr; bf16_t* WT; int N, K = 1024, k0, n0, dr;
    if (it < I2) { W = a.in[16]; gk = a.in[14]; WT = (bf16_t*)(ws + WS_WQ); N = 1024; k0 = (it / 32) * 64; n0 = (it % 32) * 32; dr = n0; }
    else if (it < I2 + I4) { const int r = it - I2; W = a.in[18]; WT = (bf16_t*)(ws + WS_WO); N = 1024; k0 = (r / 32) * 64; n0 = (r % 32) * 32; dr = n0; }
    else if (it < I2 + I4 + I5) { const int r = it - I2 - I4; W = a.in[20]; gk = a.in[19]; WT = (bf16_t*)(ws + WS_WGU); N = 2 * FF; k0 = (r / 176) * 64; n0 = (r % 176) * 32;
        const int half = n0 / FF, c = n0 % FF; dr = 256 * (c / 128) + 128 * half + (c % 128); }
    else { const int r = it - I2 - I4 - I5; W = a.in[21]; WT = (bf16_t*)(ws + WS_WD); N = 1024; K = FF; k0 = (r / 32) * 64; n0 = (r % 32) * 32; dr = n0; }
    LwItem d; d.wp = W + (size_t)(k0 + (lane >> 5)) * N + n0 + (lane & 31); d.gk = gk; d.wt = WT + (size_t)dr * K + k0; d.N = N; d.K = K; d.k0 = k0; return d;
}
__device__ __forceinline__ void late_weights(const Args& a, LAS unsigned char* lds, int gw, int NGW, int wid, int lane) {
    LAS float* scr = (LAS float*)(lds + wid * 16384);
    unsigned char* ws = a.ws;
    constexpr int NITEMS = 16 * 32 + 16 * 32 + 16 * 176 + 44 * 32;
    if (gw >= NITEMS) return;
    LwItem cur = lw_decode(a, ws, gw, lane);
    float v[32];
#pragma unroll
    for (int i = 0; i < 32; ++i) v[i] = cur.wp[(size_t)(2 * i) * cur.N];
    for (int it = gw; it < NITEMS; it += NGW) {
        const bool has_next = it + NGW < NITEMS;
        LwItem nxt = cur; float nv[32];
        if (has_next) { nxt = lw_decode(a, ws, it + NGW, lane);
#pragma unroll
            for (int i = 0; i < 32; ++i) nv[i] = nxt.wp[(size_t)(2 * i) * nxt.N]; }
        if (cur.gk) { const float gv = cur.gk[cur.k0 + lane];
#pragma unroll
            for (int i = 0; i < 32; ++i) v[i] *= __shfl(gv, 2 * i + (lane >> 5)); }
#pragma unroll
        for (int i = 0; i < 32; ++i) scr[(2 * i + (lane >> 5)) * 33 + (lane & 31)] = v[i];
        asm volatile("s_waitcnt lgkmcnt(0)" ::: "memory");
        const int c = lane & 7;
#pragma unroll
        for (int j = 0; j < 4; ++j) { const int n = (lane >> 3) + 8 * j; const LAS float* sp = scr + (8 * c) * 33 + n;
            u32x4 o; o.x = cvt_pk_bf16(sp[0 * 33], sp[1 * 33]); o.y = cvt_pk_bf16(sp[2 * 33], sp[3 * 33]); o.z = cvt_pk_bf16(sp[4 * 33], sp[5 * 33]); o.w = cvt_pk_bf16(sp[6 * 33], sp[7 * 33]);
            *(u32x4*)(cur.wt + (size_t)n * cur.K + 8 * c) = o; }
        asm volatile("s_waitcnt lgkmcnt(0)" ::: "memory");
        if (has_next) {
#pragma unroll
            for (int i = 0; i < 32; ++i) v[i] = nv[i];
            cur = nxt; }
    }
}

template <int NT> __device__ __forceinline__ void conv_unit(const Args& a, LAS unsigned char* lds, int unit, int tid, int wid, int lane) {
    unsigned char* ws = a.ws;
    const bf16_t* aglu = (const bf16_t*)(ws + WS_AGLU); const bf16_t* ub = (const bf16_t*)(ws + WS_U); const bf16_t* gvT = (const bf16_t*)(ws + WS_GVT);
    const bf16_t* wsb = (const bf16_t*)(ws + WS_WSB); bf16_t* mix = (bf16_t*)(ws + WS_MIX);
    const int t0 = unit * NT, p0 = t0 & (SEQ - 1);
    constexpr int HT = NT / 2, NB = NT / 16;
    {
        const int cp = tid & 255, th = tid >> 8;
        f32x2 w[31];
#pragma unroll
        for (int k = 0; k < 31; ++k) w[k] = *(const f32x2*)(a.in[5] + k * CW + 2 * cp);
        const f32x2 cb = *(const f32x2*)(a.in[6] + 2 * cp);
        const int base = t0 + HT * th;
        const int pbase = p0 + HT * th;
        const unsigned* arow = (const unsigned*)aglu + cp;
        f32x2 win[38];
#pragma unroll
        for (int i = 0; i < 30; ++i) { const bool ok = (pbase - 30 + i) >= 0; const unsigned v = ok ? arow[(size_t)(base - 30 + i) * 256] : 0u; win[i] = (f32x2){bf_lo(v), bf_hi(v)}; }
        unsigned nx[8], nx2[8];
#pragma unroll
        for (int i = 0; i < 8; ++i) nx[i] = arow[(size_t)(base + i) * 256];
#pragma unroll
        for (int i = 0; i < 8; ++i) nx2[i] = arow[(size_t)(base + 8 + i) * 256];
        for (int blk = 0; blk < NB; ++blk) {
#pragma unroll
            for (int i = 0; i < 8; ++i) win[30 + i] = (f32x2){bf_lo(nx[i]), bf_hi(nx[i])};
#pragma unroll
            for (int i = 0; i < 8; ++i) nx[i] = nx2[i];
            if (blk < NB - 2) {
#pragma unroll
                for (int i = 0; i < 8; ++i) nx2[i] = arow[(size_t)(base + 8 * (blk + 2) + i) * 256];
            }
#pragma unroll
            for (int o = 0; o < 8; ++o) {
                f32x2 s = cb;
#pragma unroll
                for (int k = 0; k < 31; ++k) s += w[k] * win[o + k];
                *(LAS unsigned*)(lds + (size_t)(HT * th + 8 * blk + o) * 1024 + cp * 4) = cvt_pk_bf16(s[0], s[1]);
            }
#pragma unroll
            for (int i = 0; i < 30; ++i) win[i] = win[i + 8];
        }
    }
    __syncthreads();
    {
        f32x4 g0 = *(const f32x4*)(a.in[7] + 8 * lane), g1 = *(const f32x4*)(a.in[7] + 8 * lane + 4);
        f32x4 b0 = *(const f32x4*)(a.in[8] + 8 * lane), b1 = *(const f32x4*)(a.in[8] + 8 * lane + 4);
        for (int i = 0; i < NT / 8; ++i) {
            const int tok = wid * (NT / 8) + i;
            const u32x4 raw = *(const LAS u32x4*)(lds + (size_t)tok * 1024 + lane * 16);
            f32x4 x0 = {bf_lo(raw.x), bf_hi(raw.x), bf_lo(raw.y), bf_hi(raw.y)}, x1 = {bf_lo(raw.z), bf_hi(raw.z), bf_lo(raw.w), bf_hi(raw.w)};
            const float mean = wave_sum((x0[0] + x0[1]) + (x0[2] + x0[3]) + (x1[0] + x1[1]) + (x1[2] + x1[3])) * (1.0f / CW);
            x0 = x0 - mean; x1 = x1 - mean;
            const float var = wave_sum((x0[0] * x0[0] + x0[1] * x0[1]) + (x0[2] * x0[2] + x0[3] * x0[3]) + (x1[0] * x1[0] + x1[1] * x1[1]) + (x1[2] * x1[2] + x1[3] * x1[3])) * (1.0f / CW);
            const float rstd = 1.0f / sqrtf(var + LN_EPS);
            f32x4 y0 = x0 * rstd * g0 + b0, y1 = x1 * rstd * g1 + b1;
#pragma unroll
            for (int j = 0; j < 4; ++j) { y0[j] = siluf_(y0[j]); y1[j] = siluf_(y1[j]); }
            *(u32x4*)(mix + (size_t)(t0 + tok) * D + 8 * lane) = pack8(y0, y1);
        }
    }
    __syncthreads();
}
__device__ __forceinline__ void gmlp_unit(const Args& a, LAS unsigned char* lds, int chunk, int tid, int wid, int lane) {
    unsigned char* ws = a.ws;
    const bf16_t* ub = (const bf16_t*)(ws + WS_U); const bf16_t* gvT = (const bf16_t*)(ws + WS_GVT);
    const bf16_t* wsb = (const bf16_t*)(ws + WS_WSB); bf16_t* mix = (bf16_t*)(ws + WS_MIX);
    const int t0 = chunk * CHUNK;
    constexpr int LDG = 264;
    LAS unsigned char* part = lds + 512 * LDG;
    LAS f32x2* stat = (LAS f32x2*)(lds + 512 * LDG + 8192);
    const int h = wid, fr = lane & 15, fq = lane >> 4;
    bf16x8 Bf[20];
    const bf16_t* wb = wsb + (size_t)(h * 128 + fr) * 128 + 8 * fq;
    {
        int n = 0;
#pragma unroll
        for (int ks = 0; ks < 2; ++ks)
#pragma unroll
            for (int tb = 0; tb < 4; ++tb) { if (tb < 2 * ks) continue; Bf[n++] = *(const bf16x8*)(wb + (size_t)(16 * tb) * 128 + 32 * ks); }
    }
    const bf16_t* ubase = ub + (size_t)(t0 + fr) * GW + 64 * h + 4 * fq;
    u32x2 uu[2][4][4];
#pragma unroll
    for (int tb = 0; tb < 4; ++tb)
#pragma unroll
        for (int db = 0; db < 4; ++db) uu[0][tb][db] = *(const u32x2*)(ubase + (size_t)(16 * tb) * GW + 16 * db);
    {
        const bf16_t* gp = gvT + (size_t)(tid >> 4) * M + t0 + (tid & 15) * 8;
        LAS unsigned char* lp = lds + (tid >> 4) * LDG + (tid & 15) * 16;
        u32x4 tr[16];
#pragma unroll
        for (int p = 0; p < 16; ++p) tr[p] = *(const u32x4*)(gp + (size_t)(32 * p) * M);
#pragma unroll
        for (int p = 0; p < 16; ++p) *(LAS u32x4*)(lp + 32 * p * LDG) = tr[p];
    }
    __syncthreads();
    {
        const int tg = tid & 15, cgp = tid >> 4;
        float sm[8], sq[8];
#pragma unroll
        for (int j = 0; j < 8; ++j) { sm[j] = 0.f; sq[j] = 0.f; }
        const LAS unsigned char* rp = lds + (16 * cgp) * LDG + tg * 16;
#pragma unroll
        for (int c = 0; c < 16; ++c) { const u32x4 r = *(const LAS u32x4*)(rp + c * LDG);
            const float v[8] = {bf_lo(r.x), bf_hi(r.x), bf_lo(r.y), bf_hi(r.y), bf_lo(r.z), bf_hi(r.z), bf_lo(r.w), bf_hi(r.w)};
#pragma unroll
            for (int j = 0; j < 8; ++j) { sm[j] += v[j]; sq[j] += v[j] * v[j]; } }
#pragma unroll
        for (int j = 0; j < 8; ++j) { sm[j] += __shfl_xor(sm[j], 16); sm[j] += __shfl_xor(sm[j], 32); sq[j] += __shfl_xor(sq[j], 16); sq[j] += __shfl_xor(sq[j], 32); }
        if (lane < 16) {
#pragma unroll
            for (int j = 0; j < 8; ++j) *(LAS f32x2*)(part + ((size_t)wid * 128 + 8 * tg + j) * 8) = (f32x2){sm[j], sq[j]};
        }
        __syncthreads();
        if (tid < 128) { float ts = 0.f, tq2 = 0.f;
#pragma unroll
            for (int w = 0; w < 8; ++w) { const f32x2 p = *(const LAS f32x2*)(part + ((size_t)w * 128 + tid) * 8); ts += p[0]; tq2 += p[1]; }
            const float mean = ts * (1.0f / GW); const float var = fmaxf(tq2 * (1.0f / GW) - mean * mean, 0.f);
            stat[tid] = (f32x2){mean, 1.0f / sqrtf(var + LN_EPS)}; }
        __syncthreads();
    }
    {
        float lg[4], lb[4];
#pragma unroll
        for (int db = 0; db < 4; ++db) { lg[db] = a.in[9][64 * h + 16 * db + fr]; lb[db] = a.in[10][64 * h + 16 * db + fr]; }
        const LAS unsigned char* abase = lds + (64 * h + fr) * LDG + fq * 16;
        bf16_t* obase = mix + (size_t)(t0 + fr) * D + 512 + 64 * h + 4 * fq;
        int nb = 0;
#pragma unroll
        for (int th = 0; th < 2; ++th) {
            if (th == 0) {
#pragma unroll
                for (int tb = 0; tb < 4; ++tb)
#pragma unroll
                    for (int db = 0; db < 4; ++db) uu[1][tb][db] = *(const u32x2*)(ubase + (size_t)(16 * (4 + tb)) * GW + 16 * db);
            }
            f32x4 acc[4][4];
#pragma unroll
            for (int db = 0; db < 4; ++db)
#pragma unroll
                for (int tb = 0; tb < 4; ++tb) acc[db][tb] = (f32x4){0.f, 0.f, 0.f, 0.f};
#pragma unroll
            for (int ks = 0; ks < 2 * th + 2; ++ks) {
                float mu[8], rs[8];
#pragma unroll
                for (int j = 0; j < 8; ++j) { const f32x2 st = stat[32 * ks + 8 * fq + j]; mu[j] = st[0]; rs[j] = st[1]; }
                bf16x8 Af[4];
#pragma unroll
                for (int db = 0; db < 4; ++db) {
                    const u32x4 r = *(const LAS u32x4*)(abase + 16 * db * LDG + 64 * ks);
                    const float gg = lg[db], bb = lb[db];
                    u32x4 o;
                    o.x = cvt_pk_bf16((bf_lo(r.x) - mu[0]) * rs[0] * gg + bb, (bf_hi(r.x) - mu[1]) * rs[1] * gg + bb);
                    o.y = cvt_pk_bf16((bf_lo(r.y) - mu[2]) * rs[2] * gg + bb, (bf_hi(r.y) - mu[3]) * rs[3] * gg + bb);
                    o.z = cvt_pk_bf16((bf_lo(r.z) - mu[4]) * rs[4] * gg + bb, (bf_hi(r.z) - mu[5]) * rs[5] * gg + bb);
                    o.w = cvt_pk_bf16((bf_lo(r.w) - mu[6]) * rs[6] * gg + bb, (bf_hi(r.w) - mu[7]) * rs[7] * gg + bb);
                    Af[db] = __builtin_bit_cast(bf16x8, o);
                }
#pragma unroll
                for (int tb = 0; tb < 4; ++tb) {
                    if (4 * th + tb < 2 * ks) continue;
                    const bf16x8 bfr = Bf[nb++];
#pragma unroll
                    for (int db = 0; db < 4; ++db) acc[db][tb] = __builtin_amdgcn_mfma_f32_16x16x32_bf16(Af[db], bfr, acc[db][tb], 0, 0, 0);
                }
            }
            if (th == 0) {
                asm volatile("" ::: "memory");
                int n = 6;
#pragma unroll
                for (int ks = 0; ks < 4; ++ks)
#pragma unroll
                    for (int tb = 0; tb < 4; ++tb) { if (4 + tb < 2 * ks) continue; Bf[n++] = *(const bf16x8*)(wb + (size_t)(16 * (4 + tb)) * 128 + 32 * ks); }
                asm volatile("" ::: "memory");
            }
#pragma unroll
            for (int tb = 0; tb < 4; ++tb) {
                const float bs = a.in[12][h * 128 + 16 * (4 * th + tb) + fr];
#pragma unroll
                for (int db = 0; db < 4; ++db) {
                    u32x2 o; o.x = cvt_pk_bf16(bf_lo(uu[th][tb][db].x) * (acc[db][tb][0] + bs), bf_hi(uu[th][tb][db].x) * (acc[db][tb][1] + bs));
                    o.y = cvt_pk_bf16(bf_lo(uu[th][tb][db].y) * (acc[db][tb][2] + bs), bf_hi(uu[th][tb][db].y) * (acc[db][tb][3] + bs));
                    *(u32x2*)(obase + (size_t)(16 * (4 * th + tb)) * D + 16 * db) = o;
                }
            }
        }
    }
}

__device__ __forceinline__ void attn_unit(LAS unsigned char* lds, const bf16_t* q, const bf16_t* Km, const bf16_t* Vt, bf16_t* o, int pm, int h, int tid, int wid, int lane) {
    constexpr int LDK = 544, LDV = 528;
    const int fr = lane & 15, fq = lane >> 4, b = pm >> 4, row0 = pm * 256 + wid * 32;
    {
        const bf16_t* kg = Km + (size_t)(b * 256 + (tid >> 5)) * 1024 + h * 256 + (tid & 31) * 8;
        LAS unsigned char* kl = lds + (tid >> 5) * LDK + (tid & 31) * 16;
#pragma unroll
        for (int half = 0; half < 2; ++half) {
            u32x4 kr[8];
#pragma unroll
            for (int i = 0; i < 8; ++i) kr[i] = *(const u32x4*)(kg + (size_t)(half * 8 + i) * 16 * 1024);
#pragma unroll
            for (int i = 0; i < 8; ++i) *(LAS u32x4*)(kl + (half * 8 + i) * 16 * LDK) = kr[i];
        }
    }
    __syncthreads();
    bf16x8 Pf[2][8]; float inv[2];
    const bf16_t* qbase = q + (size_t)(row0 + fr) * D + h * 256 + 8 * fq;
#pragma unroll
    for (int qb = 0; qb < 2; ++qb) {
        bf16x8 Qf[8];
#pragma unroll
        for (int ks = 0; ks < 8; ++ks) Qf[ks] = *(const bf16x8*)(qbase + (size_t)(16 * qb) * D + 32 * ks);
        f32x4 S[16];
#pragma unroll
        for (int kb = 0; kb < 16; ++kb) S[kb] = (f32x4){0.f, 0.f, 0.f, 0.f};
        bf16x8 kf[2][4];
        const LAS unsigned char* kbase = lds + fr * LDK + fq * 16;
#pragma unroll
        for (int k4 = 0; k4 < 4; ++k4) kf[0][k4] = *(const LAS bf16x8*)(kbase + 64 * k4);
#pragma unroll
        for (int it = 0; it < 32; ++it) {
            if (it < 31) {
#pragma unroll
                for (int k4 = 0; k4 < 4; ++k4) kf[(it + 1) & 1][k4] = *(const LAS bf16x8*)(kbase + 16 * ((it + 1) >> 1) * LDK + 64 * (4 * ((it + 1) & 1) + k4));
            }
#pragma unroll
            for (int k4 = 0; k4 < 4; ++k4) S[it >> 1] = __builtin_amdgcn_mfma_f32_16x16x32_bf16(kf[it & 1][k4], Qf[4 * (it & 1) + k4], S[it >> 1], 0, 0, 0);
#pragma unroll
            for (int k4 = 0; k4 < 4; ++k4) { __builtin_amdgcn_sched_group_barrier(0x100, 1, 0); __builtin_amdgcn_sched_group_barrier(0x008, 1, 0); }
            __builtin_amdgcn_sched_barrier(0);
        }
        float mx = -3.0e38f;
#pragma unroll
        for (int kb = 0; kb < 16; ++kb) mx = fmaxf(fmaxf(fmaxf(S[kb][0], S[kb][1]), fmaxf(S[kb][2], S[kb][3])), mx);
        mx = fmaxf(mx, __shfl_xor(mx, 16)); mx = fmaxf(mx, __shfl_xor(mx, 32));
        float sum = 0.f;
#pragma unroll
        for (int kb = 0; kb < 16; ++kb)
#pragma unroll
            for (int j = 0; j < 4; ++j) { const float p = __builtin_amdgcn_exp2f(S[kb][j] - mx); S[kb][j] = p; sum += p; }
        sum += __shfl_xor(sum, 16); sum += __shfl_xor(sum, 32);
        inv[qb] = 1.0f / sum;
#pragma unroll
        for (int ks = 0; ks < 8; ++ks) { const u32x4 w = pack8(S[2 * ks], S[2 * ks + 1]); Pf[qb][ks] = __builtin_bit_cast(bf16x8, w); }
        asm volatile("" ::: "memory");
    }
    __syncthreads();
    {
        const bf16_t* vg = Vt + (size_t)(h * 256 + (tid >> 5)) * 1024 + b * 256 + (tid & 31) * 8;
        LAS unsigned char* vl = lds + (tid >> 5) * LDV + (tid & 31) * 16;
#pragma unroll
        for (int half = 0; half < 2; ++half) {
            u32x4 kr[8];
#pragma unroll
            for (int i = 0; i < 8; ++i) kr[i] = *(const u32x4*)(vg + (size_t)(half * 8 + i) * 16 * 1024);
#pragma unroll
            for (int i = 0; i < 8; ++i) *(LAS u32x4*)(vl + (half * 8 + i) * 16 * LDV) = kr[i];
        }
    }
    __syncthreads();
    const LAS unsigned char* vbase = lds + fr * LDV + fq * 8;
    bf16_t* obase = o + (size_t)(row0 + fr) * D + h * 256 + 4 * fq;
#pragma unroll
    for (int dh = 0; dh < 2; ++dh) {
        f32x4 O[2][8];
#pragma unroll
        for (int qb = 0; qb < 2; ++qb)
#pragma unroll
            for (int db = 0; db < 8; ++db) O[qb][db] = (f32x4){0.f, 0.f, 0.f, 0.f};
        u32x2 vlo[2][4], vhi[2][4];
#pragma unroll
        for (int k4 = 0; k4 < 4; ++k4) { const LAS unsigned char* vp = vbase + 128 * dh * LDV + 64 * k4; vlo[0][k4] = *(const LAS u32x2*)vp; vhi[0][k4] = *(const LAS u32x2*)(vp + 32); }
#pragma unroll
        for (int it = 0; it < 16; ++it) {
            if (it < 15) {
#pragma unroll
                for (int k4 = 0; k4 < 4; ++k4) { const LAS unsigned char* vp = vbase + (128 * dh + 16 * ((it + 1) >> 1)) * LDV + 64 * (4 * ((it + 1) & 1) + k4); vlo[(it + 1) & 1][k4] = *(const LAS u32x2*)vp; vhi[(it + 1) & 1][k4] = *(const LAS u32x2*)(vp + 32); }
            }
#pragma unroll
            for (int k4 = 0; k4 < 4; ++k4) {
                const u32x4 w = {vlo[it & 1][k4].x, vlo[it & 1][k4].y, vhi[it & 1][k4].x, vhi[it & 1][k4].y}; const bf16x8 vf = __builtin_bit_cast(bf16x8, w);
#pragma unroll
                for (int qb = 0; qb < 2; ++qb) O[qb][it >> 1] = __builtin_amdgcn_mfma_f32_16x16x32_bf16(vf, Pf[qb][4 * (it & 1) + k4], O[qb][it >> 1], 0, 0, 0);
            }
#pragma unroll
            for (int k4 = 0; k4 < 4; ++k4) { __builtin_amdgcn_sched_group_barrier(0x100, 2, 0); __builtin_amdgcn_sched_group_barrier(0x008, 2, 0); }
            __builtin_amdgcn_sched_barrier(0);
        }
#pragma unroll
        for (int qb = 0; qb < 2; ++qb)
#pragma unroll
            for (int db = 0; db < 8; ++db) {
                const f32x4 v = O[qb][db] * inv[qb]; u32x2 w; w.x = cvt_pk_bf16(v[0], v[1]); w.y = cvt_pk_bf16(v[2], v[3]);
                *(u32x2*)(obase + (size_t)(16 * qb) * D + 128 * dh + 16 * db) = w;
            }
    }
    __syncthreads();
}

#define PHASE_ARGS const Args& a, LAS unsigned char* lds, unsigned char* ws, int tid, int wid, int lane, int bid, int G
#define PHASE_CALL a, lds, ws, tid, wid, lane, bid, G
constexpr size_t TS1024 = (size_t)256 * 1024 * 2;

__device__ __forceinline__ void phase_p1(PHASE_ARGS) {
    pg8::Sched S{}; S.G = G; S.c = bid; S.tstep = TS1024;
    S.A0 = (const char*)(ws + WS_HN); S.B0 = (const char*)(ws + WS_BT1); S.nM0 = 64; S.nN0 = 4;
    S.A1 = (const char*)(ws + WS_HN); S.B1 = (const char*)(ws + WS_BT1) + (size_t)1024 * 2048; S.nM1 = 64; S.nN1 = 2;
    S.A2 = (const char*)(ws + WS_BT1) + (size_t)1536 * 2048; S.B2 = (const char*)(ws + WS_HN); S.nM2 = 2; S.nN2 = 64;
    EpiP1 E{(bf16_t*)(ws + WS_AGLU), (bf16_t*)(ws + WS_U), (bf16_t*)(ws + WS_GVT), a.in[4], (const float*)(ws + WS_RX)};
    pg8::gemm_phase(lds, 1024, S, E);
}
__device__ __forceinline__ void phase_p2(PHASE_ARGS) {
    conv_unit<64>(a, lds, bid, tid, wid, lane);
    if (bid < 128) {
        gmlp_unit(a, lds, bid, tid, wid, lane);
    } else if (bid < 160) {
        pg8::Sched S{}; S.G = 32; S.c = bid - 128; S.tstep = TS1024;
        S.A0 = (const char*)(ws + WS_MN); S.B0 = (const char*)(ws + WS_WKV); S.nM0 = 4; S.nN0 = 4;
        S.A1 = (const char*)(ws + WS_WKV) + (size_t)1024 * 2048; S.B1 = (const char*)(ws + WS_MN); S.nM1 = 4; S.nN1 = 4;
        EpiKV E{(bf16_t*)(ws + WS_KM), (bf16_t*)(ws + WS_VT)};
        pg8::gemm_phase(lds, 1024, S, E);
    } else {
        late_weights(a, lds, (bid - 160) * 8 + wid, 96 * 8, wid, lane);
    }
}
__device__ __forceinline__ void phase_p3(PHASE_ARGS) {
    pg8::Sched S{}; S.G = G; S.c = bid; S.tstep = TS1024;
    S.A0 = (const char*)(ws + WS_MIX); S.B0 = (const char*)(ws + WS_WOUT); S.nM0 = 64; S.nN0 = 4;
    EpiRes<true> E{(const bf16_t*)(ws + WS_HN), (bf16_t*)(ws + WS_HB), (float*)(ws + WS_SSQ1)};
    pg8::gemm_phase(lds, 1024, S, E);
}
__device__ __forceinline__ void phase_p4(PHASE_ARGS) {
    pg8::Sched S{}; S.G = 1 << 20; S.c = bid; S.tstep = TS1024;
    S.A0 = (const char*)(ws + WS_HB); S.B0 = (const char*)(ws + WS_WQ); S.nM0 = 64; S.nN0 = 4;
    Unit un; S.next(0, un);
    EpiQ E{(bf16_t*)(ws + WS_Q), (const float*)(ws + WS_SSQ1)};
    pg8::gemm_phase(lds, 1024, S, E);
    asm volatile("s_waitcnt vmcnt(0)" ::: "memory");
    __syncthreads();
    attn_unit(lds, (const bf16_t*)(ws + WS_Q), (const bf16_t*)(ws + WS_KM), (const bf16_t*)(ws + WS_VT), (bf16_t*)(ws + WS_HN), un.pm, un.pn, tid, wid, lane);
}
__device__ __forceinline__ void phase_p5(PHASE_ARGS) {
    pg8::Sched S{}; S.G = G; S.c = bid; S.tstep = TS1024;
    S.A0 = (const char*)(ws + WS_HN); S.B0 = (const char*)(ws + WS_WO); S.nM0 = 64; S.nN0 = 4;
    EpiRes<true> E{(const bf16_t*)(ws + WS_HB), (bf16_t*)(ws + WS_HB), (float*)(ws + WS_SSQ2)};
    pg8::gemm_phase(lds, 1024, S, E);
}
__device__ __forceinline__ void phase_p6(PHASE_ARGS) {
    pg8::Sched S{}; S.G = G; S.c = bid; S.tstep = TS1024;
    S.A0 = (const char*)(ws + WS_HB); S.B0 = (const char*)(ws + WS_WGU); S.nM0 = 64; S.nN0 = 22;
    EpiGU E{(bf16_t*)(ws + WS_ACT), (const float*)(ws + WS_SSQ2)};
    pg8::gemm_phase(lds, 1024, S, E);
}
__device__ __forceinline__ void phase_p7(PHASE_ARGS) {
    pg8::Sched S{}; S.G = G; S.c = bid; S.tstep = (size_t)256 * FF * 2;
    S.A0 = (const char*)(ws + WS_ACT); S.B0 = (const char*)(ws + WS_WD); S.nM0 = 64; S.nN0 = 4;
    EpiFinal E{(const bf16_t*)(ws + WS_HB), a.out, (float*)(ws + WS_SSQ3), (unsigned*)(ws + WS_CTL + 16384), a.in[22]};
    pg8::gemm_phase(lds, FF, S, E);
}
__global__ void __launch_bounds__(512, 2) fwd_mega(Args a) {
    extern __shared__ __attribute__((aligned(16))) unsigned char lds_raw[];
    LAS unsigned char* lds = (LAS unsigned char*)lds_raw;
    cg::grid_group grid = cg::this_grid();
    const int tid = threadIdx.x, wid = __builtin_amdgcn_readfirstlane(tid >> 6), lane = tid & 63, bid = blockIdx.x, G = gridDim.x;
    unsigned char* ws = a.ws;
    if (tid < 2) ((volatile LAS unsigned*)(lds + LDS_BYTES - 64))[tid] = 0u;
    __syncthreads();
    const XcdBarrier xbar = xcd_barrier_post((unsigned*)(ws + WS_CTL), (volatile LAS unsigned*)(lds + LDS_BYTES - 64));
    if (a.never != 0) grid.sync();
#define GRID_BAR() xcd_barrier(xbar)
    { p0_prologue(a, lds, bid, G, wid, lane); }
    GRID_BAR();
    phase_p1(PHASE_CALL); GRID_BAR();
    { phase_p2(PHASE_CALL);
    } GRID_BAR();
    phase_p3(PHASE_CALL); GRID_BAR();
    { phase_p4(PHASE_CALL); } GRID_BAR();
    { phase_p5(PHASE_CALL); } GRID_BAR();
    phase_p6(PHASE_CALL); GRID_BAR();
    phase_p7(PHASE_CALL);
}

extern "C" void kernel_launch(void* const* d_in, const int* in_sizes, int n_in, void* d_out, int out_size, void* d_ws, size_t ws_size, hipStream_t stream) {
    static int grid = 0;
    if (grid == 0) {
        int dev = 0, cus = 0, per_cu = 0;
        (void)hipGetDevice(&dev);
        (void)hipDeviceGetAttribute(&cus, hipDeviceAttributeMultiprocessorCount, dev);
        (void)hipFuncSetAttribute((const void*)fwd_mega, hipFuncAttributeMaxDynamicSharedMemorySize, LDS_BYTES);
        (void)hipOccupancyMaxActiveBlocksPerMultiprocessor(&per_cu, (const void*)fwd_mega, 512, LDS_BYTES);
        (void)hipGetLastError();
        grid = cus > 0 ? cus : 256;
        if (grid > 256) grid = 256;
    }
    Args a{};
    for (int i = 0; i < 23; ++i) a.in[i] = (const float*)d_in[i];
    a.out = (float*)d_out; a.ws = (unsigned char*)d_ws; a.never = 0ull;
    (void)hipMemsetAsync((char*)d_ws + WS_CTL, 0, CTL_ZERO_BYTES, stream);
    void* args[] = {&a};
    hipError_t e = hipLaunchCooperativeKernel((const void*)fwd_mega, dim3(grid), dim3(512), args, LDS_BYTES, stream);
    if (e != hipSuccess) fprintf(stderr, "cooperative launch failed: %s (grid %d)\n", hipGetErrorString(e), grid);
}
```

```cpp
#include <hip/hip_runtime.h>
#include <hip/hip_cooperative_groups.h>
#include <cstdio>
#include <cstdint>
namespace cg = cooperative_groups;

#define LAS __attribute__((address_space(3)))
typedef unsigned short bf16_t;
typedef short bf16x8 __attribute__((ext_vector_type(8)));
typedef float f32x4 __attribute__((ext_vector_type(4)));
typedef float f32x2 __attribute__((ext_vector_type(2)));
typedef unsigned u32x4 __attribute__((ext_vector_type(4)));
typedef unsigned u32x2 __attribute__((ext_vector_type(2)));

constexpr int D = 1024, NB = 4, SEQ = 4096, M = NB * SEQ, CW = 512, GW = 512, CHUNK = 128, MEML = 256, MR = NB * MEML, FF = 2816;
constexpr float RMS_EPS = 1e-6f, LN_EPS = 1e-5f;
constexpr float LOG2E = 1.4426950408889634f;
constexpr float QSCALE = 0.0625f * LOG2E;

constexpr size_t MiB = 1u << 20;
constexpr size_t WS_BT1 = 0 * MiB;
constexpr size_t WS_WOUT = 4 * MiB;
constexpr size_t WS_WQ = 6 * MiB;
constexpr size_t WS_WKV = 8 * MiB;
constexpr size_t WS_WO = 12 * MiB;
constexpr size_t WS_WGU = 14 * MiB;
constexpr size_t WS_WD = 25 * MiB;
constexpr size_t WS_WSB = 31 * MiB;
constexpr size_t WS_MN = 32 * MiB;
constexpr size_t WS_KM = 34 * MiB;
constexpr size_t WS_VT = 36 * MiB;
constexpr size_t WS_SSQ1 = 38 * MiB, WS_SSQ2 = 39 * MiB, WS_SSQ3 = 40 * MiB;
constexpr size_t WS_HB = 48 * MiB;
constexpr size_t WS_HN = 80 * MiB;
constexpr size_t WS_MIX = 176 * MiB;
constexpr size_t WS_RX = 42 * MiB;
constexpr size_t WS_AGLU = 112 * MiB;
constexpr size_t WS_U = 128 * MiB;
constexpr size_t WS_GVT = 144 * MiB;
constexpr size_t WS_Q = 112 * MiB;
constexpr size_t WS_ACT = 80 * MiB;
constexpr int LDS_BYTES = 147456;


constexpr size_t WS_CTL = 41 * MiB;
constexpr size_t CTL_ZERO_BYTES = 32768;
#define XB_TMO      128
#define XB_XCNT(j)  (256  + 64 * (j))
#define XB_XSUB(j)  (1280 + 64 * (j))
#define XB_XGEN(j)  (2304 + 64 * (j))
#define XB_TOP      3328
#define XB_TOPGEN   3392
#define XB_SPIN_CAP (1u << 18)
__device__ __forceinline__ unsigned xb_ld(unsigned* p)              { return __hip_atomic_load(p, __ATOMIC_RELAXED, __HIP_MEMORY_SCOPE_AGENT); }
__device__ __forceinline__ unsigned xb_add(unsigned* p, unsigned v) { return __hip_atomic_fetch_add(p, v, __ATOMIC_RELAXED, __HIP_MEMORY_SCOPE_AGENT); }
__device__ __forceinline__ unsigned xb_xcc_id() { return (unsigned)__builtin_amdgcn_s_getreg((3 << 11) | 20) & 0xFu; }
#define XB_SPIN(cond, bar) do { unsigned _sp = 0; while (cond) { __builtin_amdgcn_s_sleep(1); \
    if ((++_sp & 255u) == 0u) { if (xb_ld(&(bar)[XB_TMO])) break; if (_sp > XB_SPIN_CAP) { atomicAdd(&(bar)[XB_TMO], 1u); break; } } } } while (0)
struct XcdBarrier { unsigned* bar; unsigned x; volatile LAS unsigned* st; };
__device__ __forceinline__ XcdBarrier xcd_barrier_post(unsigned* bar, volatile LAS unsigned* st) {
    XcdBarrier b; b.bar = bar; b.x = xb_xcc_id(); b.st = st;
    if (threadIdx.x == 0) (void)xb_add(&bar[XB_XCNT(b.x)], 1u);
    return b;
}
__device__ __forceinline__ void xcd_barrier_complete(unsigned* bar, unsigned x, unsigned& nloc, unsigned& nx) {
    const unsigned G = gridDim.x * gridDim.y * gridDim.z;
    unsigned sum, cnt, mine, sp = 0u;
    for (;;) {
        sum = 0u; cnt = 0u; mine = 0u;
#pragma unroll
        for (unsigned j = 0; j < 16; ++j) { const unsigned c = xb_ld(&bar[XB_XCNT(j)]); sum += c; cnt += (c > 0u) ? 1u : 0u; mine = (j == x) ? c : mine; }
        if (sum == G) break;
        __builtin_amdgcn_s_sleep(1);
        if ((++sp & 255u) == 0u) { if (xb_ld(&bar[XB_TMO])) break; if (sp > XB_SPIN_CAP) { atomicAdd(&bar[XB_TMO], 1u); break; } }
    }
    nloc = mine > 0u ? mine : 1u; nx = cnt > 0u ? cnt : 1u;
}
__device__ __forceinline__ void xcd_barrier(const XcdBarrier& b) {
    asm volatile("s_waitcnt vmcnt(0)" ::: "memory");
    __syncthreads();
    if (threadIdx.x == 0) {
        unsigned* bar = b.bar;
        __builtin_amdgcn_s_waitcnt(0);
        unsigned nloc = b.st[0], nx = b.st[1];
        if (nloc == 0u) { xcd_barrier_complete(bar, b.x, nloc, nx); b.st[0] = nloc; b.st[1] = nx; }
        const unsigned old = xb_add(&bar[XB_XSUB(b.x)], 1u);
        const unsigned gen = old / nloc;
        if (old + 1u == (gen + 1u) * nloc) {
            __builtin_amdgcn_fence(__ATOMIC_RELEASE, "agent");
            asm volatile("s_waitcnt vmcnt(0)" ::: "memory");
            const unsigned og = xb_add(&bar[XB_TOP], 1u);
            const unsigned tg = og / nx;
            if (og + 1u == (tg + 1u) * nx) xb_add(&bar[XB_TOPGEN], 1u);
            else XB_SPIN(xb_ld(&bar[XB_TOPGEN]) == tg, bar);
            __builtin_amdgcn_fence(__ATOMIC_ACQUIRE, "agent");
            xb_add(&bar[XB_XGEN(b.x)], 1u);
            asm volatile("s_waitcnt vmcnt(0)" ::: "memory");
        } else {
            XB_SPIN(xb_ld(&bar[XB_XGEN(b.x)]) == gen, bar);
            __builtin_amdgcn_fence(__ATOMIC_ACQUIRE, "agent");
            asm volatile("s_waitcnt vmcnt(0)" ::: "memory");
        }
    }
    __syncthreads();
}

__device__ __forceinline__ unsigned cvt_pk_bf16(float lo, float hi) { unsigned r; asm volatile("v_cvt_pk_bf16_f32 %0, %1, %2" : "=v"(r) : "v"(lo), "v"(hi)); return r; }
__device__ __forceinline__ float bf_lo(unsigned u) { return __uint_as_float(u << 16); }
__device__ __forceinline__ float bf_hi(unsigned u) { return __uint_as_float(u & 0xffff0000u); }
__device__ __forceinline__ float sigmoidf_(float x) { return __builtin_amdgcn_rcpf(1.0f + __builtin_amdgcn_exp2f(-LOG2E * x)); }
__device__ __forceinline__ float siluf_(float x) { return x * sigmoidf_(x); }
__device__ __forceinline__ float geluf_(float x) { const float u = 0.7978845608028654f * (x + 0.044715f * x * x * x); return x * __builtin_amdgcn_rcpf(1.0f + __builtin_amdgcn_exp2f(-2.0f * LOG2E * u)); }
__device__ __forceinline__ f32x2 sigmoid2_(float x0, float x1) {
    const float a = 1.0f + __builtin_amdgcn_exp2f(fminf(-LOG2E * x0, 60.0f)), b = 1.0f + __builtin_amdgcn_exp2f(fminf(-LOG2E * x1, 60.0f));
    const float r = __builtin_amdgcn_rcpf(a * b);
    return (f32x2){r * b, r * a};
}
__device__ __forceinline__ f32x2 gelu2_(float x0, float x1) {
    const float u0 = 1.5957691216057308f * (x0 + 0.044715f * x0 * x0 * x0), u1 = 1.5957691216057308f * (x1 + 0.044715f * x1 * x1 * x1);
    const f32x2 sg = sigmoid2_(u0, u1); return (f32x2){x0 * sg[0], x1 * sg[1]};
}
__device__ __forceinline__ f32x4 swiglu4_(f32x4 ag, f32x4 au, float c1, float rr) {
    f32x4 t = ag * c1;
    t = __builtin_elementwise_min(t, (f32x4){60.f, 60.f, 60.f, 60.f});
    f32x4 e; e[0] = __builtin_amdgcn_exp2f(t[0]); e[1] = __builtin_amdgcn_exp2f(t[1]); e[2] = __builtin_amdgcn_exp2f(t[2]); e[3] = __builtin_amdgcn_exp2f(t[3]);
    const f32x4 a4 = e + 1.0f;
    const float r01 = __builtin_amdgcn_rcpf(a4[0] * a4[1]), r23 = __builtin_amdgcn_rcpf(a4[2] * a4[3]);
    const f32x4 sw = {a4[1], a4[0], a4[3], a4[2]}, rc = {r01, r01, r23, r23};
    return (ag * au) * ((rc * sw) * rr);
}
__device__ __forceinline__ f32x4 sig4_from_t_(f32x4 t) {
    t = __builtin_elementwise_min(t, (f32x4){60.f, 60.f, 60.f, 60.f});
    f32x4 e; e[0] = __builtin_amdgcn_exp2f(t[0]); e[1] = __builtin_amdgcn_exp2f(t[1]); e[2] = __builtin_amdgcn_exp2f(t[2]); e[3] = __builtin_amdgcn_exp2f(t[3]);
    const f32x4 a4 = e + 1.0f;
    const float r01 = __builtin_amdgcn_rcpf(a4[0] * a4[1]), r23 = __builtin_amdgcn_rcpf(a4[2] * a4[3]);
    const f32x4 sw = {a4[1], a4[0], a4[3], a4[2]}, rc = {r01, r01, r23, r23};
    return rc * sw;
}
__device__ __forceinline__ f32x4 glu4_(f32x4 za, f32x4 zg) { return za * sig4_from_t_(zg * (-LOG2E)); }
__device__ __forceinline__ f32x4 gelu4_(f32x4 x) {
    constexpr float CA = -LOG2E * 1.5957691216057308f, CB = CA * 0.044715f;
    return x * sig4_from_t_(x * ((x * x) * CB + CA));
}
__device__ __forceinline__ float wave_sum(float v) {
#pragma unroll
    for (int o = 1; o < 64; o <<= 1) v += __shfl_xor(v, o);
    return v;
}
__device__ __forceinline__ u32x4 pack8(f32x4 a, f32x4 b) { u32x4 w; w.x = cvt_pk_bf16(a[0], a[1]); w.y = cvt_pk_bf16(a[2], a[3]); w.z = cvt_pk_bf16(b[0], b[1]); w.w = cvt_pk_bf16(b[2], b[3]); return w; }

namespace pg8 {
constexpr int BM = 256, BK = 64, HALF = 128, HTB = HALF * BK * 2, NXCD = 8, WGM = 8;
__device__ __forceinline__ int lds_byte(int r, int c) { const int st = (r >> 4) * 2 + (c >> 5), rr = r & 15, cc = c & 31, ob = rr * 64 + cc * 2; return st * 1024 + (ob ^ (((ob >> 9) & 1) << 5)); }
__device__ __forceinline__ void stage_rc(int b, int& R, int& C) { const int st = b / 1024, sb = b % 1024, swz = sb ^ (((sb >> 9) & 1) << 5); R = (st >> 1) * 16 + swz / 64; C = (st & 1) * 32 + (swz % 64) / 2; }
__device__ __forceinline__ int perm32(int rho) { const int n = rho >> 4, i = rho & 15; return 8 * (i >> 2) + 4 * n + (i & 3); }

struct Unit { const char* A; const char* B; int pm, pn, kind; };

__device__ __forceinline__ void tile_order(int wgid, int nM, int nN, int& pm, int& pn) {
    const int nwg = nM * nN;
    { const int q = nwg / NXCD, r = nwg % NXCD, xcd = wgid % NXCD, off = wgid / NXCD; wgid = (xcd < r ? xcd * (q + 1) : r * (q + 1) + (xcd - r) * q) + off; }
    const int nig = WGM * nN, gid = wgid / nig, fm = gid * WGM, gsz = (nM - fm) < WGM ? (nM - fm) : WGM;
    pm = fm + ((wgid % nig) % gsz); pn = (wgid % nig) / gsz;
}
struct Sched {
    const char *A0, *B0, *A1, *B1, *A2, *B2; int nM0, nN0, nM1, nN1, nM2, nN2; int G, c; size_t tstep;
    __device__ __forceinline__ bool next(int i, Unit& u) const {
        int L = i * G + c;
        if (L < nM0 * nN0) { tile_order(L, nM0, nN0, u.pm, u.pn); u.A = A0 + (size_t)u.pm * tstep; u.B = B0 + (size_t)u.pn * tstep; u.kind = 0; return true; }
        L -= nM0 * nN0;
        if (L < nM1 * nN1) { tile_order(L, nM1, nN1, u.pm, u.pn); u.A = A1 + (size_t)u.pm * tstep; u.B = B1 + (size_t)u.pn * tstep; u.kind = 1; return true; }
        L -= nM1 * nN1;
        if (L < nM2 * nN2) { tile_order(L, nM2, nN2, u.pm, u.pn); u.A = A2 + (size_t)u.pm * tstep; u.B = B2 + (size_t)u.pn * tstep; u.kind = 2; return true; }
        return false;
    }
};
template <class Epi, class Sch>
__device__ __forceinline__ void gemm_phase(LAS unsigned char* lds, const int K, const Sch& S, const Epi& E) {
    int tid_ = threadIdx.x; asm volatile("" : "+v"(tid_));
    const int tid = tid_, wid = __builtin_amdgcn_readfirstlane(tid >> 6), lane = tid & 63, wr = wid >> 2, wc = wid & 3, fr = lane & 15, fq = lane >> 4;
    const int nt = K / BK;
    unsigned voffA[2], voffB[2];
#pragma unroll
    for (int i = 0; i < 2; ++i) { int R, C; stage_rc(tid * 16 + i * 8192, R, C); const int Rb = (R & ~31) + perm32(R & 31);
        voffA[i] = (unsigned)(R * K + C) * 2u; voffB[i] = (unsigned)(Rb * K + C) * 2u; }
    const size_t kstep = (size_t)(BK * 2);
    const size_t hstep = (size_t)HALF * K * 2;
    const unsigned ldsw = (unsigned)wid * 1024u;
    const int aoff = lds_byte(wr * 64 + fr, fq * 8), boff = lds_byte(wc * 32 + fr, fq * 8);
#define PG8_SA(b, h) (((b) * 2 + (h)) * HTB)
#define PG8_SB(b, h) ((4 + (b) * 2 + (h)) * HTB)
#define PG8_STAGE(bufoff, gbase, voff) do { _Pragma("unroll") for (int _i = 0; _i < 2; ++_i) \
        __builtin_amdgcn_global_load_lds((const unsigned*)((const char*)(gbase) + (voff)[_i]), (LAS unsigned*)(lds + (bufoff) + ldsw + _i * 8192), 16, 0, 0); } while (0)
#define PG8_LDA(dst, b, h) do { _Pragma("unroll") for (int m = 0; m < 4; ++m) _Pragma("unroll") for (int k = 0; k < 2; ++k) dst[m][k] = *(const LAS bf16x8*)(lds + PG8_SA(b, h) + aoff + m * 2048 + k * 1024); } while (0)
#define PG8_LDB(dst, b, h) do { _Pragma("unroll") for (int n = 0; n < 2; ++n) _Pragma("unroll") for (int k = 0; k < 2; ++k) dst[n][k] = *(const LAS bf16x8*)(lds + PG8_SB(b, h) + boff + n * 2048 + k * 1024); } while (0)
#define PG8_MMA(ai, bj, At, Bt) do { __builtin_amdgcn_s_setprio(1); _Pragma("unroll") for (int m = 0; m < 4; ++m) _Pragma("unroll") for (int n = 0; n < 2; ++n) _Pragma("unroll") for (int k = 0; k < 2; ++k) \
        acc[ai][bj][m][n] = __builtin_amdgcn_mfma_f32_16x16x32_bf16(Bt[n][k], At[m][k], acc[ai][bj][m][n], 0, 0, 0); __builtin_amdgcn_s_setprio(0); } while (0)
#define PG8_WAIT_V(n) asm volatile("s_waitcnt vmcnt(" #n ")" ::: "memory")
#define PG8_WAIT_L(n) asm volatile("s_waitcnt lgkmcnt(" #n ")" ::: "memory")
#define PG8_BAR __builtin_amdgcn_s_barrier()
#define PG8_SCHED __builtin_amdgcn_sched_barrier(0)
    Unit cur, nxt; int ui = 0;
    if (!S.next(0, cur)) return;
    f32x4 acc[2][2][4][2];
#pragma unroll
    for (int a = 0; a < 2; ++a)
#pragma unroll
        for (int b = 0; b < 2; ++b)
#pragma unroll
            for (int m = 0; m < 4; ++m)
#pragma unroll
                for (int n = 0; n < 2; ++n) acc[a][b][m][n] = (f32x4){0.f, 0.f, 0.f, 0.f};
    bf16x8 At[4][2], B0[2][2], B1[2][2];
    const char* cA = cur.A; const char* cB = cur.B;
    PG8_STAGE(PG8_SB(0, 0), cB, voffB); PG8_STAGE(PG8_SB(0, 1), cB + hstep, voffB); PG8_STAGE(PG8_SA(0, 0), cA, voffA); PG8_STAGE(PG8_SA(0, 1), cA + hstep, voffA);
    if (wr == 1) PG8_BAR;
    PG8_WAIT_V(2); PG8_BAR;
    PG8_STAGE(PG8_SB(1, 0), cB + kstep, voffB); PG8_STAGE(PG8_SA(1, 0), cA + kstep, voffA); PG8_STAGE(PG8_SB(1, 1), cB + hstep + kstep, voffB);
    PG8_WAIT_V(6); PG8_BAR;
    for (;;) {
        const bool has_next = S.next(ui + 1, nxt);
        const char* nA = has_next ? nxt.A : cA; const char* nB = has_next ? nxt.B : cB;
        for (int t = 0; t < nt; t += 2) {
            const bool last = (t == nt - 2);
            const char* a1 = cA + (size_t)(t + 1) * kstep;
            const char* a2 = last ? nA : cA + (size_t)(t + 2) * kstep; const char* b2 = last ? nB : cB + (size_t)(t + 2) * kstep;
            const char* a3 = a2 + kstep; const char* b3 = b2 + kstep;
            PG8_LDB(B0, 0, 0); PG8_LDB(B1, 0, 1); PG8_SCHED; PG8_LDA(At, 0, 0); PG8_STAGE(PG8_SA(1, 1), a1 + hstep, voffA);
            PG8_WAIT_V(8); PG8_WAIT_L(0); PG8_BAR; PG8_MMA(0, 0, At, B0); PG8_MMA(0, 1, At, B1); PG8_BAR; PG8_SCHED;
            PG8_LDA(At, 0, 1); PG8_STAGE(PG8_SB(0, 0), b2, voffB); PG8_STAGE(PG8_SB(0, 1), b2 + hstep, voffB); PG8_STAGE(PG8_SA(0, 0), a2, voffA);
            PG8_WAIT_V(8); PG8_WAIT_L(0); PG8_BAR; PG8_MMA(1, 0, At, B0); PG8_MMA(1, 1, At, B1); PG8_BAR; PG8_SCHED;
            PG8_LDB(B0, 1, 0); PG8_LDB(B1, 1, 1); PG8_SCHED; PG8_LDA(At, 1, 0); PG8_STAGE(PG8_SA(0, 1), a2 + hstep, voffA);
            PG8_WAIT_V(8); PG8_WAIT_L(0); PG8_BAR; PG8_MMA(0, 0, At, B0); PG8_MMA(0, 1, At, B1); PG8_BAR; PG8_SCHED;
            PG8_LDA(At, 1, 1); PG8_STAGE(PG8_SB(1, 0), b3, voffB); PG8_STAGE(PG8_SB(1, 1), b3 + hstep, voffB); PG8_STAGE(PG8_SA(1, 0), a3, voffA);
            PG8_WAIT_V(8); PG8_WAIT_L(0); PG8_BAR; PG8_MMA(1, 0, At, B0); PG8_MMA(1, 1, At, B1); PG8_BAR; PG8_SCHED;
        }
        if (wr == 0) PG8_BAR;
        E(acc, cur, wr, wc, fr, fq);
        if (!has_next) break;
#pragma unroll
        for (int a = 0; a < 2; ++a)
#pragma unroll
            for (int b = 0; b < 2; ++b)
#pragma unroll
                for (int m = 0; m < 4; ++m)
#pragma unroll
                    for (int n = 0; n < 2; ++n) acc[a][b][m][n] = (f32x4){0.f, 0.f, 0.f, 0.f};
        cur = nxt; cA = nA; cB = nB; ++ui;
        if (wr == 1) PG8_BAR;
    }
    PG8_WAIT_V(0);
    PG8_BAR;
#undef PG8_SA
#undef PG8_SB
#undef PG8_STAGE
#undef PG8_LDA
#undef PG8_LDB
#undef PG8_MMA
#undef PG8_WAIT_V
#undef PG8_WAIT_L
#undef PG8_BAR
#undef PG8_SCHED
}
}
using pg8::Unit;

#define EPI_ROW(ai, m) (un.pm * 256 + (ai) * 128 + wr * 64 + (m) * 16 + fr)
struct EpiP1 {
    bf16_t* aglu; bf16_t* u; bf16_t* gvT; const float* b_in; const float* rx;
    __device__ __forceinline__ void operator()(const f32x4 (&acc)[2][2][4][2], const Unit& un, int wr, int wc, int fr, int fq) const {
        if (un.kind == 0) {
            const int c0 = un.pn * 128 + wc * 32 + 8 * fq;
            f32x4 ba[2], bg[2];
#pragma unroll
            for (int n = 0; n < 2; ++n) { ba[n] = *(const f32x4*)(b_in + c0 + 4 * n); bg[n] = *(const f32x4*)(b_in + 512 + c0 + 4 * n); }
            float rsv[2][4];
#pragma unroll
            for (int ai = 0; ai < 2; ++ai)
#pragma unroll
                for (int m = 0; m < 4; ++m) rsv[ai][m] = rx[EPI_ROW(ai, m)];
#pragma unroll
            for (int ai = 0; ai < 2; ++ai)
#pragma unroll
                for (int m = 0; m < 4; ++m) {
                    f32x4 v[2]; const float rs = rsv[ai][m];
#pragma unroll
                    for (int n = 0; n < 2; ++n) v[n] = glu4_(acc[ai][0][m][n] * rs + ba[n], acc[ai][1][m][n] * rs + bg[n]);
                    *(u32x4*)(aglu + (size_t)EPI_ROW(ai, m) * CW + c0) = pack8(v[0], v[1]);
                }
        } else if (un.kind == 1) {
            float rsv[2][4];
#pragma unroll
            for (int ai = 0; ai < 2; ++ai)
#pragma unroll
                for (int m = 0; m < 4; ++m) rsv[ai][m] = rx[EPI_ROW(ai, m)];
#pragma unroll
            for (int bj = 0; bj < 2; ++bj) {
                const int cu = un.pn * 256 + bj * 128 + wc * 32 + 8 * fq;
                f32x4 bb[2];
#pragma unroll
                for (int n = 0; n < 2; ++n) bb[n] = *(const f32x4*)(b_in + 1024 + cu + 4 * n);
#pragma unroll
                for (int ai = 0; ai < 2; ++ai)
#pragma unroll
                    for (int m = 0; m < 4; ++m) {
                        f32x4 v[2]; const float rs = rsv[ai][m];
#pragma unroll
                        for (int n = 0; n < 2; ++n) v[n] = gelu4_(acc[ai][bj][m][n] * rs + bb[n]);
                        *(u32x4*)(u + (size_t)EPI_ROW(ai, m) * GW + cu) = pack8(v[0], v[1]);
                    }
            }
        } else {
            f32x4 rt[2][2];
#pragma unroll
            for (int bj = 0; bj < 2; ++bj)
#pragma unroll
                for (int n = 0; n < 2; ++n) rt[bj][n] = *(const f32x4*)(rx + un.pn * 256 + bj * 128 + wc * 32 + 8 * fq + 4 * n);
            float bbv[2][4];
#pragma unroll
            for (int ai = 0; ai < 2; ++ai)
#pragma unroll
                for (int m = 0; m < 4; ++m) bbv[ai][m] = b_in[1536 + EPI_ROW(ai, m)];
#pragma unroll
            for (int ai = 0; ai < 2; ++ai)
#pragma unroll
                for (int m = 0; m < 4; ++m) {
                    const int ch = EPI_ROW(ai, m);
                    const float bb = bbv[ai][m];
#pragma unroll
                    for (int bj = 0; bj < 2; ++bj) {
                        const int tok = un.pn * 256 + bj * 128 + wc * 32 + 8 * fq;
                        f32x4 v[2];
#pragma unroll
                        for (int n = 0; n < 2; ++n) v[n] = gelu4_(acc[ai][bj][m][n] * rt[bj][n] + bb);
                        *(u32x4*)(gvT + (size_t)ch * M + tok) = pack8(v[0], v[1]);
                    }
                }
        }
    }
};
struct EpiKV {
    bf16_t* o0; bf16_t* o1;
    __device__ __forceinline__ void operator()(const f32x4 (&acc)[2][2][4][2], const Unit& un, int wr, int wc, int fr, int fq) const {
        bf16_t* o = un.kind == 0 ? o0 : o1;
#pragma unroll
        for (int ai = 0; ai < 2; ++ai)
#pragma unroll
            for (int m = 0; m < 4; ++m)
#pragma unroll
                for (int bj = 0; bj < 2; ++bj)
                    *(u32x4*)(o + (size_t)EPI_ROW(ai, m) * 1024 + un.pn * 256 + bj * 128 + wc * 32 + 8 * fq) = pack8(acc[ai][bj][m][0], acc[ai][bj][m][1]);
    }
};
template <bool RES_BF16> struct EpiRes {
    const bf16_t* resb; bf16_t* hb; float* ssq;
    __device__ __forceinline__ void operator()(const f32x4 (&acc)[2][2][4][2], const Unit& un, int wr, int wc, int fr, int fq) const {
        const size_t off0 = (size_t)(un.pm * 256 + wr * 64 + fr) * D + un.pn * 256 + wc * 32 + 8 * fq;
        if (RES_BF16) {
            u32x4 hv[2][4][2];
#pragma unroll
            for (int ai = 0; ai < 2; ++ai)
#pragma unroll
                for (int m = 0; m < 4; ++m)
#pragma unroll
                    for (int bj = 0; bj < 2; ++bj) hv[ai][m][bj] = *(const u32x4*)(resb + off0 + (size_t)(ai * 128 + m * 16) * D + bj * 128);
#pragma unroll
            for (int ai = 0; ai < 2; ++ai)
#pragma unroll
                for (int m = 0; m < 4; ++m) {
                    float ss = 0.f;
#pragma unroll
                    for (int bj = 0; bj < 2; ++bj) {
                        const u32x4 h4 = hv[ai][m][bj];
                        const f32x4 v0 = acc[ai][bj][m][0] + (f32x4){bf_lo(h4.x), bf_hi(h4.x), bf_lo(h4.y), bf_hi(h4.y)}, v1 = acc[ai][bj][m][1] + (f32x4){bf_lo(h4.z), bf_hi(h4.z), bf_lo(h4.w), bf_hi(h4.w)};
                        *(u32x4*)(hb + off0 + (size_t)(ai * 128 + m * 16) * D + bj * 128) = pack8(v0, v1);
                        ss += (v0[0] * v0[0] + v0[1] * v0[1]) + (v0[2] * v0[2] + v0[3] * v0[3]) + (v1[0] * v1[0] + v1[1] * v1[1]) + (v1[2] * v1[2] + v1[3] * v1[3]);
                    }
                    ss += __shfl_xor(ss, 16); ss += __shfl_xor(ss, 32);
                    if (fq == 0) ssq[(size_t)EPI_ROW(ai, m) * 16 + un.pn * 4 + wc] = ss;
                }
        } else {
#pragma unroll
            for (int aim = 0; aim < 4; ++aim) {
                const int ai = aim >> 1;
                f32x4 rv[4][2][2];
#pragma unroll
                for (int m = 2 * (aim & 1); m < 2 * (aim & 1) + 2; ++m)
#pragma unroll
                    for (int bj = 0; bj < 2; ++bj) { const float* p = (const float*)resb + off0 + (size_t)(ai * 128 + m * 16) * D + bj * 128; rv[m][bj][0] = *(const f32x4*)p; rv[m][bj][1] = *(const f32x4*)(p + 4); }
#pragma unroll
                for (int m = 2 * (aim & 1); m < 2 * (aim & 1) + 2; ++m) {
                    float ss = 0.f;
#pragma unroll
                    for (int bj = 0; bj < 2; ++bj) {
                        const f32x4 v0 = acc[ai][bj][m][0] + rv[m][bj][0], v1 = acc[ai][bj][m][1] + rv[m][bj][1];
                        *(u32x4*)(hb + off0 + (size_t)(ai * 128 + m * 16) * D + bj * 128) = pack8(v0, v1);
                        ss += (v0[0] * v0[0] + v0[1] * v0[1]) + (v0[2] * v0[2] + v0[3] * v0[3]) + (v1[0] * v1[0] + v1[1] * v1[1]) + (v1[2] * v1[2] + v1[3] * v1[3]);
                    }
                    ss += __shfl_xor(ss, 16); ss += __shfl_xor(ss, 32);
                    if (fq == 0) ssq[(size_t)EPI_ROW(ai, m) * 16 + un.pn * 4 + wc] = ss;
                }
                asm volatile("" ::: "memory");
            }
        }
    }
};
struct EpiFinal {
    const bf16_t* hb; float* out; float* ssqp; unsigned* cnt; const float* g;
    __device__ __forceinline__ void operator()(f32x4 (&acc)[2][2][4][2], const Unit& un, int wr, int wc, int fr, int fq) const {
        const size_t off0 = (size_t)(un.pm * 256 + wr * 64 + fr) * D + un.pn * 256 + wc * 32 + 8 * fq;
        {
            u32x4 hv[2][4][2];
#pragma unroll
            for (int ai = 0; ai < 2; ++ai)
#pragma unroll
                for (int m = 0; m < 4; ++m)
#pragma unroll
                    for (int bj = 0; bj < 2; ++bj) hv[ai][m][bj] = *(const u32x4*)(hb + off0 + (size_t)(ai * 128 + m * 16) * D + bj * 128);
#pragma unroll
            for (int ai = 0; ai < 2; ++ai)
#pragma unroll
                for (int m = 0; m < 4; ++m) {
                    float ss = 0.f;
#pragma unroll
                    for (int bj = 0; bj < 2; ++bj) {
                        const u32x4 h4 = hv[ai][m][bj];
                        const f32x4 v0 = acc[ai][bj][m][0] + (f32x4){bf_lo(h4.x), bf_hi(h4.x), bf_lo(h4.y), bf_hi(h4.y)}, v1 = acc[ai][bj][m][1] + (f32x4){bf_lo(h4.z), bf_hi(h4.z), bf_lo(h4.w), bf_hi(h4.w)};
                        acc[ai][bj][m][0] = v0; acc[ai][bj][m][1] = v1;
                        ss += (v0[0] * v0[0] + v0[1] * v0[1]) + (v0[2] * v0[2] + v0[3] * v0[3]) + (v1[0] * v1[0] + v1[1] * v1[1]) + (v1[2] * v1[2] + v1[3] * v1[3]);
                    }
                    ss += __shfl_xor(ss, 16); ss += __shfl_xor(ss, 32);
                    if (fq == 0) __hip_atomic_store(ssqp + ((size_t)un.pn * M + EPI_ROW(ai, m)) * 4 + wc, ss, __ATOMIC_RELAXED, __HIP_MEMORY_SCOPE_AGENT);
                }
        }
        asm volatile("s_waitcnt vmcnt(0)" ::: "memory");
        if ((threadIdx.x & 63) == 0) __hip_atomic_fetch_add(cnt + 64 * un.pm, 1u, __ATOMIC_RELAXED, __HIP_MEMORY_SCOPE_AGENT);
        f32x4 gg[2][2];
#pragma unroll
        for (int bj = 0; bj < 2; ++bj)
#pragma unroll
            for (int n = 0; n < 2; ++n) gg[bj][n] = *(const f32x4*)(g + un.pn * 256 + bj * 128 + wc * 32 + 8 * fq + 4 * n);
        if (wr == 0 && wc == 0) {
            unsigned sp = 0;
            while ((unsigned)__builtin_amdgcn_readfirstlane(__hip_atomic_load(cnt + 64 * un.pm, __ATOMIC_RELAXED, __HIP_MEMORY_SCOPE_AGENT)) < 32u) { __builtin_amdgcn_s_sleep(2); if (++sp > (1u << 22)) break; }
            __builtin_amdgcn_fence(__ATOMIC_ACQUIRE, "agent");
        }
        asm volatile("s_waitcnt vmcnt(0) lgkmcnt(0)" ::: "memory"); __builtin_amdgcn_s_barrier(); asm volatile("" ::: "memory");
        float rr[2][4];
        {
            unsigned long long p0[2][4], p1[2][4];
#pragma unroll
            for (int ai = 0; ai < 2; ++ai)
#pragma unroll
                for (int m = 0; m < 4; ++m) { const unsigned long long* sp8 = (const unsigned long long*)(ssqp + ((size_t)fq * M + EPI_ROW(ai, m)) * 4);
                    p0[ai][m] = __hip_atomic_load(sp8, __ATOMIC_RELAXED, __HIP_MEMORY_SCOPE_AGENT); p1[ai][m] = __hip_atomic_load(sp8 + 1, __ATOMIC_RELAXED, __HIP_MEMORY_SCOPE_AGENT); }
#pragma unroll
            for (int ai = 0; ai < 2; ++ai)
#pragma unroll
                for (int m = 0; m < 4; ++m) {
                    float t = (__uint_as_float((unsigned)p0[ai][m]) + __uint_as_float((unsigned)(p0[ai][m] >> 32))) + (__uint_as_float((unsigned)p1[ai][m]) + __uint_as_float((unsigned)(p1[ai][m] >> 32)));
                    t += __shfl_xor(t, 16); t += __shfl_xor(t, 32);
                    rr[ai][m] = 1.0f / sqrtf(t * (1.0f / D) + RMS_EPS);
                }
        }
#pragma unroll
        for (int ai = 0; ai < 2; ++ai)
#pragma unroll
            for (int m = 0; m < 4; ++m) {
                const float r = rr[ai][m];
#pragma unroll
                for (int bj = 0; bj < 2; ++bj) {
                    float* op = out + off0 + (size_t)(ai * 128 + m * 16) * D + bj * 128;
                    *(f32x4*)op = acc[ai][bj][m][0] * r * gg[bj][0]; *(f32x4*)(op + 4) = acc[ai][bj][m][1] * r * gg[bj][1];
                }
            }
    }
};
__device__ __forceinline__ float row_rs(const float* ssq, int row, int fq) {
    const f32x4 p = *(const f32x4*)(ssq + (size_t)row * 16 + 4 * fq);
    float s = (p[0] + p[1]) + (p[2] + p[3]); s += __shfl_xor(s, 16); s += __shfl_xor(s, 32);
    return __builtin_amdgcn_rsqf(s * (1.0f / D) + RMS_EPS);
}
struct EpiQ {
    bf16_t* q; const float* ssq;
    __device__ __forceinline__ void operator()(const f32x4 (&acc)[2][2][4][2], const Unit& un, int wr, int wc, int fr, int fq) const {
        float rsv[2][4];
#pragma unroll
        for (int ai = 0; ai < 2; ++ai)
#pragma unroll
            for (int m = 0; m < 4; ++m) rsv[ai][m] = row_rs(ssq, EPI_ROW(ai, m), fq);
#pragma unroll
        for (int ai = 0; ai < 2; ++ai)
#pragma unroll
            for (int m = 0; m < 4; ++m) {
                const int row = EPI_ROW(ai, m); const float r = rsv[ai][m] * QSCALE;
#pragma unroll
                for (int bj = 0; bj < 2; ++bj)
                    *(u32x4*)(q + (size_t)row * D + un.pn * 256 + bj * 128 + wc * 32 + 8 * fq) = pack8(acc[ai][bj][m][0] * r, acc[ai][bj][m][1] * r);
            }
    }
};
struct EpiGU {
    bf16_t* act; const float* ssq;
    __device__ __forceinline__ void operator()(const f32x4 (&acc)[2][2][4][2], const Unit& un, int wr, int wc, int fr, int fq) const {
        float rsv[2][4];
#pragma unroll
        for (int ai = 0; ai < 2; ++ai)
#pragma unroll
            for (int m = 0; m < 4; ++m) rsv[ai][m] = row_rs(ssq, EPI_ROW(ai, m), fq);
#pragma unroll
        for (int ai = 0; ai < 2; ++ai)
#pragma unroll
            for (int m = 0; m < 4; ++m) {
                const int row = EPI_ROW(ai, m); const float r = rsv[ai][m];
                f32x4 v[2];
#pragma unroll
                for (int n = 0; n < 2; ++n) v[n] = swiglu4_(acc[ai][0][m][n], acc[ai][1][m][n], -LOG2E * r, r * r);
                *(u32x4*)(act + (size_t)row * FF + un.pn * 128 + wc * 32 + 8 * fq) = pack8(v[0], v[1]);
            }
    }
};

__device__ __forceinline__ void p0_transpose_item(const float* W, int N, bf16_t* WT, int K, int dest_row0, const float* gk, LAS float* scr, int k0, int n0, int lane) {
    float v[32];
    const float* wp = W + (size_t)(k0 + (lane >> 5)) * N + n0 + (lane & 31);
#pragma unroll
    for (int i = 0; i < 32; ++i) v[i] = wp[(size_t)(2 * i) * N];
    if (gk) {
        const float gv = gk[k0 + lane];
#pragma unroll
        for (int i = 0; i < 32; ++i) v[i] *= __shfl(gv, 2 * i + (lane >> 5));
    }
#pragma unroll
    for (int i = 0; i < 32; ++i) scr[(2 * i + (lane >> 5)) * 33 + (lane & 31)] = v[i];
    asm volatile("s_waitcnt lgkmcnt(0)" ::: "memory");
    const int c = lane & 7;
#pragma unroll
    for (int j = 0; j < 4; ++j) { const int n = (lane >> 3) + 8 * j; const LAS float* s = scr + (8 * c) * 33 + n;
        u32x4 o; o.x = cvt_pk_bf16(s[0 * 33], s[1 * 33]); o.y = cvt_pk_bf16(s[2 * 33], s[3 * 33]); o.z = cvt_pk_bf16(s[4 * 33], s[5 * 33]); o.w = cvt_pk_bf16(s[6 * 33], s[7 * 33]);
        *(u32x4*)(WT + (size_t)(dest_row0 + n) * K + k0 + 8 * c) = o; }
    asm volatile("s_waitcnt lgkmcnt(0)" ::: "memory");
}
__device__ __forceinline__ void rms_row_to_bf16(const float* xrow, const float* g, bf16_t* orow, int lane) {
    const f32x4* xr = (const f32x4*)xrow + lane; const f32x4* gr = (const f32x4*)g + lane;
    f32x4 v[4]; float s = 0.f;
#pragma unroll
    for (int j = 0; j < 4; ++j) { v[j] = xr[64 * j]; s += (v[j][0] * v[j][0] + v[j][1] * v[j][1]) + (v[j][2] * v[j][2] + v[j][3] * v[j][3]); }
    const float r = 1.0f / sqrtf(wave_sum(s) * (1.0f / D) + RMS_EPS);
    u32x2* o8 = (u32x2*)orow + lane;
#pragma unroll
    for (int j = 0; j < 4; ++j) { const f32x4 gg = gr[64 * j]; u32x2 w; w.x = cvt_pk_bf16(v[j][0] * r * gg[0], v[j][1] * r * gg[1]); w.y = cvt_pk_bf16(v[j][2] * r * gg[2], v[j][3] * r * gg[3]); o8[64 * j] = w; }
}

struct Args { const float* in[23]; float* out; unsigned char* ws; unsigned long long never; };

__device__ __forceinline__ void rms_row2_to_bf16(const float* xrow, const float* g, bf16_t* orow, int lane) {
    const f32x4* xr = (const f32x4*)xrow + lane; const f32x4* gr = (const f32x4*)g + lane;
    f32x4 v[8]; float s0 = 0.f, s1 = 0.f;
#pragma unroll
    for (int j = 0; j < 8; ++j) v[j] = xr[64 * j];
#pragma unroll
    for (int j = 0; j < 4; ++j) { s0 += (v[j][0] * v[j][0] + v[j][1] * v[j][1]) + (v[j][2] * v[j][2] + v[j][3] * v[j][3]); s1 += (v[4 + j][0] * v[4 + j][0] + v[4 + j][1] * v[4 + j][1]) + (v[4 + j][2] * v[4 + j][2] + v[4 + j][3] * v[4 + j][3]); }
    const float r0 = 1.0f / sqrtf(wave_sum(s0) * (1.0f / D) + RMS_EPS), r1 = 1.0f / sqrtf(wave_sum(s1) * (1.0f / D) + RMS_EPS);
    u32x2* o8 = (u32x2*)orow + lane;
#pragma unroll
    for (int j = 0; j < 4; ++j) { const f32x4 gg = gr[64 * j]; u32x2 w;
        w.x = cvt_pk_bf16(v[j][0] * r0 * gg[0], v[j][1] * r0 * gg[1]); w.y = cvt_pk_bf16(v[j][2] * r0 * gg[2], v[j][3] * r0 * gg[3]); o8[64 * j] = w;
        w.x = cvt_pk_bf16(v[4 + j][0] * r1 * gg[0], v[4 + j][1] * r1 * gg[1]); w.y = cvt_pk_bf16(v[4 + j][2] * r1 * gg[2], v[4 + j][3] * r1 * gg[3]); o8[256 + 64 * j] = w; }
}
__device__ __forceinline__ void rms_row4_to_bf16(const float* xrow, const float* g, bf16_t* orow, int lane) {
    const f32x4* xr = (const f32x4*)xrow + lane; const f32x4* gr = (const f32x4*)g + lane;
    f32x4 v[16]; float ss[4];
#pragma unroll
    for (int j = 0; j < 16; ++j) v[j] = xr[64 * j];
#pragma unroll
    for (int r = 0; r < 4; ++r) { float s = 0.f;
#pragma unroll
        for (int j = 0; j < 4; ++j) s += (v[4 * r + j][0] * v[4 * r + j][0] + v[4 * r + j][1] * v[4 * r + j][1]) + (v[4 * r + j][2] * v[4 * r + j][2] + v[4 * r + j][3] * v[4 * r + j][3]);
        ss[r] = s; }
#pragma unroll
    for (int o = 1; o < 64; o <<= 1) {
#pragma unroll
        for (int r = 0; r < 4; ++r) ss[r] += __shfl_xor(ss[r], o); }
    u32x2* o8 = (u32x2*)orow + lane;
#pragma unroll
    for (int j = 0; j < 4; ++j) { const f32x4 gg = gr[64 * j];
#pragma unroll
        for (int r = 0; r < 4; ++r) { const float rr = 1.0f / sqrtf(ss[r] * (1.0f / D) + RMS_EPS); const f32x4 x = v[4 * r + j]; u32x2 w;
            w.x = cvt_pk_bf16(x[0] * rr * gg[0], x[1] * rr * gg[1]); w.y = cvt_pk_bf16(x[2] * rr * gg[2], x[3] * rr * gg[3]); o8[256 * r + 64 * j] = w; } }
}
__device__ __forceinline__ void x_row4_to_bf16(const float* xrow, bf16_t* orow, float* rx, int lane) {
    const f32x4* xr = (const f32x4*)xrow + lane;
    f32x4 v[16]; float ss[4];
#pragma unroll
    for (int j = 0; j < 16; ++j) v[j] = xr[64 * j];
    u32x2* o8 = (u32x2*)orow + lane;
#pragma unroll
    for (int r = 0; r < 4; ++r) { float s = 0.f;
#pragma unroll
        for (int j = 0; j < 4; ++j) { const f32x4 x = v[4 * r + j]; s += (x[0] * x[0] + x[1] * x[1]) + (x[2] * x[2] + x[3] * x[3]);
            u32x2 w; w.x = cvt_pk_bf16(x[0], x[1]); w.y = cvt_pk_bf16(x[2], x[3]); o8[256 * r + 64 * j] = w; }
        ss[r] = s; }
#pragma unroll
    for (int o = 1; o < 64; o <<= 1) {
#pragma unroll
        for (int r = 0; r < 4; ++r) ss[r] += __shfl_xor(ss[r], o); }
    if (lane < 4) rx[lane] = 1.0f / sqrtf((lane == 0 ? ss[0] : lane == 1 ? ss[1] : lane == 2 ? ss[2] : ss[3]) * (1.0f / D) + RMS_EPS);
}
__device__ __forceinline__ void p0_prologue(const Args& a, LAS unsigned char* lds, int bid, int G, int wid, int lane) {
    LAS float* scr = (LAS float*)(lds + wid * 16384);
    const int gw = bid * 8 + wid, NGW = G * 8;
    unsigned char* ws = a.ws;
    constexpr int I0 = 16 * 64, I1 = 16 * 32, I3 = 16 * 64;
    constexpr int NITEMS = I0 + I1 + I3;
    for (int it = gw; it < NITEMS; it += NGW) {
        int r = it;
        if (r < I0) { const int nb = r % 64, kb = r / 64, n0 = nb * 32; int dr = n0;
            if (n0 < 1024) { const int half = n0 / 512, c = n0 % 512; dr = 256 * (c / 128) + 128 * half + (c % 128); }
            p0_transpose_item(a.in[3], 2048, (bf16_t*)(ws + WS_BT1), 1024, dr, a.in[2], scr, kb * 64, n0, lane); continue; } r -= I0;
        if (r < I1) { p0_transpose_item(a.in[13], 1024, (bf16_t*)(ws + WS_WOUT), 1024, (r % 32) * 32, nullptr, scr, (r / 32) * 64, (r % 32) * 32, lane); continue; } r -= I1;
        p0_transpose_item(a.in[17], 2048, (bf16_t*)(ws + WS_WKV), 1024, (r % 64) * 32, nullptr, scr, (r / 64) * 64, (r % 64) * 32, lane);
    }
    for (int m = 4 * gw; m < M; m += 4 * NGW) x_row4_to_bf16(a.in[0] + (size_t)m * D, (bf16_t*)(ws + WS_HN) + (size_t)m * D, (float*)(ws + WS_RX) + m, lane);
    for (int m = gw; m < MR; m += NGW) rms_row_to_bf16(a.in[1] + (size_t)m * D, a.in[15], (bf16_t*)(ws + WS_MN) + (size_t)m * D, lane);
    for (int rr = gw; rr < 8 * 128; rr += NGW) {
        const int t = rr & 127; const f32x2 wv = *(const f32x2*)(a.in[11] + (size_t)rr * 128 + 2 * lane);
        ((unsigned*)(ws + WS_WSB))[(size_t)rr * 64 + lane] = cvt_pk_bf16(2 * lane <= t ? wv[0] : 0.f, 2 * lane + 1 <= t ? wv[1] : 0.f);
    }
}
struct LwItem { const float* wp; const float* gk; bf16_t* wt; int N, K, k0; };
__device__ __forceinline__ LwItem lw_decode(const Args& a, unsigned char* ws, int it, int lane) {
    constexpr int I2 = 16 * 32, I4 = 16 * 32, I5 = 16 * 176;
    const float* W; const float* gk = nullptr; bf16_t* WT; int N, K = 1024, k0, n0, dr;
    if (it < I2) { W = a.in[16]; gk = a.in[14]; WT = (bf16_t*)(ws + WS_WQ); N = 1024; k0 = (it / 32) * 64; n0 = (it % 32) * 32; dr = n0; }
    else if (it < I2 + I4) { const int r = it - I2; W = a.in[18]; WT = (bf16_t*)(ws + WS_WO); N = 1024; k0 = (r / 32) * 64; n0 = (r % 32) * 32; dr = n0; }
    else if (it < I2 + I4 + I5) { const int r = it - I2 - I4; W = a.in[20]; gk = a.in[19]; WT = (bf16_t*)(ws + WS_WGU); N = 2 * FF; k0 = (r / 176) * 64; n0 = (r % 176) * 32;
        const int half = n0 / FF, c = n0 % FF; dr = 256 * (c / 128) + 128 * half + (c % 128); }
    else { const int r = it - I2 - I4 - I5; W = a.in[21]; WT = (bf16_t*)(ws + WS_WD); N = 1024; K = FF; k0 = (r / 32) * 64; n0 = (r % 32) * 32; dr = n0; }
    LwItem d; d.wp = W + (size_t)(k0 + (lane >> 5)) * N + n0 + (lane & 31); d.gk = gk; d.wt = WT + (size_t)dr * K + k0; d.N = N; d.K = K; d.k0 = k0; return d;
}
__device__ __forceinline__ void late_weights(const Args& a, LAS unsigned char* lds, int gw, int NGW, int wid, int lane) {
    LAS float* scr = (LAS float*)(lds + wid * 16384);
    unsigned char* ws = a.ws;
    constexpr int NITEMS = 16 * 32 + 16 * 32 + 16 * 176 + 44 * 32;
    if (gw >= NITEMS) return;
    LwItem cur = lw_decode(a, ws, gw, lane);
    float v[32];
#pragma unroll
    for (int i = 0; i < 32; ++i) v[i] = cur.wp[(size_t)(2 * i) * cur.N];
    for (int it = gw; it < NITEMS; it += NGW) {
        const bool has_next = it + NGW < NITEMS;
        LwItem nxt = cur; float nv[32];
        if (has_next) { nxt = lw_decode(a, ws, it + NGW, lane);
#pragma unroll
            for (int i = 0; i < 32; ++i) nv[i] = nxt.wp[(size_t)(2 * i) * nxt.N]; }
        if (cur.gk) { const float gv = cur.gk[cur.k0 + lane];
#pragma unroll
            for (int i = 0; i < 32; ++i) v[i] *= __shfl(gv, 2 * i + (lane >> 5)); }
#pragma unroll
        for (int i = 0; i < 32; ++i) scr[(2 * i + (lane >> 5)) * 33 + (lane & 31)] = v[i];
        asm volatile("s_waitcnt lgkmcnt(0)" ::: "memory");
        const int c = lane & 7;
#pragma unroll
        for (int j = 0; j < 4; ++j) { const int n = (lane >> 3) + 8 * j; const LAS float* sp = scr + (8 * c) * 33 + n;
            u32x4 o; o.x = cvt_pk_bf16(sp[0 * 33], sp[1 * 33]); o.y = cvt_pk_bf16(sp[2 * 33], sp[3 * 33]); o.z = cvt_pk_bf16(sp[4 * 33], sp[5 * 33]); o.w = cvt_pk_bf16(sp[6 * 33], sp[7 * 33]);
            *(u32x4*)(cur.wt + (size_t)n * cur.K + 8 * c) = o; }
        asm volatile("s_waitcnt lgkmcnt(0)" ::: "memory");
        if (has_next) {
#pragma unroll
            for (int i = 0; i < 32; ++i) v[i] = nv[i];
            cur = nxt; }
    }
}

template <int NT> __device__ __forceinline__ void conv_unit(const Args& a, LAS unsigned char* lds, int unit, int tid, int wid, int lane) {
    unsigned char* ws = a.ws;
    const bf16_t* aglu = (const bf16_t*)(ws + WS_AGLU); const bf16_t* ub = (const bf16_t*)(ws + WS_U); const bf16_t* gvT = (const bf16_t*)(ws + WS_GVT);
    const bf16_t* wsb = (const bf16_t*)(ws + WS_WSB); bf16_t* mix = (bf16_t*)(ws + WS_MIX);
    const int t0 = unit * NT, p0 = t0 & (SEQ - 1);
    constexpr int HT = NT / 2, NB = NT / 16;
    {
        const int cp = tid & 255, th = tid >> 8;
        f32x2 w[31];
#pragma unroll
        for (int k = 0; k < 31; ++k) w[k] = *(const f32x2*)(a.in[5] + k * CW + 2 * cp);
        const f32x2 cb = *(const f32x2*)(a.in[6] + 2 * cp);
        const int base = t0 + HT * th;
        const int pbase = p0 + HT * th;
        const unsigned* arow = (const unsigned*)aglu + cp;
        f32x2 win[38];
#pragma unroll
        for (int i = 0; i < 30; ++i) { const bool ok = (pbase - 30 + i) >= 0; const unsigned v = ok ? arow[(size_t)(base - 30 + i) * 256] : 0u; win[i] = (f32x2){bf_lo(v), bf_hi(v)}; }
        unsigned nx[8], nx2[8];
#pragma unroll
        for (int i = 0; i < 8; ++i) nx[i] = arow[(size_t)(base + i) * 256];
#pragma unroll
        for (int i = 0; i < 8; ++i) nx2[i] = arow[(size_t)(base + 8 + i) * 256];
        for (int blk = 0; blk < NB; ++blk) {
#pragma unroll
            for (int i = 0; i < 8; ++i) win[30 + i] = (f32x2){bf_lo(nx[i]), bf_hi(nx[i])};
#pragma unroll
            for (int i = 0; i < 8; ++i) nx[i] = nx2[i];
            if (blk < NB - 2) {
#pragma unroll
                for (int i = 0; i < 8; ++i) nx2[i] = arow[(size_t)(base + 8 * (blk + 2) + i) * 256];
            }
#pragma unroll
            for (int o = 0; o < 8; ++o) {
                f32x2 s = cb;
#pragma unroll
                for (int k = 0; k < 31; ++k) s += w[k] * win[o + k];
                *(LAS unsigned*)(lds + (size_t)(HT * th + 8 * blk + o) * 1024 + cp * 4) = cvt_pk_bf16(s[0], s[1]);
            }
#pragma unroll
            for (int i = 0; i < 30; ++i) win[i] = win[i + 8];
        }
    }
    __syncthreads();
    {
        f32x4 g0 = *(const f32x4*)(a.in[7] + 8 * lane), g1 = *(const f32x4*)(a.in[7] + 8 * lane + 4);
        f32x4 b0 = *(const f32x4*)(a.in[8] + 8 * lane), b1 = *(const f32x4*)(a.in[8] + 8 * lane + 4);
        constexpr int NR = NT / 8;
        f32x4 x0[NR], x1[NR]; float sm[NR];
#pragma unroll
        for (int i = 0; i < NR; ++i) {
            const u32x4 raw = *(const LAS u32x4*)(lds + (size_t)(wid * NR + i) * 1024 + lane * 16);
            x0[i] = (f32x4){bf_lo(raw.x), bf_hi(raw.x), bf_lo(raw.y), bf_hi(raw.y)}; x1[i] = (f32x4){bf_lo(raw.z), bf_hi(raw.z), bf_lo(raw.w), bf_hi(raw.w)};
            const f32x4 t = x0[i] + x1[i]; sm[i] = (t[0] + t[1]) + (t[2] + t[3]);
        }
#pragma unroll
        for (int o = 1; o < 64; o <<= 1) {
#pragma unroll
            for (int i = 0; i < NR; ++i) sm[i] += __shfl_xor(sm[i], o); }
#pragma unroll
        for (int i = 0; i < NR; ++i) { const float mean = sm[i] * (1.0f / CW); x0[i] = x0[i] - mean; x1[i] = x1[i] - mean;
            const f32x4 t = x0[i] * x0[i] + x1[i] * x1[i]; sm[i] = (t[0] + t[1]) + (t[2] + t[3]); }
#pragma unroll
        for (int o = 1; o < 64; o <<= 1) {
#pragma unroll
            for (int i = 0; i < NR; ++i) sm[i] += __shfl_xor(sm[i], o); }
#pragma unroll
        for (int i = 0; i < NR; ++i) {
            const float rstd = 1.0f / sqrtf(sm[i] * (1.0f / CW) + LN_EPS);
            const f32x4 y0 = x0[i] * rstd * g0 + b0, y1 = x1[i] * rstd * g1 + b1;
            const f32x4 z0 = y0 * sig4_from_t_(y0 * (-LOG2E)), z1 = y1 * sig4_from_t_(y1 * (-LOG2E));
            *(u32x4*)(mix + (size_t)(t0 + wid * NR + i) * D + 8 * lane) = pack8(z0, z1);
        }
    }
    __syncthreads();
}
__device__ __forceinline__ void gmlp_unit(const Args& a, LAS unsigned char* lds, int chunk, int tid, int wid, int lane) {
    unsigned char* ws = a.ws;
    const bf16_t* ub = (const bf16_t*)(ws + WS_U); const bf16_t* gvT = (const bf16_t*)(ws + WS_GVT);
    const bf16_t* wsb = (const bf16_t*)(ws + WS_WSB); bf16_t* mix = (bf16_t*)(ws + WS_MIX);
    const int t0 = chunk * CHUNK;
    constexpr int LDG = 264;
    LAS unsigned char* part = lds + 512 * LDG;
    LAS f32x2* stat = (LAS f32x2*)(lds + 512 * LDG + 8192);
    const int h = wid, fr = lane & 15, fq = lane >> 4;
    bf16x8 Bf[20];
    const bf16_t* wb = wsb + (size_t)(h * 128 + fr) * 128 + 8 * fq;
    {
        int n = 0;
#pragma unroll
        for (int ks = 0; ks < 2; ++ks)
#pragma unroll
            for (int tb = 0; tb < 4; ++tb) { if (tb < 2 * ks) continue; Bf[n++] = *(const bf16x8*)(wb + (size_t)(16 * tb) * 128 + 32 * ks); }
    }
    const bf16_t* ubase = ub + (size_t)(t0 + fr) * GW + 64 * h + 4 * fq;
    u32x2 uu[2][4][4];
#pragma unroll
    for (int tb = 0; tb < 4; ++tb)
#pragma unroll
        for (int db = 0; db < 4; ++db) uu[0][tb][db] = *(const u32x2*)(ubase + (size_t)(16 * tb) * GW + 16 * db);
    {
        const bf16_t* gp = gvT + (size_t)(tid >> 4) * M + t0 + (tid & 15) * 8;
        LAS unsigned char* lp = lds + (tid >> 4) * LDG + (tid & 15) * 16;
        u32x4 tr[16];
#pragma unroll
        for (int p = 0; p < 16; ++p) tr[p] = *(const u32x4*)(gp + (size_t)(32 * p) * M);
#pragma unroll
        for (int p = 0; p < 16; ++p) *(LAS u32x4*)(lp + 32 * p * LDG) = tr[p];
    }
    __syncthreads();
    {
        const int tg = tid & 15, cgp = tid >> 4;
        float sm[8], sq[8];
#pragma unroll
        for (int j = 0; j < 8; ++j) { sm[j] = 0.f; sq[j] = 0.f; }
        const LAS unsigned char* rp = lds + (16 * cgp) * LDG + tg * 16;
#pragma unroll
        for (int c = 0; c < 16; ++c) { const u32x4 r = *(const LAS u32x4*)(rp + c * LDG);
            const float v[8] = {bf_lo(r.x), bf_hi(r.x), bf_lo(r.y), bf_hi(r.y), bf_lo(r.z), bf_hi(r.z), bf_lo(r.w), bf_hi(r.w)};
#pragma unroll
            for (int j = 0; j < 8; ++j) { sm[j] += v[j]; sq[j] += v[j] * v[j]; } }
#pragma unroll
        for (int j = 0; j < 8; ++j) { sm[j] += __shfl_xor(sm[j], 16); sm[j] += __shfl_xor(sm[j], 32); sq[j] += __shfl_xor(sq[j], 16); sq[j] += __shfl_xor(sq[j], 32); }
        if (lane < 16) {
#pragma unroll
            for (int j = 0; j < 8; ++j) *(LAS f32x2*)(part + ((size_t)wid * 128 + 8 * tg + j) * 8) = (f32x2){sm[j], sq[j]};
        }
        __syncthreads();
        if (tid < 128) { float ts = 0.f, tq2 = 0.f;
#pragma unroll
            for (int w = 0; w < 8; ++w) { const f32x2 p = *(const LAS f32x2*)(part + ((size_t)w * 128 + tid) * 8); ts += p[0]; tq2 += p[1]; }
            const float mean = ts * (1.0f / GW); const float var = fmaxf(tq2 * (1.0f / GW) - mean * mean, 0.f);
            stat[tid] = (f32x2){mean, 1.0f / sqrtf(var + LN_EPS)}; }
        __syncthreads();
    }
    {
        float lg[4], lb[4];
#pragma unroll
        for (int db = 0; db < 4; ++db) { lg[db] = a.in[9][64 * h + 16 * db + fr]; lb[db] = a.in[10][64 * h + 16 * db + fr]; }
        const LAS unsigned char* abase = lds + (64 * h + fr) * LDG + fq * 16;
        bf16_t* obase = mix + (size_t)(t0 + fr) * D + 512 + 64 * h + 4 * fq;
        int nb = 0;
#pragma unroll
        for (int th = 0; th < 2; ++th) {
            if (th == 0) {
#pragma unroll
                for (int tb = 0; tb < 4; ++tb)
#pragma unroll
                    for (int db = 0; db < 4; ++db) uu[1][tb][db] = *(const u32x2*)(ubase + (size_t)(16 * (4 + tb)) * GW + 16 * db);
            }
            f32x4 acc[4][4];
#pragma unroll
            for (int db = 0; db < 4; ++db)
#pragma unroll
                for (int tb = 0; tb < 4; ++tb) acc[db][tb] = (f32x4){0.f, 0.f, 0.f, 0.f};
#pragma unroll
            for (int ks = 0; ks < 2 * th + 2; ++ks) {
                float mu[8], rs[8];
#pragma unroll
                for (int j = 0; j < 8; ++j) { const f32x2 st = stat[32 * ks + 8 * fq + j]; mu[j] = st[0]; rs[j] = st[1]; }
                bf16x8 Af[4];
#pragma unroll
                for (int db = 0; db < 4; ++db) {
                    const u32x4 r = *(const LAS u32x4*)(abase + 16 * db * LDG + 64 * ks);
                    const float gg = lg[db], bb = lb[db];
                    u32x4 o;
                    o.x = cvt_pk_bf16((bf_lo(r.x) - mu[0]) * rs[0] * gg + bb, (bf_hi(r.x) - mu[1]) * rs[1] * gg + bb);
                    o.y = cvt_pk_bf16((bf_lo(r.y) - mu[2]) * rs[2] * gg + bb, (bf_hi(r.y) - mu[3]) * rs[3] * gg + bb);
                    o.z = cvt_pk_bf16((bf_lo(r.z) - mu[4]) * rs[4] * gg + bb, (bf_hi(r.z) - mu[5]) * rs[5] * gg + bb);
                    o.w = cvt_pk_bf16((bf_lo(r.w) - mu[6]) * rs[6] * gg + bb, (bf_hi(r.w) - mu[7]) * rs[7] * gg + bb);
                    Af[db] = __builtin_bit_cast(bf16x8, o);
                }
#pragma unroll
                for (int tb = 0; tb < 4; ++tb) {
                    if (4 * th + tb < 2 * ks) continue;
                    const bf16x8 bfr = Bf[nb++];
#pragma unroll
                    for (int db = 0; db < 4; ++db) acc[db][tb] = __builtin_amdgcn_mfma_f32_16x16x32_bf16(Af[db], bfr, acc[db][tb], 0, 0, 0);
                }
            }
            if (th == 0) {
                asm volatile("" ::: "memory");
                int n = 6;
#pragma unroll
                for (int ks = 0; ks < 4; ++ks)
#pragma unroll
                    for (int tb = 0; tb < 4; ++tb) { if (4 + tb < 2 * ks) continue; Bf[n++] = *(const bf16x8*)(wb + (size_t)(16 * (4 + tb)) * 128 + 32 * ks); }
                asm volatile("" ::: "memory");
            }
#pragma unroll
            for (int tb = 0; tb < 4; ++tb) {
                const float bs = a.in[12][h * 128 + 16 * (4 * th + tb) + fr];
#pragma unroll
                for (int db = 0; db < 4; ++db) {
                    u32x2 o; o.x = cvt_pk_bf16(bf_lo(uu[th][tb][db].x) * (acc[db][tb][0] + bs), bf_hi(uu[th][tb][db].x) * (acc[db][tb][1] + bs));
                    o.y = cvt_pk_bf16(bf_lo(uu[th][tb][db].y) * (acc[db][tb][2] + bs), bf_hi(uu[th][tb][db].y) * (acc[db][tb][3] + bs));
                    *(u32x2*)(obase + (size_t)(16 * (4 * th + tb)) * D + 16 * db) = o;
                }
            }
        }
    }
}

__device__ __forceinline__ void attn_unit(LAS unsigned char* lds, const bf16_t* q, const bf16_t* Km, const bf16_t* Vt, bf16_t* o, int pm, int h, int tid, int wid, int lane) {
    constexpr int LDK = 544, LDV = 528;
    const int fr = lane & 15, fq = lane >> 4, b = pm >> 4, row0 = pm * 256 + wid * 32;
    {
        const bf16_t* kg = Km + (size_t)(b * 256 + (tid >> 5)) * 1024 + h * 256 + (tid & 31) * 8;
        LAS unsigned char* kl = lds + (tid >> 5) * LDK + (tid & 31) * 16;
#pragma unroll
        for (int half = 0; half < 2; ++half) {
            u32x4 kr[8];
#pragma unroll
            for (int i = 0; i < 8; ++i) kr[i] = *(const u32x4*)(kg + (size_t)(half * 8 + i) * 16 * 1024);
#pragma unroll
            for (int i = 0; i < 8; ++i) *(LAS u32x4*)(kl + (half * 8 + i) * 16 * LDK) = kr[i];
        }
    }
    __syncthreads();
    bf16x8 Pf[2][8]; float inv[2];
    const bf16_t* qbase = q + (size_t)(row0 + fr) * D + h * 256 + 8 * fq;
#pragma unroll
    for (int qb = 0; qb < 2; ++qb) {
        bf16x8 Qf[8];
#pragma unroll
        for (int ks = 0; ks < 8; ++ks) Qf[ks] = *(const bf16x8*)(qbase + (size_t)(16 * qb) * D + 32 * ks);
        f32x4 S[16];
#pragma unroll
        for (int kb = 0; kb < 16; ++kb) S[kb] = (f32x4){0.f, 0.f, 0.f, 0.f};
        bf16x8 kf[2][4];
        const LAS unsigned char* kbase = lds + fr * LDK + fq * 16;
#pragma unroll
        for (int k4 = 0; k4 < 4; ++k4) kf[0][k4] = *(const LAS bf16x8*)(kbase + 64 * k4);
#pragma unroll
        for (int it = 0; it < 32; ++it) {
            if (it < 31) {
#pragma unroll
                for (int k4 = 0; k4 < 4; ++k4) kf[(it + 1) & 1][k4] = *(const LAS bf16x8*)(kbase + 16 * ((it + 1) >> 1) * LDK + 64 * (4 * ((it + 1) & 1) + k4));
            }
#pragma unroll
            for (int k4 = 0; k4 < 4; ++k4) S[it >> 1] = __builtin_amdgcn_mfma_f32_16x16x32_bf16(kf[it & 1][k4], Qf[4 * (it & 1) + k4], S[it >> 1], 0, 0, 0);
#pragma unroll
            for (int k4 = 0; k4 < 4; ++k4) { __builtin_amdgcn_sched_group_barrier(0x100, 1, 0); __builtin_amdgcn_sched_group_barrier(0x008, 1, 0); }
            __builtin_amdgcn_sched_barrier(0);
        }
        float mx = -3.0e38f;
#pragma unroll
        for (int kb = 0; kb < 16; ++kb) mx = fmaxf(fmaxf(fmaxf(S[kb][0], S[kb][1]), fmaxf(S[kb][2], S[kb][3])), mx);
        mx = fmaxf(mx, __shfl_xor(mx, 16)); mx = fmaxf(mx, __shfl_xor(mx, 32));
        float sum = 0.f;
#pragma unroll
        for (int kb = 0; kb < 16; ++kb)
#pragma unroll
            for (int j = 0; j < 4; ++j) { const float p = __builtin_amdgcn_exp2f(S[kb][j] - mx); S[kb][j] = p; sum += p; }
        sum += __shfl_xor(sum, 16); sum += __shfl_xor(sum, 32);
        inv[qb] = 1.0f / sum;
#pragma unroll
        for (int ks = 0; ks < 8; ++ks) { const u32x4 w = pack8(S[2 * ks], S[2 * ks + 1]); Pf[qb][ks] = __builtin_bit_cast(bf16x8, w); }
        asm volatile("" ::: "memory");
    }
    __syncthreads();
    {
        const bf16_t* vg = Vt + (size_t)(h * 256 + (tid >> 5)) * 1024 + b * 256 + (tid & 31) * 8;
        LAS unsigned char* vl = lds + (tid >> 5) * LDV + (tid & 31) * 16;
#pragma unroll
        for (int half = 0; half < 2; ++half) {
            u32x4 kr[8];
#pragma unroll
            for (int i = 0; i < 8; ++i) kr[i] = *(const u32x4*)(vg + (size_t)(half * 8 + i) * 16 * 1024);
#pragma unroll
            for (int i = 0; i < 8; ++i) *(LAS u32x4*)(vl + (half * 8 + i) * 16 * LDV) = kr[i];
        }
    }
    __syncthreads();
    const LAS unsigned char* vbase = lds + fr * LDV + fq * 8;
    bf16_t* obase = o + (size_t)(row0 + fr) * D + h * 256 + 4 * fq;
#pragma unroll
    for (int dh = 0; dh < 2; ++dh) {
        f32x4 O[2][8];
#pragma unroll
        for (int qb = 0; qb < 2; ++qb)
#pragma unroll
            for (int db = 0; db < 8; ++db) O[qb][db] = (f32x4){0.f, 0.f, 0.f, 0.f};
        u32x2 vlo[2][4], vhi[2][4];
#pragma unroll
        for (int k4 = 0; k4 < 4; ++k4) { const LAS unsigned char* vp = vbase + 128 * dh * LDV + 64 * k4; vlo[0][k4] = *(const LAS u32x2*)vp; vhi[0][k4] = *(const LAS u32x2*)(vp + 32); }
#pragma unroll
        for (int it = 0; it < 16; ++it) {
            if (it < 15) {
#pragma unroll
                for (int k4 = 0; k4 < 4; ++k4) { const LAS unsigned char* vp = vbase + (128 * dh + 16 * ((it + 1) >> 1)) * LDV + 64 * (4 * ((it + 1) & 1) + k4); vlo[(it + 1) & 1][k4] = *(const LAS u32x2*)vp; vhi[(it + 1) & 1][k4] = *(const LAS u32x2*)(vp + 32); }
            }
#pragma unroll
            for (int k4 = 0; k4 < 4; ++k4) {
                const u32x4 w = {vlo[it & 1][k4].x, vlo[it & 1][k4].y, vhi[it & 1][k4].x, vhi[it & 1][k4].y}; const bf16x8 vf = __builtin_bit_cast(bf16x8, w);
#pragma unroll
                for (int qb = 0; qb < 2; ++qb) O[qb][it >> 1] = __builtin_amdgcn_mfma_f32_16x16x32_bf16(vf, Pf[qb][4 * (it & 1) + k4], O[qb][it >> 1], 0, 0, 0);
            }
#pragma unroll
            for (int k4 = 0; k4 < 4; ++k4) { __builtin_amdgcn_sched_group_barrier(0x100, 2, 0); __builtin_amdgcn_sched_group_barrier(0x008, 2, 0); }
            __builtin_amdgcn_sched_barrier(0);
        }
#pragma unroll
        for (int qb = 0; qb < 2; ++qb)
#pragma unroll
            for (int db = 0; db < 8; ++db) {
                const f32x4 v = O[qb][db] * inv[qb]; u32x2 w; w.x = cvt_pk_bf16(v[0], v[1]); w.y = cvt_pk_bf16(v[2], v[3]);
                *(u32x2*)(obase + (size_t)(16 * qb) * D + 128 * dh + 16 * db) = w;
            }
    }
    __syncthreads();
}

#define PHASE_ARGS const Args& a, LAS unsigned char* lds, unsigned char* ws, int tid, int wid, int lane, int bid, int G
#define PHASE_CALL a, lds, ws, tid, wid, lane, bid, G
constexpr size_t TS1024 = (size_t)256 * 1024 * 2;

__device__ __forceinline__ void phase_p1(PHASE_ARGS) {
    pg8::Sched S{}; S.G = G; S.c = bid; S.tstep = TS1024;
    S.A0 = (const char*)(ws + WS_HN); S.B0 = (const char*)(ws + WS_BT1); S.nM0 = 64; S.nN0 = 4;
    S.A1 = (const char*)(ws + WS_HN); S.B1 = (const char*)(ws + WS_BT1) + (size_t)1024 * 2048; S.nM1 = 64; S.nN1 = 2;
    S.A2 = (const char*)(ws + WS_BT1) + (size_t)1536 * 2048; S.B2 = (const char*)(ws + WS_HN); S.nM2 = 2; S.nN2 = 64;
    EpiP1 E{(bf16_t*)(ws + WS_AGLU), (bf16_t*)(ws + WS_U), (bf16_t*)(ws + WS_GVT), a.in[4], (const float*)(ws + WS_RX)};
    pg8::gemm_phase(lds, 1024, S, E);
}
__device__ __forceinline__ void phase_p2(PHASE_ARGS) {
    conv_unit<64>(a, lds, bid, tid, wid, lane);
    if (bid < 128) {
        gmlp_unit(a, lds, bid, tid, wid, lane);
    } else if (bid < 160) {
        pg8::Sched S{}; S.G = 32; S.c = bid - 128; S.tstep = TS1024;
        S.A0 = (const char*)(ws + WS_MN); S.B0 = (const char*)(ws + WS_WKV); S.nM0 = 4; S.nN0 = 4;
        S.A1 = (const char*)(ws + WS_WKV) + (size_t)1024 * 2048; S.B1 = (const char*)(ws + WS_MN); S.nM1 = 4; S.nN1 = 4;
        EpiKV E{(bf16_t*)(ws + WS_KM), (bf16_t*)(ws + WS_VT)};
        pg8::gemm_phase(lds, 1024, S, E);
    } else {
        late_weights(a, lds, (bid - 160) * 8 + wid, 96 * 8, wid, lane);
    }
}
__device__ __forceinline__ void phase_p3(PHASE_ARGS) {
    pg8::Sched S{}; S.G = G; S.c = bid; S.tstep = TS1024;
    S.A0 = (const char*)(ws + WS_MIX); S.B0 = (const char*)(ws + WS_WOUT); S.nM0 = 64; S.nN0 = 4;
    EpiRes<true> E{(const bf16_t*)(ws + WS_HN), (bf16_t*)(ws + WS_HB), (float*)(ws + WS_SSQ1)};
    pg8::gemm_phase(lds, 1024, S, E);
}
__device__ __forceinline__ void phase_p4(PHASE_ARGS) {
    pg8::Sched S{}; S.G = 1 << 20; S.c = bid; S.tstep = TS1024;
    S.A0 = (const char*)(ws + WS_HB); S.B0 = (const char*)(ws + WS_WQ); S.nM0 = 64; S.nN0 = 4;
    Unit un; S.next(0, un);
    EpiQ E{(bf16_t*)(ws + WS_Q), (const float*)(ws + WS_SSQ1)};
    pg8::gemm_phase(lds, 1024, S, E);
    asm volatile("s_waitcnt vmcnt(0)" ::: "memory");
    __syncthreads();
    attn_unit(lds, (const bf16_t*)(ws + WS_Q), (const bf16_t*)(ws + WS_KM), (const bf16_t*)(ws + WS_VT), (bf16_t*)(ws + WS_HN), un.pm, un.pn, tid, wid, lane);
}
__device__ __forceinline__ void phase_p5(PHASE_ARGS) {
    pg8::Sched S{}; S.G = G; S.c = bid; S.tstep = TS1024;
    S.A0 = (const char*)(ws + WS_HN); S.B0 = (const char*)(ws + WS_WO); S.nM0 = 64; S.nN0 = 4;
    EpiRes<true> E{(const bf16_t*)(ws + WS_HB), (bf16_t*)(ws + WS_HB), (float*)(ws + WS_SSQ2)};
    pg8::gemm_phase(lds, 1024, S, E);
}
__device__ __forceinline__ void phase_p6(PHASE_ARGS) {
    pg8::Sched S{}; S.G = G; S.c = bid; S.tstep = TS1024;
    S.A0 = (const char*)(ws + WS_HB); S.B0 = (const char*)(ws + WS_WGU); S.nM0 = 64; S.nN0 = 22;
    EpiGU E{(bf16_t*)(ws + WS_ACT), (const float*)(ws + WS_SSQ2)};
    pg8::gemm_phase(lds, 1024, S, E);
}
__device__ __forceinline__ void phase_p7(PHASE_ARGS) {
    pg8::Sched S{}; S.G = G; S.c = bid; S.tstep = (size_t)256 * FF * 2;
    S.A0 = (const char*)(ws + WS_ACT); S.B0 = (const char*)(ws + WS_WD); S.nM0 = 64; S.nN0 = 4;
    EpiFinal E{(const bf16_t*)(ws + WS_HB), a.out, (float*)(ws + WS_SSQ3), (unsigned*)(ws + WS_CTL + 16384), a.in[22]};
    pg8::gemm_phase(lds, FF, S, E);
}
__global__ void __launch_bounds__(512, 2) fwd_mega(Args a) {
    extern __shared__ __attribute__((aligned(16))) unsigned char lds_raw[];
    LAS unsigned char* lds = (LAS unsigned char*)lds_raw;
    cg::grid_group grid = cg::this_grid();
    const int tid = threadIdx.x, wid = __builtin_amdgcn_readfirstlane(tid >> 6), lane = tid & 63, bid = blockIdx.x, G = gridDim.x;
    unsigned char* ws = a.ws;
    if (tid < 2) ((volatile LAS unsigned*)(lds + LDS_BYTES - 64))[tid] = 0u;
    __syncthreads();
    const XcdBarrier xbar = xcd_barrier_post((unsigned*)(ws + WS_CTL), (volatile LAS unsigned*)(lds + LDS_BYTES - 64));
    if (a.never != 0) grid.sync();
#define GRID_BAR() xcd_barrier(xbar)
    { p0_prologue(a, lds, bid, G, wid, lane); }
    GRID_BAR();
    phase_p1(PHASE_CALL); GRID_BAR();
    { phase_p2(PHASE_CALL);
    } GRID_BAR();
    phase_p3(PHASE_CALL); GRID_BAR();
    { phase_p4(PHASE_CALL); } GRID_BAR();
    { phase_p5(PHASE_CALL); } GRID_BAR();
    phase_p6(PHASE_CALL); GRID_BAR();
    phase_p7(PHASE_CALL);
}

extern "C" void kernel_launch(void* const* d_in, const int* in_sizes, int n_in, void* d_out, int out_size, void* d_ws, size_t ws_size, hipStream_t stream) {
    static int grid = 0;
    if (grid == 0) {
        int dev = 0, cus = 0, per_cu = 0;
        (void)hipGetDevice(&dev);
        (void)hipDeviceGetAttribute(&cus, hipDeviceAttributeMultiprocessorCount, dev);
        (void)hipFuncSetAttribute((const void*)fwd_mega, hipFuncAttributeMaxDynamicSharedMemorySize, LDS_BYTES);
        (void)hipOccupancyMaxActiveBlocksPerMultiprocessor(&per_cu, (const void*)fwd_mega, 512, LDS_BYTES);
        (void)hipGetLastError();
        grid = cus > 0 ? cus : 256;
        if (grid > 256) grid = 256;
    }
    Args a{};
    for (int i = 0; i < 23; ++i) a.in[i] = (const float*)d_in[i];
    a.out = (float*)d_out; a.ws = (unsigned char*)d_ws; a.never = 0ull;
    (void)hipMemsetAsync((char*)d_ws + WS_CTL, 0, CTL_ZERO_BYTES, stream);
    void* args[] = {&a};
    hipError_t e = hipLaunchCooperativeKernel((const void*)fwd_mega, dim3(grid), dim3(512), args, LDS_BYTES, stream);
    if (e != hipSuccess) fprintf(stderr, "cooperative launch failed: %s (grid %d)\n", hipGetErrorString(e), grid);
}
```

```cpp
#include <hip/hip_runtime.h>
#include <hip/hip_cooperative_groups.h>
#include <cstdio>
#include <cstdint>
namespace cg = cooperative_groups;

#define LAS __attribute__((address_space(3)))
typedef unsigned short bf16_t;
typedef short bf16x8 __attribute__((ext_vector_type(8)));
typedef float f32x4 __attribute__((ext_vector_type(4)));
typedef float f32x2 __attribute__((ext_vector_type(2)));
typedef unsigned u32x4 __attribute__((ext_vector_type(4)));
typedef unsigned u32x2 __attribute__((ext_vector_type(2)));

constexpr int D = 1024, NB = 4, SEQ = 4096, M = NB * SEQ, CW = 512, GW = 512, CHUNK = 128, MEML = 256, MR = NB * MEML, FF = 2816;
constexpr float RMS_EPS = 1e-6f, LN_EPS = 1e-5f;
constexpr float LOG2E = 1.4426950408889634f;
constexpr float QSCALE = 0.0625f * LOG2E;

constexpr size_t MiB = 1u << 20;
constexpr size_t WS_BT1 = 0 * MiB;
constexpr size_t WS_WOUT = 4 * MiB;
constexpr size_t WS_WQ = 6 * MiB;
constexpr size_t WS_WKV = 8 * MiB;
constexpr size_t WS_WO = 12 * MiB;
constexpr size_t WS_WGU = 14 * MiB;
constexpr size_t WS_WD = 25 * MiB;
constexpr size_t WS_WSB = 31 * MiB;
constexpr size_t WS_MN = 32 * MiB;
constexpr size_t WS_KM = 34 * MiB;
constexpr size_t WS_VT = 36 * MiB;
constexpr size_t WS_SSQ1 = 38 * MiB, WS_SSQ2 = 39 * MiB, WS_SSQ3 = 40 * MiB;
constexpr size_t WS_HB = 48 * MiB;
constexpr size_t WS_HN = 80 * MiB;
constexpr size_t WS_MIX = 176 * MiB;
constexpr size_t WS_RX = 42 * MiB;
constexpr size_t WS_AGLU = 112 * MiB;
constexpr size_t WS_U = 128 * MiB;
constexpr size_t WS_GVT = 144 * MiB;
constexpr size_t WS_Q = 112 * MiB;
constexpr size_t WS_ACT = 80 * MiB;
constexpr int LDS_BYTES = 147456;


constexpr size_t WS_CTL = 41 * MiB;
constexpr size_t CTL_ZERO_BYTES = 32768;
#define XB_TMO      128
#define XB_XCNT(j)  (256  + 64 * (j))
#define XB_XSUB(j)  (1280 + 64 * (j))
#define XB_XGEN(j)  (2304 + 64 * (j))
#define XB_TOP      3328
#define XB_TOPGEN   3392
#define XB_SPIN_CAP (1u << 18)
__device__ __forceinline__ unsigned xb_ld(unsigned* p)              { return __hip_atomic_load(p, __ATOMIC_RELAXED, __HIP_MEMORY_SCOPE_AGENT); }
__device__ __forceinline__ unsigned xb_add(unsigned* p, unsigned v) { return __hip_atomic_fetch_add(p, v, __ATOMIC_RELAXED, __HIP_MEMORY_SCOPE_AGENT); }
__device__ __forceinline__ unsigned xb_xcc_id() { return (unsigned)__builtin_amdgcn_s_getreg((3 << 11) | 20) & 0xFu; }
#define XB_SPIN(cond, bar) do { unsigned _sp = 0; while (cond) { __builtin_amdgcn_s_sleep(1); \
    if ((++_sp & 255u) == 0u) { if (xb_ld(&(bar)[XB_TMO])) break; if (_sp > XB_SPIN_CAP) { atomicAdd(&(bar)[XB_TMO], 1u); break; } } } } while (0)
struct XcdBarrier { unsigned* bar; unsigned x; volatile LAS unsigned* st; };
__device__ __forceinline__ XcdBarrier xcd_barrier_post(unsigned* bar, volatile LAS unsigned* st) {
    XcdBarrier b; b.bar = bar; b.x = xb_xcc_id(); b.st = st;
    if (threadIdx.x == 0) (void)xb_add(&bar[XB_XCNT(b.x)], 1u);
    return b;
}
__device__ __forceinline__ void xcd_barrier_complete(unsigned* bar, unsigned x, unsigned& nloc, unsigned& nx) {
    const unsigned G = gridDim.x * gridDim.y * gridDim.z;
    unsigned sum, cnt, mine, sp = 0u;
    for (;;) {
        sum = 0u; cnt = 0u; mine = 0u;
#pragma unroll
        for (unsigned j = 0; j < 16; ++j) { const unsigned c = xb_ld(&bar[XB_XCNT(j)]); sum += c; cnt += (c > 0u) ? 1u : 0u; mine = (j == x) ? c : mine; }
        if (sum == G) break;
        __builtin_amdgcn_s_sleep(1);
        if ((++sp & 255u) == 0u) { if (xb_ld(&bar[XB_TMO])) break; if (sp > XB_SPIN_CAP) { atomicAdd(&bar[XB_TMO], 1u); break; } }
    }
    nloc = mine > 0u ? mine : 1u; nx = cnt > 0u ? cnt : 1u;
}
__device__ __forceinline__ void xcd_barrier(const XcdBarrier& b) {
    asm volatile("s_waitcnt vmcnt(0)" ::: "memory");
    __syncthreads();
    if (threadIdx.x == 0) {
        unsigned* bar = b.bar;
        __builtin_amdgcn_s_waitcnt(0);
        unsigned nloc = b.st[0], nx = b.st[1];
        if (nloc == 0u) { xcd_barrier_complete(bar, b.x, nloc, nx); b.st[0] = nloc; b.st[1] = nx; }
        const unsigned old = xb_add(&bar[XB_XSUB(b.x)], 1u);
        const unsigned gen = old / nloc;
        if (old + 1u == (gen + 1u) * nloc) {
            __builtin_amdgcn_fence(__ATOMIC_RELEASE, "agent");
            asm volatile("s_waitcnt vmcnt(0)" ::: "memory");
            const unsigned og = xb_add(&bar[XB_TOP], 1u);
            const unsigned tg = og / nx;
            if (og + 1u == (tg + 1u) * nx) xb_add(&bar[XB_TOPGEN], 1u);
            else XB_SPIN(xb_ld(&bar[XB_TOPGEN]) == tg, bar);
            __builtin_amdgcn_fence(__ATOMIC_ACQUIRE, "agent");
            xb_add(&bar[XB_XGEN(b.x)], 1u);
            asm volatile("s_waitcnt vmcnt(0)" ::: "memory");
        } else {
            XB_SPIN(xb_ld(&bar[XB_XGEN(b.x)]) == gen, bar);
            __builtin_amdgcn_fence(__ATOMIC_ACQUIRE, "agent");
            asm volatile("s_waitcnt vmcnt(0)" ::: "memory");
        }
    }
    __syncthreads();
}

__device__ __forceinline__ unsigned cvt_pk_bf16(float lo, float hi) { unsigned r; asm volatile("v_cvt_pk_bf16_f32 %0, %1, %2" : "=v"(r) : "v"(lo), "v"(hi)); return r; }
__device__ __forceinline__ float bf_lo(unsigned u) { return __uint_as_float(u << 16); }
__device__ __forceinline__ float bf_hi(unsigned u) { return __uint_as_float(u & 0xffff0000u); }
__device__ __forceinline__ float sigmoidf_(float x) { return __builtin_amdgcn_rcpf(1.0f + __builtin_amdgcn_exp2f(-LOG2E * x)); }
__device__ __forceinline__ float siluf_(float x) { return x * sigmoidf_(x); }
__device__ __forceinline__ float geluf_(float x) { const float u = 0.7978845608028654f * (x + 0.044715f * x * x * x); return x * __builtin_amdgcn_rcpf(1.0f + __builtin_amdgcn_exp2f(-2.0f * LOG2E * u)); }
__device__ __forceinline__ f32x2 sigmoid2_(float x0, float x1) {
    const float a = 1.0f + __builtin_amdgcn_exp2f(fminf(-LOG2E * x0, 60.0f)), b = 1.0f + __builtin_amdgcn_exp2f(fminf(-LOG2E * x1, 60.0f));
    const float r = __builtin_amdgcn_rcpf(a * b);
    return (f32x2){r * b, r * a};
}
__device__ __forceinline__ f32x2 gelu2_(float x0, float x1) {
    const float u0 = 1.5957691216057308f * (x0 + 0.044715f * x0 * x0 * x0), u1 = 1.5957691216057308f * (x1 + 0.044715f * x1 * x1 * x1);
    const f32x2 sg = sigmoid2_(u0, u1); return (f32x2){x0 * sg[0], x1 * sg[1]};
}
__device__ __forceinline__ f32x4 swiglu4_(f32x4 ag, f32x4 au, float c1, float rr) {
    f32x4 t = ag * c1;
    t = __builtin_elementwise_min(t, (f32x4){60.f, 60.f, 60.f, 60.f});
    f32x4 e; e[0] = __builtin_amdgcn_exp2f(t[0]); e[1] = __builtin_amdgcn_exp2f(t[1]); e[2] = __builtin_amdgcn_exp2f(t[2]); e[3] = __builtin_amdgcn_exp2f(t[3]);
    const f32x4 a4 = e + 1.0f;
    const float r01 = __builtin_amdgcn_rcpf(a4[0] * a4[1]), r23 = __builtin_amdgcn_rcpf(a4[2] * a4[3]);
    const f32x4 sw = {a4[1], a4[0], a4[3], a4[2]}, rc = {r01, r01, r23, r23};
    return (ag * au) * ((rc * sw) * rr);
}
__device__ __forceinline__ f32x4 sig4_from_t_(f32x4 t) {
    t = __builtin_elementwise_min(t, (f32x4){60.f, 60.f, 60.f, 60.f});
    f32x4 e; e[0] = __builtin_amdgcn_exp2f(t[0]); e[1] = __builtin_amdgcn_exp2f(t[1]); e[2] = __builtin_amdgcn_exp2f(t[2]); e[3] = __builtin_amdgcn_exp2f(t[3]);
    const f32x4 a4 = e + 1.0f;
    const float r01 = __builtin_amdgcn_rcpf(a4[0] * a4[1]), r23 = __builtin_amdgcn_rcpf(a4[2] * a4[3]);
    const f32x4 sw = {a4[1], a4[0], a4[3], a4[2]}, rc = {r01, r01, r23, r23};
    return rc * sw;
}
__device__ __forceinline__ f32x4 glu4_(f32x4 za, f32x4 zg) { return za * sig4_from_t_(zg * (-LOG2E)); }
__device__ __forceinline__ f32x4 gelu4_(f32x4 x) {
    constexpr float CA = -LOG2E * 1.5957691216057308f, CB = CA * 0.044715f;
    return x * sig4_from_t_(x * ((x * x) * CB + CA));
}
__device__ __forceinline__ float wave_sum(float v) {
#pragma unroll
    for (int o = 1; o < 64; o <<= 1) v += __shfl_xor(v, o);
    return v;
}
__device__ __forceinline__ u32x4 pack8(f32x4 a, f32x4 b) { u32x4 w; w.x = cvt_pk_bf16(a[0], a[1]); w.y = cvt_pk_bf16(a[2], a[3]); w.z = cvt_pk_bf16(b[0], b[1]); w.w = cvt_pk_bf16(b[2], b[3]); return w; }

namespace pg8 {
constexpr int BM = 256, BK = 64, HALF = 128, HTB = HALF * BK * 2, NXCD = 8, WGM = 8;
__device__ __forceinline__ int lds_byte(int r, int c) { const int st = (r >> 4) * 2 + (c >> 5), rr = r & 15, cc = c & 31, ob = rr * 64 + cc * 2; return st * 1024 + (ob ^ (((ob >> 9) & 1) << 5)); }
__device__ __forceinline__ void stage_rc(int b, int& R, int& C) { const int st = b / 1024, sb = b % 1024, swz = sb ^ (((sb >> 9) & 1) << 5); R = (st >> 1) * 16 + swz / 64; C = (st & 1) * 32 + (swz % 64) / 2; }
__device__ __forceinline__ int perm32(int rho) { const int n = rho >> 4, i = rho & 15; return 8 * (i >> 2) + 4 * n + (i & 3); }

struct Unit { const char* A; const char* B; int pm, pn, kind, idx; };

__device__ __forceinline__ void tile_order(int wgid, int nM, int nN, int& pm, int& pn) {
    const int nwg = nM * nN;
    { const int q = nwg / NXCD, r = nwg % NXCD, xcd = wgid % NXCD, off = wgid / NXCD; wgid = (xcd < r ? xcd * (q + 1) : r * (q + 1) + (xcd - r) * q) + off; }
    const int nig = WGM * nN, gid = wgid / nig, fm = gid * WGM, gsz = (nM - fm) < WGM ? (nM - fm) : WGM;
    pm = fm + ((wgid % nig) % gsz); pn = (wgid % nig) / gsz;
}
struct Sched {
    const char *A0, *B0, *A1, *B1, *A2, *B2; int nM0, nN0, nM1, nN1, nM2, nN2; int G, c; size_t tstep;
    __device__ __forceinline__ bool next(int i, Unit& u) const {
        int L = i * G + c; u.idx = i;
        if (L < nM0 * nN0) { tile_order(L, nM0, nN0, u.pm, u.pn); u.A = A0 + (size_t)u.pm * tstep; u.B = B0 + (size_t)u.pn * tstep; u.kind = 0; return true; }
        L -= nM0 * nN0;
        if (L < nM1 * nN1) { tile_order(L, nM1, nN1, u.pm, u.pn); u.A = A1 + (size_t)u.pm * tstep; u.B = B1 + (size_t)u.pn * tstep; u.kind = 1; return true; }
        L -= nM1 * nN1;
        if (L < nM2 * nN2) { tile_order(L, nM2, nN2, u.pm, u.pn); u.A = A2 + (size_t)u.pm * tstep; u.B = B2 + (size_t)u.pn * tstep; u.kind = 2; return true; }
        return false;
    }
};
template <class Epi, class Sch>
__device__ __forceinline__ void gemm_phase(LAS unsigned char* lds, const int K, const Sch& S, const Epi& E) {
    int tid_ = threadIdx.x; asm volatile("" : "+v"(tid_));
    const int tid = tid_, wid = __builtin_amdgcn_readfirstlane(tid >> 6), lane = tid & 63, wr = wid >> 2, wc = wid & 3, fr = lane & 15, fq = lane >> 4;
    const int nt = K / BK;
    unsigned voffA[2], voffB[2];
#pragma unroll
    for (int i = 0; i < 2; ++i) { int R, C; stage_rc(tid * 16 + i * 8192, R, C); const int Rb = (R & ~31) + perm32(R & 31);
        voffA[i] = (unsigned)(R * K + C) * 2u; voffB[i] = (unsigned)(Rb * K + C) * 2u; }
    const size_t kstep = (size_t)(BK * 2);
    const size_t hstep = (size_t)HALF * K * 2;
    const unsigned ldsw = (unsigned)wid * 1024u;
    const int aoff = lds_byte(wr * 64 + fr, fq * 8), boff = lds_byte(wc * 32 + fr, fq * 8);
#define PG8_SA(b, h) (((b) * 2 + (h)) * HTB)
#define PG8_SB(b, h) ((4 + (b) * 2 + (h)) * HTB)
#define PG8_STAGE(bufoff, gbase, voff) do { _Pragma("unroll") for (int _i = 0; _i < 2; ++_i) \
        __builtin_amdgcn_global_load_lds((const unsigned*)((const char*)(gbase) + (voff)[_i]), (LAS unsigned*)(lds + (bufoff) + ldsw + _i * 8192), 16, 0, 0); } while (0)
#define PG8_LDA(dst, b, h) do { _Pragma("unroll") for (int m = 0; m < 4; ++m) _Pragma("unroll") for (int k = 0; k < 2; ++k) dst[m][k] = *(const LAS bf16x8*)(lds + PG8_SA(b, h) + aoff + m * 2048 + k * 1024); } while (0)
#define PG8_LDB(dst, b, h) do { _Pragma("unroll") for (int n = 0; n < 2; ++n) _Pragma("unroll") for (int k = 0; k < 2; ++k) dst[n][k] = *(const LAS bf16x8*)(lds + PG8_SB(b, h) + boff + n * 2048 + k * 1024); } while (0)
#define PG8_MMA(ai, bj, At, Bt) do { __builtin_amdgcn_s_setprio(1); _Pragma("unroll") for (int m = 0; m < 4; ++m) _Pragma("unroll") for (int n = 0; n < 2; ++n) _Pragma("unroll") for (int k = 0; k < 2; ++k) \
        acc[ai][bj][m][n] = __builtin_amdgcn_mfma_f32_16x16x32_bf16(Bt[n][k], At[m][k], acc[ai][bj][m][n], 0, 0, 0); __builtin_amdgcn_s_setprio(0); } while (0)
#define PG8_WAIT_V(n) asm volatile("s_waitcnt vmcnt(" #n ")" ::: "memory")
#define PG8_WAIT_L(n) asm volatile("s_waitcnt lgkmcnt(" #n ")" ::: "memory")
#define PG8_BAR __builtin_amdgcn_s_barrier()
#define PG8_SCHED __builtin_amdgcn_sched_barrier(0)
    Unit cur, nxt; int ui = 0;
    if (!S.next(0, cur)) return;
    f32x4 acc[2][2][4][2];
#pragma unroll
    for (int a = 0; a < 2; ++a)
#pragma unroll
        for (int b = 0; b < 2; ++b)
#pragma unroll
            for (int m = 0; m < 4; ++m)
#pragma unroll
                for (int n = 0; n < 2; ++n) acc[a][b][m][n] = (f32x4){0.f, 0.f, 0.f, 0.f};
    bf16x8 At[4][2], B0[2][2], B1[2][2];
    const char* cA = cur.A; const char* cB = cur.B;
    PG8_STAGE(PG8_SB(0, 0), cB, voffB); PG8_STAGE(PG8_SB(0, 1), cB + hstep, voffB); PG8_STAGE(PG8_SA(0, 0), cA, voffA); PG8_STAGE(PG8_SA(0, 1), cA + hstep, voffA);
    if (wr == 1) PG8_BAR;
    PG8_WAIT_V(2); PG8_BAR;
    PG8_STAGE(PG8_SB(1, 0), cB + kstep, voffB); PG8_STAGE(PG8_SA(1, 0), cA + kstep, voffA); PG8_STAGE(PG8_SB(1, 1), cB + hstep + kstep, voffB);
    PG8_WAIT_V(6); PG8_BAR;
    for (;;) {
        const bool has_next = S.next(ui + 1, nxt);
        const char* nA = has_next ? nxt.A : cA; const char* nB = has_next ? nxt.B : cB;
        for (int t = 0; t < nt; t += 2) {
            const bool last = (t == nt - 2);
            const char* a1 = cA + (size_t)(t + 1) * kstep;
            const char* a2 = last ? nA : cA + (size_t)(t + 2) * kstep; const char* b2 = last ? nB : cB + (size_t)(t + 2) * kstep;
            const char* a3 = a2 + kstep; const char* b3 = b2 + kstep;
            PG8_LDB(B0, 0, 0); PG8_LDB(B1, 0, 1); PG8_SCHED; PG8_LDA(At, 0, 0); PG8_STAGE(PG8_SA(1, 1), a1 + hstep, voffA);
            PG8_WAIT_V(8); PG8_WAIT_L(0); PG8_BAR; PG8_MMA(0, 0, At, B0); PG8_MMA(0, 1, At, B1); PG8_BAR; PG8_SCHED;
            PG8_LDA(At, 0, 1); PG8_STAGE(PG8_SB(0, 0), b2, voffB); PG8_STAGE(PG8_SB(0, 1), b2 + hstep, voffB); PG8_STAGE(PG8_SA(0, 0), a2, voffA);
            PG8_WAIT_V(8); PG8_WAIT_L(0); PG8_BAR; PG8_MMA(1, 0, At, B0); PG8_MMA(1, 1, At, B1); PG8_BAR; PG8_SCHED;
            PG8_LDB(B0, 1, 0); PG8_LDB(B1, 1, 1); PG8_SCHED; PG8_LDA(At, 1, 0); PG8_STAGE(PG8_SA(0, 1), a2 + hstep, voffA);
            PG8_WAIT_V(8); PG8_WAIT_L(0); PG8_BAR; PG8_MMA(0, 0, At, B0); PG8_MMA(0, 1, At, B1); PG8_BAR; PG8_SCHED;
            PG8_LDA(At, 1, 1); PG8_STAGE(PG8_SB(1, 0), b3, voffB); PG8_STAGE(PG8_SB(1, 1), b3 + hstep, voffB); PG8_STAGE(PG8_SA(1, 0), a3, voffA);
            PG8_WAIT_V(8); PG8_WAIT_L(0); PG8_BAR; PG8_MMA(1, 0, At, B0); PG8_MMA(1, 1, At, B1); PG8_BAR; PG8_SCHED;
        }
        if (wr == 0) PG8_BAR;
        E(acc, cur, wr, wc, fr, fq);
        if (!has_next) break;
#pragma unroll
        for (int a = 0; a < 2; ++a)
#pragma unroll
            for (int b = 0; b < 2; ++b)
#pragma unroll
                for (int m = 0; m < 4; ++m)
#pragma unroll
                    for (int n = 0; n < 2; ++n) acc[a][b][m][n] = (f32x4){0.f, 0.f, 0.f, 0.f};
        cur = nxt; cA = nA; cB = nB; ++ui;
        if (wr == 1) PG8_BAR;
    }
    PG8_WAIT_V(0);
    PG8_BAR;
#undef PG8_SA
#undef PG8_SB
#undef PG8_STAGE
#undef PG8_LDA
#undef PG8_LDB
#undef PG8_MMA
#undef PG8_WAIT_V
#undef PG8_WAIT_L
#undef PG8_BAR
#undef PG8_SCHED
}
}
using pg8::Unit;

#define EPI_ROW(ai, m) (un.pm * 256 + (ai) * 128 + wr * 64 + (m) * 16 + fr)
struct EpiP1 {
    bf16_t* aglu; bf16_t* u; bf16_t* gvT; const float* b_in; const float* rx;
    __device__ __forceinline__ void operator()(const f32x4 (&acc)[2][2][4][2], const Unit& un, int wr, int wc, int fr, int fq) const {
        if (un.kind == 0) {
            const int c0 = un.pn * 128 + wc * 32 + 8 * fq;
            f32x4 ba[2], bg[2];
#pragma unroll
            for (int n = 0; n < 2; ++n) { ba[n] = *(const f32x4*)(b_in + c0 + 4 * n); bg[n] = *(const f32x4*)(b_in + 512 + c0 + 4 * n); }
            float rsv[2][4];
#pragma unroll
            for (int ai = 0; ai < 2; ++ai)
#pragma unroll
                for (int m = 0; m < 4; ++m) rsv[ai][m] = rx[EPI_ROW(ai, m)];
#pragma unroll
            for (int ai = 0; ai < 2; ++ai)
#pragma unroll
                for (int m = 0; m < 4; ++m) {
                    f32x4 v[2]; const float rs = rsv[ai][m];
#pragma unroll
                    for (int n = 0; n < 2; ++n) v[n] = glu4_(acc[ai][0][m][n] * rs + ba[n], acc[ai][1][m][n] * rs + bg[n]);
                    *(u32x4*)(aglu + (size_t)EPI_ROW(ai, m) * CW + c0) = pack8(v[0], v[1]);
                }
        } else if (un.kind == 1) {
            float rsv[2][4];
#pragma unroll
            for (int ai = 0; ai < 2; ++ai)
#pragma unroll
                for (int m = 0; m < 4; ++m) rsv[ai][m] = rx[EPI_ROW(ai, m)];
#pragma unroll
            for (int bj = 0; bj < 2; ++bj) {
                const int cu = un.pn * 256 + bj * 128 + wc * 32 + 8 * fq;
                f32x4 bb[2];
#pragma unroll
                for (int n = 0; n < 2; ++n) bb[n] = *(const f32x4*)(b_in + 1024 + cu + 4 * n);
#pragma unroll
                for (int ai = 0; ai < 2; ++ai)
#pragma unroll
                    for (int m = 0; m < 4; ++m) {
                        f32x4 v[2]; const float rs = rsv[ai][m];
#pragma unroll
                        for (int n = 0; n < 2; ++n) v[n] = gelu4_(acc[ai][bj][m][n] * rs + bb[n]);
                        *(u32x4*)(u + (size_t)EPI_ROW(ai, m) * GW + cu) = pack8(v[0], v[1]);
                    }
            }
        } else {
            f32x4 rt[2][2];
#pragma unroll
            for (int bj = 0; bj < 2; ++bj)
#pragma unroll
                for (int n = 0; n < 2; ++n) rt[bj][n] = *(const f32x4*)(rx + un.pn * 256 + bj * 128 + wc * 32 + 8 * fq + 4 * n);
            float bbv[2][4];
#pragma unroll
            for (int ai = 0; ai < 2; ++ai)
#pragma unroll
                for (int m = 0; m < 4; ++m) bbv[ai][m] = b_in[1536 + EPI_ROW(ai, m)];
#pragma unroll
            for (int ai = 0; ai < 2; ++ai)
#pragma unroll
                for (int m = 0; m < 4; ++m) {
                    const int ch = EPI_ROW(ai, m);
                    const float bb = bbv[ai][m];
#pragma unroll
                    for (int bj = 0; bj < 2; ++bj) {
                        const int tok = un.pn * 256 + bj * 128 + wc * 32 + 8 * fq;
                        f32x4 v[2];
#pragma unroll
                        for (int n = 0; n < 2; ++n) v[n] = gelu4_(acc[ai][bj][m][n] * rt[bj][n] + bb);
                        *(u32x4*)(gvT + (size_t)ch * M + tok) = pack8(v[0], v[1]);
                    }
                }
        }
    }
};
struct EpiKV {
    bf16_t* o0; bf16_t* o1;
    __device__ __forceinline__ void operator()(const f32x4 (&acc)[2][2][4][2], const Unit& un, int wr, int wc, int fr, int fq) const {
        bf16_t* o = un.kind == 0 ? o0 : o1;
#pragma unroll
        for (int ai = 0; ai < 2; ++ai)
#pragma unroll
            for (int m = 0; m < 4; ++m)
#pragma unroll
                for (int bj = 0; bj < 2; ++bj)
                    *(u32x4*)(o + (size_t)EPI_ROW(ai, m) * 1024 + un.pn * 256 + bj * 128 + wc * 32 + 8 * fq) = pack8(acc[ai][bj][m][0], acc[ai][bj][m][1]);
    }
};
template <bool RES_BF16> struct EpiRes {
    const bf16_t* resb; bf16_t* hb; float* ssq;
    __device__ __forceinline__ void operator()(const f32x4 (&acc)[2][2][4][2], const Unit& un, int wr, int wc, int fr, int fq) const {
        const size_t off0 = (size_t)(un.pm * 256 + wr * 64 + fr) * D + un.pn * 256 + wc * 32 + 8 * fq;
        if (RES_BF16) {
            u32x4 hv[2][4][2];
#pragma unroll
            for (int ai = 0; ai < 2; ++ai)
#pragma unroll
                for (int m = 0; m < 4; ++m)
#pragma unroll
                    for (int bj = 0; bj < 2; ++bj) hv[ai][m][bj] = *(const u32x4*)(resb + off0 + (size_t)(ai * 128 + m * 16) * D + bj * 128);
#pragma unroll
            for (int ai = 0; ai < 2; ++ai)
#pragma unroll
                for (int m = 0; m < 4; ++m) {
                    float ss = 0.f;
#pragma unroll
                    for (int bj = 0; bj < 2; ++bj) {
                        const u32x4 h4 = hv[ai][m][bj];
                        const f32x4 v0 = acc[ai][bj][m][0] + (f32x4){bf_lo(h4.x), bf_hi(h4.x), bf_lo(h4.y), bf_hi(h4.y)}, v1 = acc[ai][bj][m][1] + (f32x4){bf_lo(h4.z), bf_hi(h4.z), bf_lo(h4.w), bf_hi(h4.w)};
                        *(u32x4*)(hb + off0 + (size_t)(ai * 128 + m * 16) * D + bj * 128) = pack8(v0, v1);
                        ss += (v0[0] * v0[0] + v0[1] * v0[1]) + (v0[2] * v0[2] + v0[3] * v0[3]) + (v1[0] * v1[0] + v1[1] * v1[1]) + (v1[2] * v1[2] + v1[3] * v1[3]);
                    }
                    ss += __shfl_xor(ss, 16); ss += __shfl_xor(ss, 32);
                    if (fq == 0) ssq[(size_t)EPI_ROW(ai, m) * 16 + un.pn * 4 + wc] = ss;
                }
        } else {
#pragma unroll
            for (int aim = 0; aim < 4; ++aim) {
                const int ai = aim >> 1;
                f32x4 rv[4][2][2];
#pragma unroll
                for (int m = 2 * (aim & 1); m < 2 * (aim & 1) + 2; ++m)
#pragma unroll
                    for (int bj = 0; bj < 2; ++bj) { const float* p = (const float*)resb + off0 + (size_t)(ai * 128 + m * 16) * D + bj * 128; rv[m][bj][0] = *(const f32x4*)p; rv[m][bj][1] = *(const f32x4*)(p + 4); }
#pragma unroll
                for (int m = 2 * (aim & 1); m < 2 * (aim & 1) + 2; ++m) {
                    float ss = 0.f;
#pragma unroll
                    for (int bj = 0; bj < 2; ++bj) {
                        const f32x4 v0 = acc[ai][bj][m][0] + rv[m][bj][0], v1 = acc[ai][bj][m][1] + rv[m][bj][1];
                        *(u32x4*)(hb + off0 + (size_t)(ai * 128 + m * 16) * D + bj * 128) = pack8(v0, v1);
                        ss += (v0[0] * v0[0] + v0[1] * v0[1]) + (v0[2] * v0[2] + v0[3] * v0[3]) + (v1[0] * v1[0] + v1[1] * v1[1]) + (v1[2] * v1[2] + v1[3] * v1[3]);
                    }
                    ss += __shfl_xor(ss, 16); ss += __shfl_xor(ss, 32);
                    if (fq == 0) ssq[(size_t)EPI_ROW(ai, m) * 16 + un.pn * 4 + wc] = ss;
                }
                asm volatile("" ::: "memory");
            }
        }
    }
};
struct EpiFinal {
    const bf16_t* hb; float* out; float* ssqp; unsigned* cnt; const float* g;
    __device__ __forceinline__ void operator()(f32x4 (&acc)[2][2][4][2], const Unit& un, int wr, int wc, int fr, int fq) const {
        const size_t off0 = (size_t)(un.pm * 256 + wr * 64 + fr) * D + un.pn * 256 + wc * 32 + 8 * fq;
        {
            u32x4 hv[2][4][2];
#pragma unroll
            for (int ai = 0; ai < 2; ++ai)
#pragma unroll
                for (int m = 0; m < 4; ++m)
#pragma unroll
                    for (int bj = 0; bj < 2; ++bj) hv[ai][m][bj] = *(const u32x4*)(hb + off0 + (size_t)(ai * 128 + m * 16) * D + bj * 128);
#pragma unroll
            for (int ai = 0; ai < 2; ++ai)
#pragma unroll
                for (int m = 0; m < 4; ++m) {
                    float ss = 0.f;
#pragma unroll
                    for (int bj = 0; bj < 2; ++bj) {
                        const u32x4 h4 = hv[ai][m][bj];
                        const f32x4 v0 = acc[ai][bj][m][0] + (f32x4){bf_lo(h4.x), bf_hi(h4.x), bf_lo(h4.y), bf_hi(h4.y)}, v1 = acc[ai][bj][m][1] + (f32x4){bf_lo(h4.z), bf_hi(h4.z), bf_lo(h4.w), bf_hi(h4.w)};
                        acc[ai][bj][m][0] = v0; acc[ai][bj][m][1] = v1;
                        ss += (v0[0] * v0[0] + v0[1] * v0[1]) + (v0[2] * v0[2] + v0[3] * v0[3]) + (v1[0] * v1[0] + v1[1] * v1[1]) + (v1[2] * v1[2] + v1[3] * v1[3]);
                    }
                    ss += __shfl_xor(ss, 16); ss += __shfl_xor(ss, 32);
                    if (fq == 0) __hip_atomic_store(ssqp + ((size_t)un.pn * M + EPI_ROW(ai, m)) * 4 + wc, ss, __ATOMIC_RELAXED, __HIP_MEMORY_SCOPE_AGENT);
                }
        }
        asm volatile("s_waitcnt vmcnt(0)" ::: "memory");
        if ((threadIdx.x & 63) == 0) __hip_atomic_fetch_add(cnt + 64 * un.pm, 1u, __ATOMIC_RELAXED, __HIP_MEMORY_SCOPE_AGENT);
        f32x4 gg[2][2];
#pragma unroll
        for (int bj = 0; bj < 2; ++bj)
#pragma unroll
            for (int n = 0; n < 2; ++n) gg[bj][n] = *(const f32x4*)(g + un.pn * 256 + bj * 128 + wc * 32 + 8 * fq + 4 * n);
        if (wr == 0 && wc == 0) {
            unsigned sp = 0;
            while ((unsigned)__builtin_amdgcn_readfirstlane(__hip_atomic_load(cnt + 64 * un.pm, __ATOMIC_RELAXED, __HIP_MEMORY_SCOPE_AGENT)) < 32u) { __builtin_amdgcn_s_sleep(2); if (++sp > (1u << 22)) break; }
            __builtin_amdgcn_fence(__ATOMIC_ACQUIRE, "agent");
        }
        asm volatile("s_waitcnt vmcnt(0) lgkmcnt(0)" ::: "memory"); __builtin_amdgcn_s_barrier(); asm volatile("" ::: "memory");
        float rr[2][4];
        {
            unsigned long long p0[2][4], p1[2][4];
#pragma unroll
            for (int ai = 0; ai < 2; ++ai)
#pragma unroll
                for (int m = 0; m < 4; ++m) { const unsigned long long* sp8 = (const unsigned long long*)(ssqp + ((size_t)fq * M + EPI_ROW(ai, m)) * 4);
                    p0[ai][m] = __hip_atomic_load(sp8, __ATOMIC_RELAXED, __HIP_MEMORY_SCOPE_AGENT); p1[ai][m] = __hip_atomic_load(sp8 + 1, __ATOMIC_RELAXED, __HIP_MEMORY_SCOPE_AGENT); }
#pragma unroll
            for (int ai = 0; ai < 2; ++ai)
#pragma unroll
                for (int m = 0; m < 4; ++m) {
                    float t = (__uint_as_float((unsigned)p0[ai][m]) + __uint_as_float((unsigned)(p0[ai][m] >> 32))) + (__uint_as_float((unsigned)p1[ai][m]) + __uint_as_float((unsigned)(p1[ai][m] >> 32)));
                    t += __shfl_xor(t, 16); t += __shfl_xor(t, 32);
                    rr[ai][m] = 1.0f / sqrtf(t * (1.0f / D) + RMS_EPS);
                }
        }
#pragma unroll
        for (int ai = 0; ai < 2; ++ai)
#pragma unroll
            for (int m = 0; m < 4; ++m) {
                const float r = rr[ai][m];
#pragma unroll
                for (int bj = 0; bj < 2; ++bj) {
                    float* op = out + off0 + (size_t)(ai * 128 + m * 16) * D + bj * 128;
                    *(f32x4*)op = acc[ai][bj][m][0] * r * gg[bj][0]; *(f32x4*)(op + 4) = acc[ai][bj][m][1] * r * gg[bj][1];
                }
            }
    }
};
__device__ __forceinline__ float row_rs(const float* ssq, int row, int fq) {
    const f32x4 p = *(const f32x4*)(ssq + (size_t)row * 16 + 4 * fq);
    float s = (p[0] + p[1]) + (p[2] + p[3]); s += __shfl_xor(s, 16); s += __shfl_xor(s, 32);
    return __builtin_amdgcn_rsqf(s * (1.0f / D) + RMS_EPS);
}
struct EpiQ {
    bf16_t* q; const float* ssq;
    __device__ __forceinline__ void operator()(const f32x4 (&acc)[2][2][4][2], const Unit& un, int wr, int wc, int fr, int fq) const {
        float rsv[2][4];
#pragma unroll
        for (int ai = 0; ai < 2; ++ai)
#pragma unroll
            for (int m = 0; m < 4; ++m) rsv[ai][m] = row_rs(ssq, EPI_ROW(ai, m), fq);
#pragma unroll
        for (int ai = 0; ai < 2; ++ai)
#pragma unroll
            for (int m = 0; m < 4; ++m) {
                const int row = EPI_ROW(ai, m); const float r = rsv[ai][m] * QSCALE;
#pragma unroll
                for (int bj = 0; bj < 2; ++bj)
                    *(u32x4*)(q + (size_t)row * D + un.pn * 256 + bj * 128 + wc * 32 + 8 * fq) = pack8(acc[ai][bj][m][0] * r, acc[ai][bj][m][1] * r);
            }
    }
};
struct EpiGU {
    bf16_t* act; const LAS float* rsT;
    __device__ __forceinline__ void operator()(const f32x4 (&acc)[2][2][4][2], const Unit& un, int wr, int wc, int fr, int fq) const {
        float rsv[2][4];
#pragma unroll
        for (int ai = 0; ai < 2; ++ai)
#pragma unroll
            for (int m = 0; m < 4; ++m) rsv[ai][m] = rsT[un.idx * 256 + ai * 128 + wr * 64 + m * 16 + fr];
#pragma unroll
        for (int ai = 0; ai < 2; ++ai)
#pragma unroll
            for (int m = 0; m < 4; ++m) {
                const int row = EPI_ROW(ai, m); const float r = rsv[ai][m];
                f32x4 v[2];
#pragma unroll
                for (int n = 0; n < 2; ++n) v[n] = swiglu4_(acc[ai][0][m][n], acc[ai][1][m][n], -LOG2E * r, r * r);
                *(u32x4*)(act + (size_t)row * FF + un.pn * 128 + wc * 32 + 8 * fq) = pack8(v[0], v[1]);
            }
    }
};

__device__ __forceinline__ void p0_transpose_item(const float* W, int N, bf16_t* WT, int K, int dest_row0, const float* gk, LAS float* scr, int k0, int n0, int lane) {
    float v[32];
    const float* wp = W + (size_t)(k0 + (lane >> 5)) * N + n0 + (lane & 31);
#pragma unroll
    for (int i = 0; i < 32; ++i) v[i] = wp[(size_t)(2 * i) * N];
    if (gk) {
        const float gv = gk[k0 + lane];
#pragma unroll
        for (int i = 0; i < 32; ++i) v[i] *= __shfl(gv, 2 * i + (lane >> 5));
    }
#pragma unroll
    for (int i = 0; i < 32; ++i) scr[(2 * i + (lane >> 5)) * 33 + (lane & 31)] = v[i];
    asm volatile("s_waitcnt lgkmcnt(0)" ::: "memory");
    const int c = lane & 7;
#pragma unroll
    for (int j = 0; j < 4; ++j) { const int n = (lane >> 3) + 8 * j; const LAS float* s = scr + (8 * c) * 33 + n;
        u32x4 o; o.x = cvt_pk_bf16(s[0 * 33], s[1 * 33]); o.y = cvt_pk_bf16(s[2 * 33], s[3 * 33]); o.z = cvt_pk_bf16(s[4 * 33], s[5 * 33]); o.w = cvt_pk_bf16(s[6 * 33], s[7 * 33]);
        *(u32x4*)(WT + (size_t)(dest_row0 + n) * K + k0 + 8 * c) = o; }
    asm volatile("s_waitcnt lgkmcnt(0)" ::: "memory");
}
__device__ __forceinline__ void rms_row_to_bf16(const float* xrow, const float* g, bf16_t* orow, int lane) {
    const f32x4* xr = (const f32x4*)xrow + lane; const f32x4* gr = (const f32x4*)g + lane;
    f32x4 v[4]; float s = 0.f;
#pragma unroll
    for (int j = 0; j < 4; ++j) { v[j] = xr[64 * j]; s += (v[j][0] * v[j][0] + v[j][1] * v[j][1]) + (v[j][2] * v[j][2] + v[j][3] * v[j][3]); }
    const float r = 1.0f / sqrtf(wave_sum(s) * (1.0f / D) + RMS_EPS);
    u32x2* o8 = (u32x2*)orow + lane;
#pragma unroll
    for (int j = 0; j < 4; ++j) { const f32x4 gg = gr[64 * j]; u32x2 w; w.x = cvt_pk_bf16(v[j][0] * r * gg[0], v[j][1] * r * gg[1]); w.y = cvt_pk_bf16(v[j][2] * r * gg[2], v[j][3] * r * gg[3]); o8[64 * j] = w; }
}

struct Args { const float* in[23]; float* out; unsigned char* ws; unsigned long long never; };

__device__ __forceinline__ void rms_row2_to_bf16(const float* xrow, const float* g, bf16_t* orow, int lane) {
    const f32x4* xr = (const f32x4*)xrow + lane; const f32x4* gr = (const f32x4*)g + lane;
    f32x4 v[8]; float s0 = 0.f, s1 = 0.f;
#pragma unroll
    for (int j = 0; j < 8; ++j) v[j] = xr[64 * j];
#pragma unroll
    for (int j = 0; j < 4; ++j) { s0 += (v[j][0] * v[j][0] + v[j][1] * v[j][1]) + (v[j][2] * v[j][2] + v[j][3] * v[j][3]); s1 += (v[4 + j][0] * v[4 + j][0] + v[4 + j][1] * v[4 + j][1]) + (v[4 + j][2] * v[4 + j][2] + v[4 + j][3] * v[4 + j][3]); }
    const float r0 = 1.0f / sqrtf(wave_sum(s0) * (1.0f / D) + RMS_EPS), r1 = 1.0f / sqrtf(wave_sum(s1) * (1.0f / D) + RMS_EPS);
    u32x2* o8 = (u32x2*)orow + lane;
#pragma unroll
    for (int j = 0; j < 4; ++j) { const f32x4 gg = gr[64 * j]; u32x2 w;
        w.x = cvt_pk_bf16(v[j][0] * r0 * gg[0], v[j][1] * r0 * gg[1]); w.y = cvt_pk_bf16(v[j][2] * r0 * gg[2], v[j][3] * r0 * gg[3]); o8[64 * j] = w;
        w.x = cvt_pk_bf16(v[4 + j][0] * r1 * gg[0], v[4 + j][1] * r1 * gg[1]); w.y = cvt_pk_bf16(v[4 + j][2] * r1 * gg[2], v[4 + j][3] * r1 * gg[3]); o8[256 + 64 * j] = w; }
}
__device__ __forceinline__ void rms_row4_to_bf16(const float* xrow, const float* g, bf16_t* orow, int lane) {
    const f32x4* xr = (const f32x4*)xrow + lane; const f32x4* gr = (const f32x4*)g + lane;
    f32x4 v[16]; float ss[4];
#pragma unroll
    for (int j = 0; j < 16; ++j) v[j] = xr[64 * j];
#pragma unroll
    for (int r = 0; r < 4; ++r) { float s = 0.f;
#pragma unroll
        for (int j = 0; j < 4; ++j) s += (v[4 * r + j][0] * v[4 * r + j][0] + v[4 * r + j][1] * v[4 * r + j][1]) + (v[4 * r + j][2] * v[4 * r + j][2] + v[4 * r + j][3] * v[4 * r + j][3]);
        ss[r] = s; }
#pragma unroll
    for (int o = 1; o < 64; o <<= 1) {
#pragma unroll
        for (int r = 0; r < 4; ++r) ss[r] += __shfl_xor(ss[r], o); }
    u32x2* o8 = (u32x2*)orow + lane;
#pragma unroll
    for (int j = 0; j < 4; ++j) { const f32x4 gg = gr[64 * j];
#pragma unroll
        for (int r = 0; r < 4; ++r) { const float rr = 1.0f / sqrtf(ss[r] * (1.0f / D) + RMS_EPS); const f32x4 x = v[4 * r + j]; u32x2 w;
            w.x = cvt_pk_bf16(x[0] * rr * gg[0], x[1] * rr * gg[1]); w.y = cvt_pk_bf16(x[2] * rr * gg[2], x[3] * rr * gg[3]); o8[256 * r + 64 * j] = w; } }
}
__device__ __forceinline__ void x_row4_to_bf16(const float* xrow, bf16_t* orow, float* rx, int lane) {
    const f32x4* xr = (const f32x4*)xrow + lane;
    f32x4 v[16]; float ss[4];
#pragma unroll
    for (int j = 0; j < 16; ++j) v[j] = xr[64 * j];
    u32x2* o8 = (u32x2*)orow + lane;
#pragma unroll
    for (int r = 0; r < 4; ++r) { float s = 0.f;
#pragma unroll
        for (int j = 0; j < 4; ++j) { const f32x4 x = v[4 * r + j]; s += (x[0] * x[0] + x[1] * x[1]) + (x[2] * x[2] + x[3] * x[3]);
            u32x2 w; w.x = cvt_pk_bf16(x[0], x[1]); w.y = cvt_pk_bf16(x[2], x[3]); o8[256 * r + 64 * j] = w; }
        ss[r] = s; }
#pragma unroll
    for (int o = 1; o < 64; o <<= 1) {
#pragma unroll
        for (int r = 0; r < 4; ++r) ss[r] += __shfl_xor(ss[r], o); }
    if (lane < 4) rx[lane] = 1.0f / sqrtf((lane == 0 ? ss[0] : lane == 1 ? ss[1] : lane == 2 ? ss[2] : ss[3]) * (1.0f / D) + RMS_EPS);
}
__device__ __forceinline__ void p0_prologue(const Args& a, LAS unsigned char* lds, int bid, int G, int wid, int lane) {
    LAS float* scr = (LAS float*)(lds + wid * 16384);
    const int gw = bid * 8 + wid, NGW = G * 8;
    unsigned char* ws = a.ws;
    constexpr int I0 = 16 * 64, I1 = 16 * 32, I3 = 16 * 64;
    constexpr int NITEMS = I0 + I1 + I3;
    for (int it = gw; it < NITEMS; it += NGW) {
        int r = it;
        if (r < I0) { const int nb = r % 64, kb = r / 64, n0 = nb * 32; int dr = n0;
            if (n0 < 1024) { const int half = n0 / 512, c = n0 % 512; dr = 256 * (c / 128) + 128 * half + (c % 128); }
            p0_transpose_item(a.in[3], 2048, (bf16_t*)(ws + WS_BT1), 1024, dr, a.in[2], scr, kb * 64, n0, lane); continue; } r -= I0;
        if (r < I1) { p0_transpose_item(a.in[13], 1024, (bf16_t*)(ws + WS_WOUT), 1024, (r % 32) * 32, nullptr, scr, (r / 32) * 64, (r % 32) * 32, lane); continue; } r -= I1;
        p0_transpose_item(a.in[17], 2048, (bf16_t*)(ws + WS_WKV), 1024, (r % 64) * 32, nullptr, scr, (r / 64) * 64, (r % 64) * 32, lane);
    }
    for (int m = 4 * gw; m < M; m += 4 * NGW) x_row4_to_bf16(a.in[0] + (size_t)m * D, (bf16_t*)(ws + WS_HN) + (size_t)m * D, (float*)(ws + WS_RX) + m, lane);
    for (int m = gw; m < MR; m += NGW) rms_row_to_bf16(a.in[1] + (size_t)m * D, a.in[15], (bf16_t*)(ws + WS_MN) + (size_t)m * D, lane);
    for (int rr = gw; rr < 8 * 128; rr += NGW) {
        const int t = rr & 127; const f32x2 wv = *(const f32x2*)(a.in[11] + (size_t)rr * 128 + 2 * lane);
        ((unsigned*)(ws + WS_WSB))[(size_t)rr * 64 + lane] = cvt_pk_bf16(2 * lane <= t ? wv[0] : 0.f, 2 * lane + 1 <= t ? wv[1] : 0.f);
    }
}
struct LwItem { const float* wp; const float* gk; bf16_t* wt; int N, K, k0; };
__device__ __forceinline__ LwItem lw_decode(const Args& a, unsigned char* ws, int it, int lane) {
    constexpr int I2 = 16 * 32, I4 = 16 * 32, I5 = 16 * 176;
    const float* W; const float* gk = nullptr; bf16_t* WT; int N, K = 1024, k0, n0, dr;
    if (it < I2) { W = a.in[16]; gk = a.in[14]; WT = (bf16_t*)(ws + WS_WQ); N = 1024; k0 = (it / 32) * 64; n0 = (it % 32) * 32; dr = n0; }
    else if (it < I2 + I4) { const int r = it - I2; W = a.in[18]; WT = (bf16_t*)(ws + WS_WO); N = 1024; k0 = (r / 32) * 64; n0 = (r % 32) * 32; dr = n0; }
    else if (it < I2 + I4 + I5) { const int r = it - I2 - I4; W = a.in[20]; gk = a.in[19]; WT = (bf16_t*)(ws + WS_WGU); N = 2 * FF; k0 = (r / 176) * 64; n0 = (r % 176) * 32;
        const int half = n0 / FF, c = n0 % FF; dr = 256 * (c / 128) + 128 * half + (c % 128); }
    else { const int r = it - I2 - I4 - I5; W = a.in[21]; WT = (bf16_t*)(ws + WS_WD); N = 1024; K = FF; k0 = (r / 32) * 64; n0 = (r % 32) * 32; dr = n0; }
    LwItem d; d.wp = W + (size_t)(k0 + (lane >> 5)) * N + n0 + (lane & 31); d.gk = gk; d.wt = WT + (size_t)dr * K + k0; d.N = N; d.K = K; d.k0 = k0; return d;
}
__device__ __forceinline__ void late_weights(const Args& a, LAS unsigned char* lds, int gw, int NGW, int wid, int lane) {
    LAS float* scr = (LAS float*)(lds + wid * 16384);
    unsigned char* ws = a.ws;
    constexpr int NITEMS = 16 * 32 + 16 * 32 + 16 * 176 + 44 * 32;
    if (gw >= NITEMS) return;
    LwItem cur = lw_decode(a, ws, gw, lane);
    float v[32];
#pragma unroll
    for (int i = 0; i < 32; ++i) v[i] = cur.wp[(size_t)(2 * i) * cur.N];
    for (int it = gw; it < NITEMS; it += NGW) {
        const bool has_next = it + NGW < NITEMS;
        LwItem nxt = cur; float nv[32];
        if (has_next) { nxt = lw_decode(a, ws, it + NGW, lane);
#pragma unroll
            for (int i = 0; i < 32; ++i) nv[i] = nxt.wp[(size_t)(2 * i) * nxt.N]; }
        if (cur.gk) { const float gv = cur.gk[cur.k0 + lane];
#pragma unroll
            for (int i = 0; i < 32; ++i) v[i] *= __shfl(gv, 2 * i + (lane >> 5)); }
#pragma unroll
        for (int i = 0; i < 32; ++i) scr[(2 * i + (lane >> 5)) * 33 + (lane & 31)] = v[i];
        asm volatile("s_waitcnt lgkmcnt(0)" ::: "memory");
        const int c = lane & 7;
#pragma unroll
        for (int j = 0; j < 4; ++j) { const int n = (lane >> 3) + 8 * j; const LAS float* sp = scr + (8 * c) * 33 + n;
            u32x4 o; o.x = cvt_pk_bf16(sp[0 * 33], sp[1 * 33]); o.y = cvt_pk_bf16(sp[2 * 33], sp[3 * 33]); o.z = cvt_pk_bf16(sp[4 * 33], sp[5 * 33]); o.w = cvt_pk_bf16(sp[6 * 33], sp[7 * 33]);
            *(u32x4*)(cur.wt + (size_t)n * cur.K + 8 * c) = o; }
        asm volatile("s_waitcnt lgkmcnt(0)" ::: "memory");
        if (has_next) {
#pragma unroll
            for (int i = 0; i < 32; ++i) v[i] = nv[i];
            cur = nxt; }
    }
}

template <int NT> __device__ __forceinline__ void conv_unit(const Args& a, LAS unsigned char* lds, int unit, int tid, int wid, int lane) {
    unsigned char* ws = a.ws;
    const bf16_t* aglu = (const bf16_t*)(ws + WS_AGLU); const bf16_t* ub = (const bf16_t*)(ws + WS_U); const bf16_t* gvT = (const bf16_t*)(ws + WS_GVT);
    const bf16_t* wsb = (const bf16_t*)(ws + WS_WSB); bf16_t* mix = (bf16_t*)(ws + WS_MIX);
    const int t0 = unit * NT, p0 = t0 & (SEQ - 1);
    constexpr int HT = NT / 2, NB = NT / 16;
    {
        const int cp = tid & 255, th = tid >> 8;
        f32x2 w[31];
#pragma unroll
        for (int k = 0; k < 31; ++k) w[k] = *(const f32x2*)(a.in[5] + k * CW + 2 * cp);
        const f32x2 cb = *(const f32x2*)(a.in[6] + 2 * cp);
        const int base = t0 + HT * th;
        const int pbase = p0 + HT * th;
        const unsigned* arow = (const unsigned*)aglu + cp;
        f32x2 win[38];
#pragma unroll
        for (int i = 0; i < 30; ++i) { const bool ok = (pbase - 30 + i) >= 0; const unsigned v = ok ? arow[(size_t)(base - 30 + i) * 256] : 0u; win[i] = (f32x2){bf_lo(v), bf_hi(v)}; }
        unsigned nx[8], nx2[8];
#pragma unroll
        for (int i = 0; i < 8; ++i) nx[i] = arow[(size_t)(base + i) * 256];
#pragma unroll
        for (int i = 0; i < 8; ++i) nx2[i] = arow[(size_t)(base + 8 + i) * 256];
        for (int blk = 0; blk < NB; ++blk) {
#pragma unroll
            for (int i = 0; i < 8; ++i) win[30 + i] = (f32x2){bf_lo(nx[i]), bf_hi(nx[i])};
#pragma unroll
            for (int i = 0; i < 8; ++i) nx[i] = nx2[i];
            if (blk < NB - 2) {
#pragma unroll
                for (int i = 0; i < 8; ++i) nx2[i] = arow[(size_t)(base + 8 * (blk + 2) + i) * 256];
            }
#pragma unroll
            for (int o = 0; o < 8; ++o) {
                f32x2 s = cb;
#pragma unroll
                for (int k = 0; k < 31; ++k) s += w[k] * win[o + k];
                *(LAS unsigned*)(lds + (size_t)(HT * th + 8 * blk + o) * 1024 + cp * 4) = cvt_pk_bf16(s[0], s[1]);
            }
#pragma unroll
            for (int i = 0; i < 30; ++i) win[i] = win[i + 8];
        }
    }
    __syncthreads();
    {
        f32x4 g0 = *(const f32x4*)(a.in[7] + 8 * lane), g1 = *(const f32x4*)(a.in[7] + 8 * lane + 4);
        f32x4 b0 = *(const f32x4*)(a.in[8] + 8 * lane), b1 = *(const f32x4*)(a.in[8] + 8 * lane + 4);
        constexpr int NR = NT / 8;
        f32x4 x0[NR], x1[NR]; float sm[NR];
#pragma unroll
        for (int i = 0; i < NR; ++i) {
            const u32x4 raw = *(const LAS u32x4*)(lds + (size_t)(wid * NR + i) * 1024 + lane * 16);
            x0[i] = (f32x4){bf_lo(raw.x), bf_hi(raw.x), bf_lo(raw.y), bf_hi(raw.y)}; x1[i] = (f32x4){bf_lo(raw.z), bf_hi(raw.z), bf_lo(raw.w), bf_hi(raw.w)};
            const f32x4 t = x0[i] + x1[i]; sm[i] = (t[0] + t[1]) + (t[2] + t[3]);
        }
#pragma unroll
        for (int o = 1; o < 64; o <<= 1) {
#pragma unroll
            for (int i = 0; i < NR; ++i) sm[i] += __shfl_xor(sm[i], o); }
#pragma unroll
        for (int i = 0; i < NR; ++i) { const float mean = sm[i] * (1.0f / CW); x0[i] = x0[i] - mean; x1[i] = x1[i] - mean;
            const f32x4 t = x0[i] * x0[i] + x1[i] * x1[i]; sm[i] = (t[0] + t[1]) + (t[2] + t[3]); }
#pragma unroll
        for (int o = 1; o < 64; o <<= 1) {
#pragma unroll
            for (int i = 0; i < NR; ++i) sm[i] += __shfl_xor(sm[i], o); }
#pragma unroll
        for (int i = 0; i < NR; ++i) {
            const float rstd = 1.0f / sqrtf(sm[i] * (1.0f / CW) + LN_EPS);
            const f32x4 y0 = x0[i] * rstd * g0 + b0, y1 = x1[i] * rstd * g1 + b1;
            const f32x4 z0 = y0 * sig4_from_t_(y0 * (-LOG2E)), z1 = y1 * sig4_from_t_(y1 * (-LOG2E));
            *(u32x4*)(mix + (size_t)(t0 + wid * NR + i) * D + 8 * lane) = pack8(z0, z1);
        }
    }
    __syncthreads();
}
__device__ __forceinline__ void gmlp_unit(const Args& a, LAS unsigned char* lds, int chunk, int tid, int wid, int lane) {
    unsigned char* ws = a.ws;
    const bf16_t* ub = (const bf16_t*)(ws + WS_U); const bf16_t* gvT = (const bf16_t*)(ws + WS_GVT);
    const bf16_t* wsb = (const bf16_t*)(ws + WS_WSB); bf16_t* mix = (bf16_t*)(ws + WS_MIX);
    const int t0 = chunk * CHUNK;
    constexpr int LDG = 264;
    LAS unsigned char* part = lds + 512 * LDG;
    LAS f32x2* stat = (LAS f32x2*)(lds + 512 * LDG + 8192);
    const int h = wid, fr = lane & 15, fq = lane >> 4;
    bf16x8 Bf[20];
    const bf16_t* wb = wsb + (size_t)(h * 128 + fr) * 128 + 8 * fq;
    {
        int n = 0;
#pragma unroll
        for (int ks = 0; ks < 2; ++ks)
#pragma unroll
            for (int tb = 0; tb < 4; ++tb) { if (tb < 2 * ks) continue; Bf[n++] = *(const bf16x8*)(wb + (size_t)(16 * tb) * 128 + 32 * ks); }
    }
    const bf16_t* ubase = ub + (size_t)(t0 + fr) * GW + 64 * h + 4 * fq;
    u32x2 uu[2][4][4];
#pragma unroll
    for (int tb = 0; tb < 4; ++tb)
#pragma unroll
        for (int db = 0; db < 4; ++db) uu[0][tb][db] = *(const u32x2*)(ubase + (size_t)(16 * tb) * GW + 16 * db);
    {
        const bf16_t* gp = gvT + (size_t)(tid >> 4) * M + t0 + (tid & 15) * 8;
        LAS unsigned char* lp = lds + (tid >> 4) * LDG + (tid & 15) * 16;
        u32x4 tr[16];
#pragma unroll
        for (int p = 0; p < 16; ++p) tr[p] = *(const u32x4*)(gp + (size_t)(32 * p) * M);
#pragma unroll
        for (int p = 0; p < 16; ++p) *(LAS u32x4*)(lp + 32 * p * LDG) = tr[p];
    }
    __syncthreads();
    {
        const int tg = tid & 15, cgp = tid >> 4;
        float sm[8], sq[8];
#pragma unroll
        for (int j = 0; j < 8; ++j) { sm[j] = 0.f; sq[j] = 0.f; }
        const LAS unsigned char* rp = lds + (16 * cgp) * LDG + tg * 16;
#pragma unroll
        for (int c = 0; c < 16; ++c) { const u32x4 r = *(const LAS u32x4*)(rp + c * LDG);
            const float v[8] = {bf_lo(r.x), bf_hi(r.x), bf_lo(r.y), bf_hi(r.y), bf_lo(r.z), bf_hi(r.z), bf_lo(r.w), bf_hi(r.w)};
#pragma unroll
            for (int j = 0; j < 8; ++j) { sm[j] += v[j]; sq[j] += v[j] * v[j]; } }
#pragma unroll
        for (int j = 0; j < 8; ++j) { sm[j] += __shfl_xor(sm[j], 16); sm[j] += __shfl_xor(sm[j], 32); sq[j] += __shfl_xor(sq[j], 16); sq[j] += __shfl_xor(sq[j], 32); }
        if (lane < 16) {
#pragma unroll
            for (int j = 0; j < 8; ++j) *(LAS f32x2*)(part + ((size_t)wid * 128 + 8 * tg + j) * 8) = (f32x2){sm[j], sq[j]};
        }
        __syncthreads();
        if (tid < 128) { float ts = 0.f, tq2 = 0.f;
#pragma unroll
            for (int w = 0; w < 8; ++w) { const f32x2 p = *(const LAS f32x2*)(part + ((size_t)w * 128 + tid) * 8); ts += p[0]; tq2 += p[1]; }
            const float mean = ts * (1.0f / GW); const float var = fmaxf(tq2 * (1.0f / GW) - mean * mean, 0.f);
            stat[tid] = (f32x2){mean, 1.0f / sqrtf(var + LN_EPS)}; }
        __syncthreads();
    }
    {
        float lg[4], lb[4];
#pragma unroll
        for (int db = 0; db < 4; ++db) { lg[db] = a.in[9][64 * h + 16 * db + fr]; lb[db] = a.in[10][64 * h + 16 * db + fr]; }
        const LAS unsigned char* abase = lds + (64 * h + fr) * LDG + fq * 16;
        bf16_t* obase = mix + (size_t)(t0 + fr) * D + 512 + 64 * h + 4 * fq;
        int nb = 0;
#pragma unroll
        for (int th = 0; th < 2; ++th) {
            if (th == 0) {
#pragma unroll
                for (int tb = 0; tb < 4; ++tb)
#pragma unroll
                    for (int db = 0; db < 4; ++db) uu[1][tb][db] = *(const u32x2*)(ubase + (size_t)(16 * (4 + tb)) * GW + 16 * db);
            }
            f32x4 acc[4][4];
#pragma unroll
            for (int db = 0; db < 4; ++db)
#pragma unroll
                for (int tb = 0; tb < 4; ++tb) acc[db][tb] = (f32x4){0.f, 0.f, 0.f, 0.f};
#pragma unroll
            for (int ks = 0; ks < 2 * th + 2; ++ks) {
                float mu[8], rs[8];
#pragma unroll
                for (int j = 0; j < 8; ++j) { const f32x2 st = stat[32 * ks + 8 * fq + j]; mu[j] = st[0]; rs[j] = st[1]; }
                bf16x8 Af[4];
#pragma unroll
                for (int db = 0; db < 4; ++db) {
                    const u32x4 r = *(const LAS u32x4*)(abase + 16 * db * LDG + 64 * ks);
                    const float gg = lg[db], bb = lb[db];
                    u32x4 o;
                    o.x = cvt_pk_bf16((bf_lo(r.x) - mu[0]) * rs[0] * gg + bb, (bf_hi(r.x) - mu[1]) * rs[1] * gg + bb);
                    o.y = cvt_pk_bf16((bf_lo(r.y) - mu[2]) * rs[2] * gg + bb, (bf_hi(r.y) - mu[3]) * rs[3] * gg + bb);
                    o.z = cvt_pk_bf16((bf_lo(r.z) - mu[4]) * rs[4] * gg + bb, (bf_hi(r.z) - mu[5]) * rs[5] * gg + bb);
                    o.w = cvt_pk_bf16((bf_lo(r.w) - mu[6]) * rs[6] * gg + bb, (bf_hi(r.w) - mu[7]) * rs[7] * gg + bb);
                    Af[db] = __builtin_bit_cast(bf16x8, o);
                }
#pragma unroll
                for (int tb = 0; tb < 4; ++tb) {
                    if (4 * th + tb < 2 * ks) continue;
                    const bf16x8 bfr = Bf[nb++];
#pragma unroll
                    for (int db = 0; db < 4; ++db) acc[db][tb] = __builtin_amdgcn_mfma_f32_16x16x32_bf16(Af[db], bfr, acc[db][tb], 0, 0, 0);
                }
            }
            if (th == 0) {
                asm volatile("" ::: "memory");
                int n = 6;
#pragma unroll
                for (int ks = 0; ks < 4; ++ks)
#pragma unroll
                    for (int tb = 0; tb < 4; ++tb) { if (4 + tb < 2 * ks) continue; Bf[n++] = *(const bf16x8*)(wb + (size_t)(16 * (4 + tb)) * 128 + 32 * ks); }
                asm volatile("" ::: "memory");
            }
#pragma unroll
            for (int tb = 0; tb < 4; ++tb) {
                const float bs = a.in[12][h * 128 + 16 * (4 * th + tb) + fr];
#pragma unroll
                for (int db = 0; db < 4; ++db) {
                    u32x2 o; o.x = cvt_pk_bf16(bf_lo(uu[th][tb][db].x) * (acc[db][tb][0] + bs), bf_hi(uu[th][tb][db].x) * (acc[db][tb][1] + bs));
                    o.y = cvt_pk_bf16(bf_lo(uu[th][tb][db].y) * (acc[db][tb][2] + bs), bf_hi(uu[th][tb][db].y) * (acc[db][tb][3] + bs));
                    *(u32x2*)(obase + (size_t)(16 * (4 * th + tb)) * D + 16 * db) = o;
                }
            }
        }
    }
}

__device__ __forceinline__ void attn_unit(LAS unsigned char* lds, const bf16_t* q, const bf16_t* Km, const bf16_t* Vt, bf16_t* o, int pm, int h, int tid, int wid, int lane) {
    constexpr int LDK = 544, LDV = 528;
    const int fr = lane & 15, fq = lane >> 4, b = pm >> 4, row0 = pm * 256 + wid * 32;
    {
        const bf16_t* kg = Km + (size_t)(b * 256 + (tid >> 5)) * 1024 + h * 256 + (tid & 31) * 8;
        LAS unsigned char* kl = lds + (tid >> 5) * LDK + (tid & 31) * 16;
#pragma unroll
        for (int half = 0; half < 2; ++half) {
            u32x4 kr[8];
#pragma unroll
            for (int i = 0; i < 8; ++i) kr[i] = *(const u32x4*)(kg + (size_t)(half * 8 + i) * 16 * 1024);
#pragma unroll
            for (int i = 0; i < 8; ++i) *(LAS u32x4*)(kl + (half * 8 + i) * 16 * LDK) = kr[i];
        }
    }
    __syncthreads();
    bf16x8 Pf[2][8]; float inv[2];
    const bf16_t* qbase = q + (size_t)(row0 + fr) * D + h * 256 + 8 * fq;
#pragma unroll
    for (int qb = 0; qb < 2; ++qb) {
        bf16x8 Qf[8];
#pragma unroll
        for (int ks = 0; ks < 8; ++ks) Qf[ks] = *(const bf16x8*)(qbase + (size_t)(16 * qb) * D + 32 * ks);
        f32x4 S[16];
#pragma unroll
        for (int kb = 0; kb < 16; ++kb) S[kb] = (f32x4){0.f, 0.f, 0.f, 0.f};
        bf16x8 kf[2][4];
        const LAS unsigned char* kbase = lds + fr * LDK + fq * 16;
#pragma unroll
        for (int k4 = 0; k4 < 4; ++k4) kf[0][k4] = *(const LAS bf16x8*)(kbase + 64 * k4);
#pragma unroll
        for (int it = 0; it < 32; ++it) {
            if (it < 31) {
#pragma unroll
                for (int k4 = 0; k4 < 4; ++k4) kf[(it + 1) & 1][k4] = *(const LAS bf16x8*)(kbase + 16 * ((it + 1) >> 1) * LDK + 64 * (4 * ((it + 1) & 1) + k4));
            }
#pragma unroll
            for (int k4 = 0; k4 < 4; ++k4) S[it >> 1] = __builtin_amdgcn_mfma_f32_16x16x32_bf16(kf[it & 1][k4], Qf[4 * (it & 1) + k4], S[it >> 1], 0, 0, 0);
#pragma unroll
            for (int k4 = 0; k4 < 4; ++k4) { __builtin_amdgcn_sched_group_barrier(0x100, 1, 0); __builtin_amdgcn_sched_group_barrier(0x008, 1, 0); }
            __builtin_amdgcn_sched_barrier(0);
        }
        float mx = -3.0e38f;
#pragma unroll
        for (int kb = 0; kb < 16; ++kb) mx = fmaxf(fmaxf(fmaxf(S[kb][0], S[kb][1]), fmaxf(S[kb][2], S[kb][3])), mx);
        mx = fmaxf(mx, __shfl_xor(mx, 16)); mx = fmaxf(mx, __shfl_xor(mx, 32));
        float sum = 0.f;
#pragma unroll
        for (int kb = 0; kb < 16; ++kb)
#pragma unroll
            for (int j = 0; j < 4; ++j) { const float p = __builtin_amdgcn_exp2f(S[kb][j] - mx); S[kb][j] = p; sum += p; }
        sum += __shfl_xor(sum, 16); sum += __shfl_xor(sum, 32);
        inv[qb] = 1.0f / sum;
#pragma unroll
        for (int ks = 0; ks < 8; ++ks) { const u32x4 w = pack8(S[2 * ks], S[2 * ks + 1]); Pf[qb][ks] = __builtin_bit_cast(bf16x8, w); }
        asm volatile("" ::: "memory");
    }
    __syncthreads();
    {
        const bf16_t* vg = Vt + (size_t)(h * 256 + (tid >> 5)) * 1024 + b * 256 + (tid & 31) * 8;
        LAS unsigned char* vl = lds + (tid >> 5) * LDV + (tid & 31) * 16;
#pragma unroll
        for (int half = 0; half < 2; ++half) {
            u32x4 kr[8];
#pragma unroll
            for (int i = 0; i < 8; ++i) kr[i] = *(const u32x4*)(vg + (size_t)(half * 8 + i) * 16 * 1024);
#pragma unroll
            for (int i = 0; i < 8; ++i) *(LAS u32x4*)(vl + (half * 8 + i) * 16 * LDV) = kr[i];
        }
    }
    __syncthreads();
    const LAS unsigned char* vbase = lds + fr * LDV + fq * 8;
    bf16_t* obase = o + (size_t)(row0 + fr) * D + h * 256 + 4 * fq;
#pragma unroll
    for (int dh = 0; dh < 2; ++dh) {
        f32x4 O[2][8];
#pragma unroll
        for (int qb = 0; qb < 2; ++qb)
#pragma unroll
            for (int db = 0; db < 8; ++db) O[qb][db] = (f32x4){0.f, 0.f, 0.f, 0.f};
        u32x2 vlo[2][4], vhi[2][4];
#pragma unroll
        for (int k4 = 0; k4 < 4; ++k4) { const LAS unsigned char* vp = vbase + 128 * dh * LDV + 64 * k4; vlo[0][k4] = *(const LAS u32x2*)vp; vhi[0][k4] = *(const LAS u32x2*)(vp + 32); }
#pragma unroll
        for (int it = 0; it < 16; ++it) {
            if (it < 15) {
#pragma unroll
                for (int k4 = 0; k4 < 4; ++k4) { const LAS unsigned char* vp = vbase + (128 * dh + 16 * ((it + 1) >> 1)) * LDV + 64 * (4 * ((it + 1) & 1) + k4); vlo[(it + 1) & 1][k4] = *(const LAS u32x2*)vp; vhi[(it + 1) & 1][k4] = *(const LAS u32x2*)(vp + 32); }
            }
#pragma unroll
            for (int k4 = 0; k4 < 4; ++k4) {
                const u32x4 w = {vlo[it & 1][k4].x, vlo[it & 1][k4].y, vhi[it & 1][k4].x, vhi[it & 1][k4].y}; const bf16x8 vf = __builtin_bit_cast(bf16x8, w);
#pragma unroll
                for (int qb = 0; qb < 2; ++qb) O[qb][it >> 1] = __builtin_amdgcn_mfma_f32_16x16x32_bf16(vf, Pf[qb][4 * (it & 1) + k4], O[qb][it >> 1], 0, 0, 0);
            }
#pragma unroll
            for (int k4 = 0; k4 < 4; ++k4) { __builtin_amdgcn_sched_group_barrier(0x100, 2, 0); __builtin_amdgcn_sched_group_barrier(0x008, 2, 0); }
            __builtin_amdgcn_sched_barrier(0);
        }
#pragma unroll
        for (int qb = 0; qb < 2; ++qb)
#pragma unroll
            for (int db = 0; db < 8; ++db) {
                const f32x4 v = O[qb][db] * inv[qb]; u32x2 w; w.x = cvt_pk_bf16(v[0], v[1]); w.y = cvt_pk_bf16(v[2], v[3]);
                *(u32x2*)(obase + (size_t)(16 * qb) * D + 128 * dh + 16 * db) = w;
            }
    }
    __syncthreads();
}

#define PHASE_ARGS const Args& a, LAS unsigned char* lds, unsigned char* ws, int tid, int wid, int lane, int bid, int G
#define PHASE_CALL a, lds, ws, tid, wid, lane, bid, G
constexpr size_t TS1024 = (size_t)256 * 1024 * 2;

__device__ __forceinline__ void phase_p1(PHASE_ARGS) {
    pg8::Sched S{}; S.G = G; S.c = bid; S.tstep = TS1024;
    S.A0 = (const char*)(ws + WS_HN); S.B0 = (const char*)(ws + WS_BT1); S.nM0 = 64; S.nN0 = 4;
    S.A1 = (const char*)(ws + WS_HN); S.B1 = (const char*)(ws + WS_BT1) + (size_t)1024 * 2048; S.nM1 = 64; S.nN1 = 2;
    S.A2 = (const char*)(ws + WS_BT1) + (size_t)1536 * 2048; S.B2 = (const char*)(ws + WS_HN); S.nM2 = 2; S.nN2 = 64;
    EpiP1 E{(bf16_t*)(ws + WS_AGLU), (bf16_t*)(ws + WS_U), (bf16_t*)(ws + WS_GVT), a.in[4], (const float*)(ws + WS_RX)};
    pg8::gemm_phase(lds, 1024, S, E);
}
__device__ __forceinline__ void phase_p2(PHASE_ARGS) {
    conv_unit<64>(a, lds, bid, tid, wid, lane);
    if (bid < 128) {
        gmlp_unit(a, lds, bid, tid, wid, lane);
    } else if (bid < 160) {
        pg8::Sched S{}; S.G = 32; S.c = bid - 128; S.tstep = TS1024;
        S.A0 = (const char*)(ws + WS_MN); S.B0 = (const char*)(ws + WS_WKV); S.nM0 = 4; S.nN0 = 4;
        S.A1 = (const char*)(ws + WS_WKV) + (size_t)1024 * 2048; S.B1 = (const char*)(ws + WS_MN); S.nM1 = 4; S.nN1 = 4;
        EpiKV E{(bf16_t*)(ws + WS_KM), (bf16_t*)(ws + WS_VT)};
        pg8::gemm_phase(lds, 1024, S, E);
    } else {
        late_weights(a, lds, (bid - 160) * 8 + wid, 96 * 8, wid, lane);
    }
}
__device__ __forceinline__ void phase_p3(PHASE_ARGS) {
    pg8::Sched S{}; S.G = G; S.c = bid; S.tstep = TS1024;
    S.A0 = (const char*)(ws + WS_MIX); S.B0 = (const char*)(ws + WS_WOUT); S.nM0 = 64; S.nN0 = 4;
    EpiRes<true> E{(const bf16_t*)(ws + WS_HN), (bf16_t*)(ws + WS_HB), (float*)(ws + WS_SSQ1)};
    pg8::gemm_phase(lds, 1024, S, E);
}
__device__ __forceinline__ void phase_p4(PHASE_ARGS) {
    pg8::Sched S{}; S.G = 1 << 20; S.c = bid; S.tstep = TS1024;
    S.A0 = (const char*)(ws + WS_HB); S.B0 = (const char*)(ws + WS_WQ); S.nM0 = 64; S.nN0 = 4;
    Unit un; S.next(0, un);
    EpiQ E{(bf16_t*)(ws + WS_Q), (const float*)(ws + WS_SSQ1)};
    pg8::gemm_phase(lds, 1024, S, E);
    asm volatile("s_waitcnt vmcnt(0)" ::: "memory");
    __syncthreads();
    attn_unit(lds, (const bf16_t*)(ws + WS_Q), (const bf16_t*)(ws + WS_KM), (const bf16_t*)(ws + WS_VT), (bf16_t*)(ws + WS_HN), un.pm, un.pn, tid, wid, lane);
}
__device__ __forceinline__ void phase_p5(PHASE_ARGS) {
    pg8::Sched S{}; S.G = G; S.c = bid; S.tstep = TS1024;
    S.A0 = (const char*)(ws + WS_HN); S.B0 = (const char*)(ws + WS_WO); S.nM0 = 64; S.nN0 = 4;
    EpiRes<true> E{(const bf16_t*)(ws + WS_HB), (bf16_t*)(ws + WS_HB), (float*)(ws + WS_SSQ2)};
    pg8::gemm_phase(lds, 1024, S, E);
}
__device__ __forceinline__ void phase_p6(PHASE_ARGS) {
    pg8::Sched S{}; S.G = G; S.c = bid; S.tstep = TS1024;
    S.A0 = (const char*)(ws + WS_HB); S.B0 = (const char*)(ws + WS_WGU); S.nM0 = 64; S.nN0 = 22;
    LAS float* rsT = (LAS float*)(lds + 131072);
    {
        const float* ssq = (const float*)(ws + WS_SSQ2);
        const int sel = tid >> 8, r = tid & 255;
#pragma unroll
        for (int k = 0; k < 3; ++k) {
            Unit u0, u1; const bool ok0 = S.next(2 * k, u0), ok1 = S.next(2 * k + 1, u1);
            const bool ok = sel ? ok1 : ok0; const int pm = sel ? u1.pm : u0.pm;
            if (ok) { const f32x4* p = (const f32x4*)(ssq + ((size_t)pm * 256 + r) * 16);
                const f32x4 t = (p[0] + p[1]) + (p[2] + p[3]);
                rsT[(2 * k + sel) * 256 + r] = __builtin_amdgcn_rsqf(((t[0] + t[1]) + (t[2] + t[3])) * (1.0f / D) + RMS_EPS); }
        }
    }
    __syncthreads();
    EpiGU E{(bf16_t*)(ws + WS_ACT), rsT};
    pg8::gemm_phase(lds, 1024, S, E);
}
__device__ __forceinline__ void phase_p7(PHASE_ARGS) {
    pg8::Sched S{}; S.G = G; S.c = bid; S.tstep = (size_t)256 * FF * 2;
    S.A0 = (const char*)(ws + WS_ACT); S.B0 = (const char*)(ws + WS_WD); S.nM0 = 64; S.nN0 = 4;
    EpiFinal E{(const bf16_t*)(ws + WS_HB), a.out, (float*)(ws + WS_SSQ3), (unsigned*)(ws + WS_CTL + 16384), a.in[22]};
    pg8::gemm_phase(lds, FF, S, E);
}
__global__ void __launch_bounds__(512, 2) fwd_mega(Args a) {
    extern __shared__ __attribute__((aligned(16))) unsigned char lds_raw[];
    LAS unsigned char* lds = (LAS unsigned char*)lds_raw;
    cg::grid_group grid = cg::this_grid();
    const int tid = threadIdx.x, wid = __builtin_amdgcn_readfirstlane(tid >> 6), lane = tid & 63, bid = blockIdx.x, G = gridDim.x;
    unsigned char* ws = a.ws;
    if (tid < 2) ((volatile LAS unsigned*)(lds + LDS_BYTES - 64))[tid] = 0u;
    __syncthreads();
    const XcdBarrier xbar = xcd_barrier_post((unsigned*)(ws + WS_CTL), (volatile LAS unsigned*)(lds + LDS_BYTES - 64));
    if (a.never != 0) grid.sync();
#define GRID_BAR() xcd_barrier(xbar)
    { p0_prologue(a, lds, bid, G, wid, lane); }
    GRID_BAR();
    phase_p1(PHASE_CALL); GRID_BAR();
    { phase_p2(PHASE_CALL);
    } GRID_BAR();
    phase_p3(PHASE_CALL); GRID_BAR();
    { phase_p4(PHASE_CALL); } GRID_BAR();
    { phase_p5(PHASE_CALL); } GRID_BAR();
    phase_p6(PHASE_CALL); GRID_BAR();
    phase_p7(PHASE_CALL);
}

extern "C" void kernel_launch(void* const* d_in, const int* in_sizes, int n_in, void* d_out, int out_size, void* d_ws, size_t ws_size, hipStream_t stream) {
    static int grid = 0;
    if (grid == 0) {
        int dev = 0, cus = 0, per_cu = 0;
        (void)hipGetDevice(&dev);
        (void)hipDeviceGetAttribute(&cus, hipDeviceAttributeMultiprocessorCount, dev);
        (void)hipFuncSetAttribute((const void*)fwd_mega, hipFuncAttributeMaxDynamicSharedMemorySize, LDS_BYTES);
        (void)hipOccupancyMaxActiveBlocksPerMultiprocessor(&per_cu, (const void*)fwd_mega, 512, LDS_BYTES);
        (void)hipGetLastError();
        grid = cus > 0 ? cus : 256;
        if (grid > 256) grid = 256;
    }
    Args a{};
    for (int i = 0; i < 23; ++i) a.in[i] = (const float*)d_in[i];
    a.out = (float*)d_out; a.ws = (unsigned char*)d_ws; a.never = 0ull;
    (void)hipMemsetAsync((char*)d_ws + WS_CTL, 0, CTL_ZERO_BYTES, stream);
    void* args[] = {&a};
    hipError_t e = hipLaunchCooperativeKernel((const void*)fwd_mega, dim3(grid), dim3(512), args, LDS_BYTES, stream);
    if (e != hipSuccess) fprintf(stderr, "cooperative launch failed: %s (grid %d)\n", hipGetErrorString(e), grid);
}
```
